# Optimizing an MI355X kernel written in HIP

```python
import math
import jax, jax.numpy as jnp
from jax import lax
import numpy as np

D_MODEL = 1024
BATCH = 8
SEQ = 4096
DEPTH = 2

S5_GROUP = 16
S5_WIDTH = D_MODEL // 4
S5_GROUPS = S5_WIDTH // S5_GROUP
S5_STATE = 64
S5_DT_MIN = 1e-3
S5_DT_MAX = 1e-1
LRU_WIDTH = D_MODEL // 2
LRU_BLOCK = 64
LRU_BLOCKS = LRU_WIDTH // LRU_BLOCK
LRU_CONV = 4
LRU_C = 8.0
GLA_HEADS = 4
GLA_DK = 64
GLA_DV = 64
GLA_QK = GLA_HEADS * GLA_DK
GLA_WIDTH = GLA_HEADS * GLA_DV
GLA_RANK = 16
GLA_TAU = 16.0
GLA_CHUNK = 64
N_BRANCH = 3
N_EXPERTS = 16
EXPERT_FF = 2 * D_MODEL
CAPACITY_FACTOR = 2
EPS = 1e-6

OFF_S5 = 0
OFF_LRU = OFF_S5 + S5_WIDTH
OFF_Q = OFF_LRU + LRU_WIDTH
OFF_K = OFF_Q + GLA_QK
OFF_V = OFF_K + GLA_QK
OFF_OG = OFF_V + GLA_WIDTH
OFF_ALR = OFF_OG + GLA_WIDTH
OFF_GATE = OFF_ALR + 2 * GLA_RANK
IN_WIDTH = OFF_GATE + N_BRANCH * D_MODEL

kernel_name = "hybrid_bidir_s5_rglru_gla_ec"


def rms_norm(x, g):
    x32 = x.astype(jnp.float32)
    y = x32 * lax.rsqrt(jnp.mean(x32 * x32, axis=-1, keepdims=True) + EPS)
    return (y * g.astype(jnp.float32)).astype(x.dtype)


def _lin_combine(e_i, e_j):
    a_i, b_i = e_i
    a_j, b_j = e_j
    return a_j * a_i, a_j * b_i + b_j


def _cplx_combine(e_i, e_j):
    ar_i, ai_i, br_i, bi_i = e_i
    ar_j, ai_j, br_j, bi_j = e_j
    return (ar_j * ar_i - ai_j * ai_i,
            ar_j * ai_i + ai_j * ar_i,
            ar_j * br_i - ai_j * bi_i + br_j,
            ar_j * bi_i + ai_j * br_i + bi_j)


def s5_direction(ug, lam_re, lam_im, log_dt, b_re, b_im, c_re, c_im, reverse):
    seq = ug.shape[1]
    lr = jnp.minimum(lam_re, -1e-4)
    dt = jnp.exp(log_dt)[:, None]
    mag = jnp.exp(lr * dt)
    ang = lam_im * dt
    a_re = mag * jnp.cos(ang)
    a_im = mag * jnp.sin(ang)
    den = lr * lr + lam_im * lam_im
    k_re = (((a_re - 1) * lr + a_im * lam_im) / den)[..., None]
    k_im = ((a_im * lr - (a_re - 1) * lam_im) / den)[..., None]
    bb_re = k_re * b_re - k_im * b_im
    bb_im = k_re * b_im + k_im * b_re
    bu_re = jnp.einsum('bsgh,gph->bsgp', ug, bb_re)
    bu_im = jnp.einsum('bsgh,gph->bsgp', ug, bb_im)
    shp = (1, seq) + a_re.shape
    ar = jnp.broadcast_to(a_re, shp)
    ai = jnp.broadcast_to(a_im, shp)
    _, _, x_re, x_im = lax.associative_scan(
        _cplx_combine, (ar, ai, bu_re, bu_im), reverse=reverse, axis=1)
    return (jnp.einsum('bsgp,ghp->bsgh', x_re, c_re)
            - jnp.einsum('bsgp,ghp->bsgh', x_im, c_im))


def s5_mixer(u, lam_re, lam_im, log_dt, b_re, b_im, c_re, c_im, d, w_glu):
    bsz, seq, _ = u.shape
    ug = u.reshape(bsz, seq, S5_GROUPS, S5_GROUP)
    y = d.reshape(S5_GROUPS, S5_GROUP) * ug
    for di in range(2):
        y = y + s5_direction(ug, lam_re[di], lam_im[di], log_dt[di], b_re[di], b_im[di],
                             c_re[di], c_im[di], reverse=(di == 1))
    y = y.reshape(bsz, seq, S5_WIDTH)
    z = jax.nn.gelu(y)
    return z * jax.nn.sigmoid(z @ w_glu)


def rg_lru_direction(xc, w_a, b_a, w_x, b_x, lam, reverse):
    bsz, seq, _ = xc.shape
    xr = xc.reshape(bsz, seq, LRU_BLOCKS, LRU_BLOCK)
    r = jax.nn.sigmoid(jnp.einsum('bsnc,ncd->bsnd', xr, w_a).reshape(bsz, seq, LRU_WIDTH) + b_a)
    i = jax.nn.sigmoid(jnp.einsum('bsnc,ncd->bsnd', xr, w_x).reshape(bsz, seq, LRU_WIDTH) + b_x)
    log_a = -LRU_C * r * jax.nn.softplus(-lam)
    a = jnp.exp(log_a)
    mult = jnp.sqrt(jnp.maximum(-jnp.expm1(2 * log_a), 0))
    _, h = lax.associative_scan(_lin_combine, (a, mult * (i * xc)), reverse=reverse, axis=1)
    return h


def rg_lru_mixer(xb, conv_w, conv_b, w_a, b_a, w_x, b_x, lam):
    pad = (LRU_CONV // 2, LRU_CONV - 1 - LRU_CONV // 2)
    xc = lax.conv_general_dilated(
        xb, conv_w[:, None, :], window_strides=(1,), padding=[pad],
        dimension_numbers=('NWC', 'WIO', 'NWC'), feature_group_count=LRU_WIDTH) + conv_b
    h = rg_lru_direction(xc, w_a[0], b_a[0], w_x[0], b_x[0], lam[0], reverse=False)
    return h + rg_lru_direction(xc, w_a[1], b_a[1], w_x[1], b_x[1], lam[1], reverse=True)


def gla_direction(q, k, v, g, strict):
    bsz, seq, nh, _ = q.shape
    n_chunk = seq // GLA_CHUNK

    def chunks(t):
        return t.reshape(bsz, n_chunk, GLA_CHUNK, nh, t.shape[-1]).transpose(0, 3, 1, 2, 4)

    q, k, v, g = chunks(q), chunks(k), chunks(v), chunks(g)
    bcum = jnp.cumsum(g.astype(jnp.float32), axis=3)
    b_last = bcum[:, :, :, -1:, :]
    q_dec = q * jnp.exp(bcum)
    k_dec = k * jnp.exp(-bcum)
    mask = jnp.tril(jnp.ones((GLA_CHUNK, GLA_CHUNK), dtype=bool), -1 if strict else 0)
    scores = jnp.where(mask, jnp.einsum('bhnid,bhnjd->bhnij', q_dec, k_dec), 0.0)
    o_intra = jnp.einsum('bhnij,bhnjv->bhniv', scores, v)
    chunk_kv = jnp.einsum('bhnjd,bhnjv->bhndv', k * jnp.exp(b_last - bcum), v)
    decay = jnp.exp(b_last[:, :, :, 0, :])

    def step(state, inp):
        dec, kv = inp
        return dec[..., None] * state + kv, state

    init = jnp.zeros((bsz, nh, GLA_DK, GLA_DV), chunk_kv.dtype)
    _, prev = lax.scan(step, init, (jnp.moveaxis(decay, 2, 0), jnp.moveaxis(chunk_kv, 2, 0)))
    prev = jnp.moveaxis(prev, 0, 2)
    o = o_intra + jnp.einsum('bhnid,bhndv->bhniv', q_dec, prev)
    return o.transpose(0, 2, 3, 1, 4).reshape(bsz, seq, nh, GLA_DV).astype(v.dtype)


def gla_mixer(q, k, v, og, alr, w_alpha, b_alpha, norm_g):
    bsz, seq, _ = q.shape
    shp = (bsz, seq, GLA_HEADS, GLA_DK)
    q = q.reshape(shp) * (GLA_DK ** -0.5)
    k = k.reshape(shp)
    v = v.reshape(bsz, seq, GLA_HEADS, GLA_DV)
    g_f = jax.nn.log_sigmoid(alr[..., :GLA_RANK] @ w_alpha[0] + b_alpha[0]).reshape(shp) / GLA_TAU
    g_b = jax.nn.log_sigmoid(alr[..., GLA_RANK:] @ w_alpha[1] + b_alpha[1]).reshape(shp) / GLA_TAU
    o_f = gla_direction(q, k, v, g_f, strict=False)
    fl = lambda t: jnp.flip(t, axis=1)
    o_b = fl(gla_direction(fl(q), fl(k), fl(v), fl(g_b), strict=True))
    o = rms_norm(o_f + o_b, norm_g)
    return o.reshape(bsz, seq, GLA_WIDTH) * jax.nn.silu(og)


def ec_ffn(hn, w_router, w_gate, w_up, w_down):
    bsz, seq, d = hn.shape
    cap = CAPACITY_FACTOR * seq // N_EXPERTS
    probs = jax.nn.softmax((hn @ w_router).astype(jnp.float32), axis=-1)
    gate, idx = lax.top_k(jnp.swapaxes(probs, 1, 2), cap)
    xe = jax.vmap(lambda t, i: t[i])(hn, idx)
    hid = jax.nn.silu(jnp.einsum('becd,edf->becf', xe, w_gate)) * jnp.einsum('becd,edf->becf', xe, w_up)
    ye = jnp.einsum('becf,efd->becd', hid, w_down) * gate.astype(hn.dtype)[..., None]
    return jax.vmap(lambda i, y: jnp.zeros((seq, d), y.dtype).at[i.reshape(-1)].add(y.reshape(-1, d)))(idx, ye)


def setup_inputs(seed: int = 0) -> dict:
    key = jax.random.key(seed)
    ks = iter(jax.random.split(key, 40))

    def nrm(shape, scale):
        return scale * jax.random.normal(next(ks), shape, jnp.float32)

    L = DEPTH
    G, P, H = S5_GROUPS, S5_STATE, S5_GROUP
    n = jnp.arange(P, dtype=jnp.float32)
    log_dt = jax.random.uniform(next(ks), (L, 2, G), jnp.float32,
                                math.log(S5_DT_MIN), math.log(S5_DT_MAX))
    a_c = jax.random.uniform(next(ks), (L, 2, LRU_WIDTH), jnp.float32, 0.9, 0.999)
    a = a_c ** (1.0 / LRU_C)
    return dict(
        x=nrm((BATCH, SEQ, D_MODEL), 1.0),
        mix_norm_g=1.0 + nrm((L, D_MODEL), 0.02),
        w_in=nrm((L, D_MODEL, IN_WIDTH), D_MODEL ** -0.5),
        s5_lam_re=-0.5 + nrm((L, 2, G, P), 0.01),
        s5_lam_im=math.pi * n + nrm((L, 2, G, P), 0.01),
        s5_log_dt=log_dt,
        s5_b_re=nrm((L, 2, G, P, H), (2 * H) ** -0.5),
        s5_b_im=nrm((L, 2, G, P, H), (2 * H) ** -0.5),
        s5_c_re=nrm((L, 2, G, H, P), (2 * P) ** -0.5),
        s5_c_im=nrm((L, 2, G, H, P), (2 * P) ** -0.5),
        s5_d=nrm((L, S5_WIDTH), 1.0),
        s5_w_glu=nrm((L, S5_WIDTH, S5_WIDTH), S5_WIDTH ** -0.5),
        lru_conv_w=nrm((L, LRU_CONV, LRU_WIDTH), LRU_CONV ** -0.5),
        lru_conv_b=nrm((L, LRU_WIDTH), 0.01),
        lru_w_a=nrm((L, 2, LRU_BLOCKS, LRU_BLOCK, LRU_BLOCK), LRU_BLOCK ** -0.5),
        lru_b_a=nrm((L, 2, LRU_WIDTH), 0.01),
        lru_w_x=nrm((L, 2, LRU_BLOCKS, LRU_BLOCK, LRU_BLOCK), LRU_BLOCK ** -0.5),
        lru_b_x=nrm((L, 2, LRU_WIDTH), 0.01),
        lru_lam=jnp.log(a) - jnp.log1p(-a),
        gla_w_alpha=nrm((L, 2, GLA_RANK, GLA_QK), GLA_RANK ** -0.5),
        gla_b_alpha=nrm((L, 2, GLA_QK), 0.1),
        gla_norm_g=1.0 + nrm((L, GLA_DV), 0.02),
        w_up_s5=nrm((L, S5_WIDTH, D_MODEL), S5_WIDTH ** -0.5),
        w_up_lru=nrm((L, LRU_WIDTH, D_MODEL), LRU_WIDTH ** -0.5),
        w_up_gla=nrm((L, GLA_WIDTH, D_MODEL), GLA_WIDTH ** -0.5),
        w_mix_out=nrm((L, D_MODEL, D_MODEL), D_MODEL ** -0.5),
        ffn_norm_g=1.0 + nrm((L, D_MODEL), 0.02),
        w_router=nrm((L, D_MODEL, N_EXPERTS), D_MODEL ** -0.5),
        w_exp_gate=nrm((L, N_EXPERTS, D_MODEL, EXPERT_FF), D_MODEL ** -0.5),
        w_exp_up=nrm((L, N_EXPERTS, D_MODEL, EXPERT_FF), D_MODEL ** -0.5),
        w_exp_down=nrm((L, N_EXPERTS, EXPERT_FF, D_MODEL), EXPERT_FF ** -0.5),
        final_norm_g=1.0 + nrm((D_MODEL,), 0.02),
    )


def reference(x, mix_norm_g, w_in, s5_lam_re, s5_lam_im, s5_log_dt, s5_b_re, s5_b_im,
              s5_c_re, s5_c_im, s5_d, s5_w_glu, lru_conv_w, lru_conv_b, lru_w_a, lru_b_a,
              lru_w_x, lru_b_x, lru_lam, gla_w_alpha, gla_b_alpha, gla_norm_g,
              w_up_s5, w_up_lru, w_up_gla, w_mix_out, ffn_norm_g, w_router,
              w_exp_gate, w_exp_up, w_exp_down, final_norm_g):
    bsz, seq, _ = x.shape
    h = x
    for l in range(DEPTH):
        xn = rms_norm(h, mix_norm_g[l])
        p = xn @ w_in[l]
        y_s5 = s5_mixer(p[..., OFF_S5:OFF_LRU], s5_lam_re[l], s5_lam_im[l], s5_log_dt[l],
                        s5_b_re[l], s5_b_im[l], s5_c_re[l], s5_c_im[l], s5_d[l], s5_w_glu[l])
        y_lru = rg_lru_mixer(p[..., OFF_LRU:OFF_Q], lru_conv_w[l], lru_conv_b[l], lru_w_a[l],
                             lru_b_a[l], lru_w_x[l], lru_b_x[l], lru_lam[l])
        y_gla = gla_mixer(p[..., OFF_Q:OFF_K], p[..., OFF_K:OFF_V], p[..., OFF_V:OFF_OG],
                          p[..., OFF_OG:OFF_ALR], p[..., OFF_ALR:OFF_GATE],
                          gla_w_alpha[l], gla_b_alpha[l], gla_norm_g[l])
        gates = jax.nn.sigmoid(p[..., OFF_GATE:].reshape(bsz, seq, N_BRANCH, D_MODEL))
        merged = (gates[:, :, 0] * (y_s5 @ w_up_s5[l])
                  + gates[:, :, 1] * (y_lru @ w_up_lru[l])
                  + gates[:, :, 2] * (y_gla @ w_up_gla[l]))
        h = h + merged @ w_mix_out[l]
        h = h + ec_ffn(rms_norm(h, ffn_norm_g[l]), w_router[l], w_exp_gate[l],
                       w_exp_up[l], w_exp_down[l])
    return rms_norm(h, final_norm_g)
```

```cpp
#include <hip/hip_runtime.h>
#include <cstdio>
#include <cstdint>

#define MK_PROBE_SET -1
#define MK_PROBE_FLAGS_SET 1
#define MK_PROBE MK_PROBE_SET
#define MK_REPEAT 0
#ifndef MK_PER_PHASE
#define MK_PER_PHASE 0
#endif

#define GAS __attribute__((address_space(1)))
#define LAS __attribute__((address_space(3)))
typedef unsigned short bf16;
typedef short bf16x8 __attribute__((ext_vector_type(8)));
typedef float f32x4 __attribute__((ext_vector_type(4)));
typedef float f32x2 __attribute__((ext_vector_type(2)));
typedef unsigned u32x4 __attribute__((ext_vector_type(4)));
typedef unsigned u32x2 __attribute__((ext_vector_type(2)));

constexpr int NBATCH = 8, SEQ = 4096, T = NBATCH * SEQ, D = 1024, DEPTH = 2;
constexpr int NIN = 5120;
constexpr int IN_W = 4896;
constexpr int NE = 16, FF = 2048, CAP = 512;
constexpr int S5L = 32, S5NCH = SEQ / S5L;
constexpr int S5ROWS = NBATCH * S5NCH;
constexpr int UXP = 768;
constexpr float EPS = 1e-6f;
constexpr float SA8 = 16.f, SW8 = 256.f, SH8 = 8.f, SY8 = 64.f;
constexpr int NPH = 14;

constexpr size_t MiB = 1u << 20;
constexpr size_t WS_CTL = 0, CTL_BYTES = 1 * MiB;
constexpr size_t WS_SS1 = 1 * MiB;
constexpr size_t WS_SS2 = WS_SS1 + 128 * 1024;
constexpr size_t WS_IDX = WS_SS2 + 128 * 1024;
constexpr size_t WS_GATEP = WS_IDX + 256 * 1024;
constexpr size_t WS_LRUW = WS_GATEP + 256 * 1024;
constexpr size_t WS_WRT = 2 * MiB;
constexpr size_t WS_LRUC8 = 2 * MiB + 128 * 1024;
constexpr size_t WS_SEL = 3 * MiB;
constexpr size_t WS_GDEC = 4 * MiB;
constexpr size_t WS_PROBS = 5 * MiB;
constexpr size_t WS_LSUM = 7 * MiB;
constexpr size_t WS_LCAR = 11 * MiB;
constexpr size_t WS_XLOC = 13 * MiB;
constexpr size_t WS_WGLU = 29 * MiB;
constexpr size_t WS_WUP = 30 * MiB;
constexpr size_t WS_WMIX = 32 * MiB;
constexpr size_t WS_S5MIN = 34 * MiB;
constexpr size_t WS_S5BT2 = 38 * MiB;
constexpr size_t WS_WIN = 50 * MiB;
constexpr size_t WS_WIN8 = 54 * MiB;
constexpr size_t WS_W1 = 60 * MiB;
constexpr size_t WS_W2 = 188 * MiB;
constexpr size_t WS_HB = 252 * MiB;
constexpr size_t WS_HB2 = 316 * MiB;
constexpr size_t WS_STAGE = 380 * MiB;
constexpr size_t WS_UX = WS_STAGE;
constexpr size_t WS_XB = WS_UX + 24 * MiB;
constexpr size_t WS_Q = WS_XB + 32 * MiB;
constexpr size_t WS_K = WS_Q + 16 * MiB;
constexpr size_t WS_V = WS_K + 16 * MiB;
constexpr size_t WS_SOG = WS_V + 16 * MiB;
constexpr size_t WS_ALR = WS_SOG + 16 * MiB;
constexpr size_t WS_GATES = WS_ALR + 4 * MiB;
constexpr size_t WS_YLOC = WS_GATES + 192 * MiB;
constexpr size_t WS_PF = WS_YLOC + 32 * MiB;
constexpr size_t WS_PB = WS_PF + 32 * MiB;
constexpr size_t WS_OIN = WS_PB + 32 * MiB;
constexpr size_t WS_QDF = WS_OIN + 16 * MiB;
constexpr size_t WS_QDB = WS_QDF + 16 * MiB;
constexpr size_t WS_KV = WS_QDB + 16 * MiB;
constexpr size_t WS_Z = WS_KV + 32 * MiB;
constexpr size_t WS_YCAT = WS_Z + 16 * MiB;
constexpr size_t WS_MIXEND = WS_YCAT + 64 * MiB;
constexpr size_t WS_MERGED = WS_XB;
constexpr size_t WS_XE = WS_STAGE;
constexpr size_t WS_HB8 = WS_STAGE + 400 * MiB;
constexpr size_t WS_XN8 = WS_STAGE + 400 * MiB;
constexpr size_t WS_HID = WS_STAGE + 128 * MiB;
constexpr size_t WS_END = (WS_MIXEND > WS_HID + 256 * MiB) ? WS_MIXEND : (WS_HID + 256 * MiB);
static_assert(WS_END <= 1000 * MiB && WS_XN8 >= WS_HID + 256 * MiB && WS_XN8 + 32 * MiB <= WS_END, "workspace map");

constexpr int LDS_BYTES = 160 * 1024;
constexpr int LDSCTL_OFF = LDS_BYTES - 1024;

__device__ __forceinline__ unsigned f2bf(float f) { unsigned u = __builtin_bit_cast(unsigned, f); return (u + 0x7fffu + ((u >> 16) & 1u)) >> 16; }
__device__ __forceinline__ float bf2f(unsigned h) { return __builtin_bit_cast(float, h << 16); }
typedef __bf16 bf16x2_t __attribute__((ext_vector_type(2)));
__device__ __forceinline__ unsigned cvt_pk_bf16(float lo, float hi) { const f32x2 v = {lo, hi}; return __builtin_bit_cast(unsigned, __builtin_convertvector(v, bf16x2_t)); }
__device__ __forceinline__ float bflo(unsigned w) { return __builtin_bit_cast(float, w << 16); }
__device__ __forceinline__ float bfhi(unsigned w) { return __builtin_bit_cast(float, w & 0xffff0000u); }
__device__ __forceinline__ float rcpf_(float x) { return __builtin_amdgcn_rcpf(x); }
__device__ __forceinline__ int   shx_(int v, int off, int lane)   { return __builtin_amdgcn_ds_bpermute((lane ^ off) << 2, v); }
__device__ __forceinline__ float shxf_(float v, int off, int lane) { return __builtin_bit_cast(float, __builtin_amdgcn_ds_bpermute((lane ^ off) << 2, __builtin_bit_cast(int, v))); }
__device__ __forceinline__ unsigned shdn_(unsigned v, int off, int lane) { return (unsigned)__builtin_amdgcn_ds_bpermute(((lane + off) & 63) << 2, (int)v); }
__device__ __forceinline__ unsigned shup_(unsigned v, int off, int lane) { return (unsigned)__builtin_amdgcn_ds_bpermute(((lane - off) & 63) << 2, (int)v); }
__device__ __forceinline__ float sigmoid_(float x) { return rcpf_(1.f + __expf(-x)); }
__device__ __forceinline__ float silu_(float x) { return x * sigmoid_(x); }
__device__ __forceinline__ float gelu_tanh_(float x) { const float u = 0.7978845608028654f * (x + 0.044715f * x * x * x); return x * sigmoid_(2.f * u); }
__device__ __forceinline__ float logsig_(float x) { return fminf(x, 0.f) - __logf(1.f + __expf(-fabsf(x))); }
__device__ __forceinline__ void unpack8(const u32x4 w, float (&o)[8]) { o[0] = bflo(w.x); o[1] = bfhi(w.x); o[2] = bflo(w.y); o[3] = bfhi(w.y); o[4] = bflo(w.z); o[5] = bfhi(w.z); o[6] = bflo(w.w); o[7] = bfhi(w.w); }
__device__ __forceinline__ u32x4 pack8(const float (&v)[8]) { u32x4 w; w.x = cvt_pk_bf16(v[0], v[1]); w.y = cvt_pk_bf16(v[2], v[3]); w.z = cvt_pk_bf16(v[4], v[5]); w.w = cvt_pk_bf16(v[6], v[7]); return w; }
__device__ __forceinline__ float clamp8_(float x) { return __builtin_amdgcn_fmed3f(x, -448.f, 448.f); }
__device__ __forceinline__ void unpack8_fp8(const u32x2 w, float (&o)[8]) { const f32x2 a = __builtin_amdgcn_cvt_pk_f32_fp8((int)w.x, false), b = __builtin_amdgcn_cvt_pk_f32_fp8((int)w.x, true), c = __builtin_amdgcn_cvt_pk_f32_fp8((int)w.y, false), d = __builtin_amdgcn_cvt_pk_f32_fp8((int)w.y, true);
    o[0] = a.x; o[1] = a.y; o[2] = b.x; o[3] = b.y; o[4] = c.x; o[5] = c.y; o[6] = d.x; o[7] = d.y; }
__device__ __forceinline__ unsigned pack4_fp8(float a, float b, float c, float d) { int r = 0; r = __builtin_amdgcn_cvt_pk_fp8_f32(a, b, r, false); r = __builtin_amdgcn_cvt_pk_fp8_f32(c, d, r, true); return (unsigned)r; }
typedef int i32x8 __attribute__((ext_vector_type(8)));
typedef int i32x4 __attribute__((ext_vector_type(4)));
#define LDS_WAIT() asm volatile("s_waitcnt lgkmcnt(0)" ::: "memory")
#define VM_WAIT() asm volatile("s_waitcnt vmcnt(0)" ::: "memory")
#define MFMA16(a, b, c) __builtin_amdgcn_mfma_f32_16x16x32_bf16((a), (b), (c), 0, 0, 0)

#define XB_TMO      128
#define XB_XCNT(j)  (256  + 64 * (j))
#define XB_XSUB(j)  (1280 + 64 * (j))
#define XB_XGEN(j)  (2304 + 64 * (j))
#define XB_TOP      3328
#define XB_TOPGEN   3392
#define XCD_BAR_WORDS 3456
#define XB_SPIN_CAP (1u << 18)
__device__ __forceinline__ unsigned xb_ld(unsigned* p)              { return __hip_atomic_load(p, __ATOMIC_RELAXED, __HIP_MEMORY_SCOPE_AGENT); }
__device__ __forceinline__ unsigned xb_add(unsigned* p, unsigned v) { return __hip_atomic_fetch_add(p, v, __ATOMIC_RELAXED, __HIP_MEMORY_SCOPE_AGENT); }
__device__ __forceinline__ unsigned xb_xcc_id() { return (unsigned)__builtin_amdgcn_s_getreg((3 << 11) | 20) & 0xFu; }
#define XB_SPIN(cond, bar) do { unsigned _sp = 0; while (cond) { __builtin_amdgcn_s_sleep(1); \
    if ((++_sp & 255u) == 0u) { if (xb_ld(&(bar)[XB_TMO])) break; if (_sp > XB_SPIN_CAP) { atomicAdd(&(bar)[XB_TMO], 1u); break; } } } } while (0)
struct XcdBarrier { unsigned* bar; unsigned x; volatile LAS unsigned* st; };
__device__ __forceinline__ XcdBarrier xcd_barrier_post(unsigned* bar, volatile LAS unsigned* st) {
    XcdBarrier b; b.bar = bar; b.x = xb_xcc_id(); b.st = st;
    if (threadIdx.x == 0) (void)xb_add(&bar[XB_XCNT(b.x)], 1u);
    return b;
}
__device__ __forceinline__ void xcd_barrier_complete(unsigned* bar, unsigned x, unsigned& nloc, unsigned& nx) {
    const unsigned G = gridDim.x * gridDim.y * gridDim.z;
    unsigned sum, cnt, mine, sp = 0u;
    for (;;) {
        sum = 0u; cnt = 0u; mine = 0u;
#pragma unroll
        for (unsigned j = 0; j < 16; ++j) { const unsigned c = xb_ld(&bar[XB_XCNT(j)]); sum += c; cnt += (c > 0u) ? 1u : 0u; mine = (j == x) ? c : mine; }
        if (sum == G) break;
        __builtin_amdgcn_s_sleep(1);
        if ((++sp & 255u) == 0u) { if (xb_ld(&bar[XB_TMO])) break; if (sp > XB_SPIN_CAP) { atomicAdd(&bar[XB_TMO], 1u); break; } }
    }
    nloc = mine > 0u ? mine : 1u; nx = cnt > 0u ? cnt : 1u;
}
__device__ __forceinline__ void xcd_barrier_core(const XcdBarrier& b) {
    {
        unsigned* bar = b.bar;
        __builtin_amdgcn_s_waitcnt(0);
        unsigned nloc = b.st[0], nx = b.st[1];
        if (nloc == 0u) { xcd_barrier_complete(bar, b.x, nloc, nx); b.st[0] = nloc; b.st[1] = nx; }
        const unsigned old = xb_add(&bar[XB_XSUB(b.x)], 1u);
        const unsigned gen = old / nloc;
        if (old + 1u == (gen + 1u) * nloc) {
            __builtin_amdgcn_fence(__ATOMIC_RELEASE, "agent");
            asm volatile("s_waitcnt vmcnt(0)" ::: "memory");
            const unsigned og = xb_add(&bar[XB_TOP], 1u);
            const unsigned tg = og / nx, target = (tg + 1u) * nx;
            if (og + 1u != target) XB_SPIN(xb_ld(&bar[XB_TOP]) < target, bar);
            __builtin_amdgcn_fence(__ATOMIC_ACQUIRE, "agent");
            asm volatile("s_waitcnt vmcnt(0)" ::: "memory");
        } else {
            const unsigned target = (gen + 1u) * nx;
            XB_SPIN(xb_ld(&bar[XB_TOP]) < target, bar);
            __builtin_amdgcn_fence(__ATOMIC_ACQUIRE, "agent");
            asm volatile("s_waitcnt vmcnt(0)" ::: "memory");
        }
    }
}
__device__ __forceinline__ void xcd_barrier(const XcdBarrier& b) {
    asm volatile("s_waitcnt vmcnt(0)" ::: "memory");
    __syncthreads();
    if (threadIdx.x == 0) xcd_barrier_core(b);
    __syncthreads();
}

namespace pg8 {
template <class E, class = void> struct split_of { static constexpr bool v = false; };
template <class E> struct split_of<E, decltype((void)E::SPLIT)> { static constexpr bool v = E::SPLIT; };
template <class E, class = void> struct acc0_of { static constexpr float v = 0.f; };
template <class E> struct acc0_of<E, decltype((void)E::ACC0)> { static constexpr float v = E::ACC0; };
constexpr int BM = 256, BK = 64, HALF = 128, HTB = HALF * BK * 2, STAGE_BYTES = 8 * HTB, NXCD = 8, WGM = 8;
__host__ __device__ __forceinline__ int lds_byte(int r, int c) { const int st = (r >> 4) * 2 + (c >> 5), rr = r & 15, cc = c & 31, ob = rr * 64 + cc * 2; return st * 1024 + (ob ^ (((ob >> 9) & 1) << 5)); }
__host__ __device__ __forceinline__ void stage_rc(int b, int& R, int& C) { const int st = b / 1024, sb = b % 1024, swz = sb ^ (((sb >> 9) & 1) << 5); R = (st >> 1) * 16 + swz / 64; C = (st & 1) * 32 + (swz % 64) / 2; }
__host__ __device__ __forceinline__ int perm32(int rho) { const int n = rho >> 4, i = rho & 15; return 8 * (i >> 2) + 4 * n + (i & 3); }

struct Unit { const char* a; const char* b; int row0, pn, aux, nt; };

__device__ __forceinline__ void tile_of(int L, int nM, int nN, int& pm, int& pn) {
    const int nwg = nM * nN; int wgid = L;
    { const int q = nwg / NXCD, r = nwg % NXCD, xcd = wgid % NXCD, off = wgid / NXCD; wgid = (xcd < r ? xcd * (q + 1) : r * (q + 1) + (xcd - r) * q) + off; }
    const int nig = WGM * nN, gid = wgid / nig, fm = gid * WGM, gsz = (nM - fm) < WGM ? (nM - fm) : WGM;
    pm = fm + ((wgid % nig) % gsz); pn = (wgid % nig) / gsz;
}

template <class Epi, class Sched, bool FP8 = false, bool GATHER = false, bool HALFN = false>
__device__ __forceinline__ void gemm_phase(LAS unsigned char* lds, const int tid, const int lda, const int ldb, const Sched& S, const Epi& E, const GAS int* gidx = nullptr, const char* gbaseA = nullptr) {
    const int wid = __builtin_amdgcn_readfirstlane(tid >> 6), lane = tid & 63, wr = wid >> 2, wc = wid & 3, fr = lane & 15, fq = lane >> 4;
    unsigned voffA[2], voffB[2]; unsigned gC = 0; int gR0 = 0;
#pragma unroll
    for (int i = 0; i < 2; ++i) { int R, C; stage_rc(tid * 16 + i * 8192, R, C); const int Rb = Epi::PERM ? ((R & ~31) + perm32(R & 31)) : R;
        voffA[i] = (unsigned)(R * lda + C * 2); voffB[i] = (unsigned)(Rb * ldb + C * 2); if (i == 0) { gR0 = R; gC = (unsigned)(C * 2); } }
    LAS unsigned* gtab = (LAS unsigned*)(lds + STAGE_BYTES);
    const size_t kstep = (size_t)(BK * 2);
    const size_t hstepA = (size_t)HALF * lda, hstepB = (size_t)HALF * ldb;
    const unsigned ldsw = (unsigned)wid * 1024u;
    const int aoff = lds_byte(wr * 64 + fr, fq * 8), boff = lds_byte(wc * 32 + fr, fq * 8);
    unsigned voffG[2] = {0u, 0u}; const char* gatesb = nullptr;
    if constexpr (HALFN && Epi::NSEG > 1) { gatesb = (const char*)E.gates;
#pragma unroll
        for (int i = 0; i < 2; ++i) { const int q = (i * 512 + tid) * 16; voffG[i] = (unsigned)((q >> 7) * 3072 + (q & 127)); } }
#define PG8_GPF(c, h) (gatesb + (size_t)(cur.row0 + 128 * (h)) * 3072 + (((c) >= 4) + ((c) >= 12)) * 1024 + cur.pn * 128)
#define PG8_STAGE_B1(bufoff, gaddr, c, h) do { if constexpr (HALFN && Epi::NSEG > 1) { PG8_STAGE(bufoff, PG8_GPF(c, h), voffG); } else { PG8_STAGE(bufoff, gaddr, voffB); } } while (0)
#define PG8_SA(b, h) (((b) * 2 + (h)) * HTB)
#define PG8_SB(b, h) ((4 + (b) * 2 + (h)) * HTB)
#define PG8_STAGE(bufoff, gbase, voff) do { _Pragma("unroll") for (int _i = 0; _i < 2; ++_i) \
        __builtin_amdgcn_global_load_lds((const unsigned*)((const char*)(gbase) + (voff)[_i]), (LAS unsigned*)(lds + (bufoff) + ldsw + _i * 8192), 16, 0, 0); } while (0)
#define PG8_LD8(p, koff) __builtin_shufflevector(*(const LAS i32x4*)(p), *(const LAS i32x4*)((p) + (koff)), 0, 1, 2, 3, 4, 5, 6, 7)
#define PG8_LDA(dst, b, h) do { _Pragma("unroll") for (int m = 0; m < 4; ++m) dst[m] = PG8_LD8(lds + PG8_SA(b, h) + aoff + m * 2048, 1024); } while (0)
#define PG8_LDB(dst, b, h) do { _Pragma("unroll") for (int n = 0; n < 2; ++n) dst[n] = PG8_LD8(lds + PG8_SB(b, h) + boff + n * 2048, 1024); } while (0)
#define PG8_LO(x) __builtin_bit_cast(bf16x8, __builtin_shufflevector((x), (x), 0, 1, 2, 3))
#define PG8_HI(x) __builtin_bit_cast(bf16x8, __builtin_shufflevector((x), (x), 4, 5, 6, 7))
#define PG8_MMA(ai, bj, At, Bt) do { if constexpr (FP8) { asm volatile("s_setprio 1"); _Pragma("unroll") for (int m = 0; m < 4; ++m) _Pragma("unroll") for (int n = 0; n < 2; ++n) \
        asm volatile("v_mfma_scale_f32_16x16x128_f8f6f4 %0, %1, %2, %0, %3, %4 op_sel_hi:[0,0,0]" : "+v"(acc[ai][bj][m][n]) : "v"(Bt[n]), "v"(At[m]), "v"(mscale), "v"(mscale2)); asm volatile("s_setprio 0"); } else { \
        asm volatile("s_setprio 1");   \
        _Pragma("unroll") for (int m = 0; m < 4; ++m) _Pragma("unroll") for (int n = 0; n < 2; ++n) asm volatile("v_mfma_f32_16x16x32_bf16 %0, %1, %2, %0" : "+v"(acc[ai][bj][m][n]) : "v"(PG8_LO(Bt[n])), "v"(PG8_LO(At[m]))); \
        _Pragma("unroll") for (int m = 0; m < 4; ++m) _Pragma("unroll") for (int n = 0; n < 2; ++n) asm volatile("v_mfma_f32_16x16x32_bf16 %0, %1, %2, %0" : "+v"(acc[ai][bj][m][n]) : "v"(PG8_HI(Bt[n])), "v"(PG8_HI(At[m]))); \
        asm volatile("s_setprio 0"); } } while (0)
#define PG8_MMAZ(ai, bj, At, Bt) do { if constexpr (FP8) { asm volatile("s_setprio 1"); _Pragma("unroll") for (int m = 0; m < 4; ++m) _Pragma("unroll") for (int n = 0; n < 2; ++n) \
        asm volatile("v_mfma_scale_f32_16x16x128_f8f6f4 %0, %1, %2, 0, %3, %4 op_sel_hi:[0,0,0]" : "=&v"(acc[ai][bj][m][n]) : "v"(Bt[n]), "v"(At[m]), "v"(mscale), "v"(mscale2)); asm volatile("s_setprio 0"); } else { \
        asm volatile("s_setprio 1"); \
        _Pragma("unroll") for (int m = 0; m < 4; ++m) _Pragma("unroll") for (int n = 0; n < 2; ++n) asm volatile("v_mfma_f32_16x16x32_bf16 %0, %1, %2, 0" : "=&v"(acc[ai][bj][m][n]) : "v"(PG8_LO(Bt[n])), "v"(PG8_LO(At[m]))); \
        _Pragma("unroll") for (int m = 0; m < 4; ++m) _Pragma("unroll") for (int n = 0; n < 2; ++n) asm volatile("v_mfma_f32_16x16x32_bf16 %0, %1, %2, %0" : "+v"(acc[ai][bj][m][n]) : "v"(PG8_HI(Bt[n])), "v"(PG8_HI(At[m]))); \
        asm volatile("s_setprio 0"); } } while (0)
#define PG8_WAIT_V(n) asm volatile("s_waitcnt vmcnt(" #n ")" ::: "memory")
#define PG8_WAIT_L(n) asm volatile("s_waitcnt lgkmcnt(" #n ")" ::: "memory")
#define PG8_BAR __builtin_amdgcn_s_barrier()
#define PG8_SCHED __builtin_amdgcn_sched_barrier(0)
    Unit cur, nxt; int ui = 0;
    constexpr bool ZINIT = (Epi::NSEG == 1) && (acc0_of<Epi>::v == 0.f);
    if (!S.next(0, cur)) return;
    f32x4 acc[2][2][4][2];
    if constexpr (!ZINIT) {
#pragma unroll
    for (int a = 0; a < 2; ++a)
#pragma unroll
        for (int b = 0; b < 2; ++b)
#pragma unroll
            for (int m = 0; m < 4; ++m)
#pragma unroll
                for (int n = 0; n < 2; ++n) acc[a][b][m][n] = (f32x4){acc0_of<Epi>::v, acc0_of<Epi>::v, acc0_of<Epi>::v, acc0_of<Epi>::v}; }
    i32x8 At[4], B0[2], B1[2];
    int mscale = 0x7f7f7f7f, mscale2 = 0x7f7f7f7f;
    if constexpr (FP8) mscale2 = Epi::MSCALE;
    asm volatile("" : "+v"(mscale), "+v"(mscale2)); (void)mscale; (void)mscale2;
    f32x4 tot[2][4][2];
    if constexpr (Epi::NSEG > 1) {
#pragma unroll
        for (int a = 0; a < 2; ++a)
#pragma unroll
            for (int m = 0; m < 4; ++m)
#pragma unroll
                for (int n = 0; n < 2; ++n) tot[a][m][n] = (f32x4){0.f, 0.f, 0.f, 0.f}; }
    const char* cA = GATHER ? gbaseA : cur.a; const char* cB = cur.b;
    int gpar = 0;
    if constexpr (GATHER) { gtab[tid & 255] = (unsigned)gidx[cur.row0 + (tid & 255)]; __syncthreads(); }
#define PG8_STAGE_A(bufoff, h, ko, nx) do { if constexpr (GATHER) { const LAS unsigned* _t = gtab + (((nx) ? (gpar ^ 1) : gpar) * 256) + (h) * HALF + gR0; const unsigned _b = (unsigned)((((nx) ? nxt.row0 : cur.row0) >> 13) * SEQ); \
        unsigned _vo[2]; _vo[0] = (_t[0] + _b) * (unsigned)lda + gC; _vo[1] = (_t[64] + _b) * (unsigned)lda + gC; PG8_STAGE(bufoff, gbaseA + (ko), _vo); } \
        else { PG8_STAGE(bufoff, ((nx) ? nA : cA) + (h) * hstepA + (ko), voffA); } } while (0)
    const char* nA = cA;
    PG8_STAGE(PG8_SB(0, 0), cB, voffB); PG8_STAGE_B1(PG8_SB(0, 1), cB + hstepB, 0, 0); PG8_STAGE_A(PG8_SA(0, 0), 0, (size_t)0, false); PG8_STAGE_A(PG8_SA(0, 1), 1, (size_t)0, false);
    if (wr == 1) PG8_BAR;
    PG8_WAIT_V(2); PG8_BAR;
    PG8_STAGE(PG8_SB(1, 0), cB + kstep, voffB); PG8_STAGE_A(PG8_SA(1, 0), 0, kstep, false); PG8_STAGE_B1(PG8_SB(1, 1), cB + hstepB + kstep, 0, 1);
    PG8_WAIT_V(6); PG8_BAR;
#define PG8_ITER(MM, HOOKA, HOOKB) do { const bool last = (t == nt - 2); \
            const size_t k1 = (size_t)(t + 1) * kstep, k2 = last ? (size_t)0 : (size_t)(t + 2) * kstep, k3 = k2 + kstep; \
            const char* b2 = last ? nB : cB + (size_t)(t + 2) * kstep; const char* b3 = b2 + kstep; \
            PG8_LDB(B0, 0, 0); if constexpr (!HALFN) PG8_LDB(B1, 0, 1); PG8_SCHED; PG8_LDA(At, 0, 0); PG8_STAGE_A(PG8_SA(1, 1), 1, k1, false); \
            PG8_WAIT_V(8); PG8_WAIT_L(0); PG8_BAR; MM(0, 0, At, B0); if constexpr (!HALFN) MM(0, 1, At, B1); PG8_BAR; PG8_SCHED; \
            PG8_LDA(At, 0, 1); PG8_STAGE(PG8_SB(0, 0), b2, voffB); PG8_STAGE_B1(PG8_SB(0, 1), b2 + hstepB, t, 0); PG8_STAGE_A(PG8_SA(0, 0), 0, k2, last); \
            PG8_WAIT_V(8); PG8_WAIT_L(0); PG8_BAR; MM(1, 0, At, B0); if constexpr (!HALFN) MM(1, 1, At, B1); PG8_BAR; PG8_SCHED; \
            PG8_LDB(B0, 1, 0); if constexpr (!HALFN) PG8_LDB(B1, 1, 1); PG8_SCHED; PG8_LDA(At, 1, 0); PG8_STAGE_A(PG8_SA(0, 1), 1, k2, last); \
            PG8_WAIT_V(8); PG8_WAIT_L(0); PG8_BAR; PG8_MMA(0, 0, At, B0); if constexpr (!HALFN) PG8_MMA(0, 1, At, B1); PG8_BAR; PG8_SCHED; \
            PG8_LDA(At, 1, 1); PG8_STAGE(PG8_SB(1, 0), b3, voffB); PG8_STAGE_B1(PG8_SB(1, 1), b3 + hstepB, t, 1); PG8_STAGE_A(PG8_SA(1, 0), 0, k3, last); HOOKA; \
            PG8_WAIT_V(8); PG8_WAIT_L(0); PG8_BAR; HOOKB; PG8_MMA(1, 0, At, B0); if constexpr (!HALFN) PG8_MMA(1, 1, At, B1); PG8_BAR; PG8_SCHED; } while (0)
    for (;;) {
        const bool has_next = S.next(ui + 1, nxt);
        nA = GATHER ? cA : (has_next ? nxt.a : cA); const char* nB = has_next ? nxt.b : cB;
        if constexpr (GATHER) { if (!has_next) nxt = cur;
            if (wid < 4) __builtin_amdgcn_global_load_lds((const unsigned*)(gidx + nxt.row0 + wid * 64 + lane), (LAS unsigned*)(gtab + (gpar ^ 1) * 256 + wid * 64), 4, 0, 0); }
        const int nt = cur.nt;
        int t = 0;
#pragma unroll 1
        for (int sg = 0; sg < Epi::NSEG; ++sg) {
        int tend = nt; if constexpr (Epi::NSEG > 1) tend = Epi::seg_end(sg);
        if constexpr (ZINIT) { PG8_ITER(PG8_MMAZ, , ); t = 2; }
        if constexpr (split_of<Epi>::v) {
#pragma unroll 1
            for (; t < tend - 2; t += 2) { PG8_ITER(PG8_MMA, , ); }
            u32x2 oh[4];
            PG8_ITER(PG8_MMA, { asm volatile("s_nop 15\n\ts_nop 7" ::: "memory"); E.half0_compute(acc, oh); __builtin_amdgcn_sched_barrier(0); }, E.half0_store(oh, cur, wr, wc, fr, fq)); t += 2;
        } else {
#pragma unroll 1
        for (; t < tend; t += 2) {
            PG8_ITER(PG8_MMA, , );
        }
        }
        if constexpr (Epi::NSEG > 1) { asm volatile("s_nop 15\n\ts_nop 15" ::: "memory"); if (sg + 1 < Epi::NSEG) E.mid(acc, tot, lds + PG8_SB(0, 1), lds + PG8_SB(1, 1), cur, sg, wr, wc, fr, fq); }
        }
        asm volatile("s_nop 15\n\ts_nop 15" ::: "memory");
        if (wr == 0) PG8_BAR;
        if constexpr (Epi::NSEG > 1) E.fin(acc, tot, lds + PG8_SB(0, 1), lds + PG8_SB(1, 1), cur, wr, wc, fr, fq); else if constexpr (split_of<Epi>::v) E.half1(acc, cur, wr, wc, fr, fq); else E(acc, cur, wr, wc, fr, fq);
        if (!has_next) break;
        if constexpr (!ZINIT) {
#pragma unroll
        for (int a = 0; a < 2; ++a)
#pragma unroll
            for (int b = 0; b < 2; ++b)
#pragma unroll
                for (int m = 0; m < 4; ++m)
#pragma unroll
                    for (int n = 0; n < 2; ++n) acc[a][b][m][n] = (f32x4){acc0_of<Epi>::v, acc0_of<Epi>::v, acc0_of<Epi>::v, acc0_of<Epi>::v}; }
        cur = nxt; cA = nA; cB = nB; ++ui;
        if constexpr (GATHER) gpar ^= 1;
        if (wr == 1) PG8_BAR;
    }
    PG8_WAIT_V(0);
    PG8_BAR;
#undef PG8_SA
#undef PG8_GPF
#undef PG8_STAGE_B1
#undef PG8_SB
#undef PG8_STAGE
#undef PG8_STAGE_A
#undef PG8_LD8
#undef PG8_LO
#undef PG8_HI
#undef PG8_LDA
#undef PG8_LDB
#undef PG8_MMA
#undef PG8_MMAZ
#undef PG8_ITER
#undef PG8_WAIT_V
#undef PG8_WAIT_L
#undef PG8_BAR
#undef PG8_SCHED
}
}
using pg8::Unit;

struct Args { const float* in[32]; float* out; unsigned char* ws; int ph_lo, ph_hi, li, flags; };
struct Ctx {
    unsigned long long karg; float* out; unsigned char* ws; LAS unsigned char* lds; int tid, lane, wave, G, bid;
    template <class Tp> __device__ __forceinline__ GAS Tp* W(size_t off) const { return (GAS Tp*)(ws + off); }
    template <int I> __device__ __forceinline__ const GAS float* inp() const { const float* p; asm volatile("s_load_dwordx2 %0, %1, %2\n\ts_waitcnt lgkmcnt(0)" : "=s"(p) : "s"(karg), "n"(I * 8) : "memory"); return (const GAS float*)p; }
};

__device__ __forceinline__ Ctx fresh(const Ctx& C0) {
    Ctx R = C0; asm volatile("" : "+s"(R.ws), "+s"(R.karg), "+s"(R.out));
    int ln; asm volatile("v_mbcnt_lo_u32_b32 %0, -1, 0\n\tv_mbcnt_hi_u32_b32 %0, -1, %0" : "=v"(ln));
    int t = (C0.wave << 6) | ln, b = C0.bid, g = C0.G; asm volatile("" : "+v"(t), "+s"(b), "+s"(g));
    R.out = (float*)(GAS float*)R.out; R.tid = t; R.lane = t & 63; R.wave = __builtin_amdgcn_readfirstlane(t >> 6); R.bid = b; R.G = g; return R;
}

struct SchedGrid {
    const char* A; const char* B; int nM, nN, lda, ldb, G, c, nt; int i0 = 0, i1 = 1 << 30; int pn0 = 0;
    __device__ __forceinline__ bool next(int i, Unit& u) const {
        i += i0; if (i >= i1) return false;
        const long L = (long)i * G + c; if (L >= (long)nM * nN) return false;
        int pm, pn; pg8::tile_of((int)L, nM, nN, pm, pn);
        u.a = A + (size_t)pm * 256 * lda; u.b = B + (size_t)pn * 256 * ldb; u.row0 = pm * 256; u.pn = pn + pn0; u.aux = 0; u.nt = nt; return true;
    }
};
struct SchedUp {
    const char* A; const char* B; int G, c;
    __device__ __forceinline__ bool next(int i, Unit& u) const {
        const long L = (long)i * G + c; if (L >= (long)(T / 256) * 8) return false;
        int pm, pn; pg8::tile_of((int)L, T / 256, 8, pm, pn);
        u.a = A + (size_t)pm * 256 * (D * 2); u.b = B + (size_t)pn * 128 * (D * 2); u.row0 = pm * 256; u.pn = pn; u.aux = 0; u.nt = 16; return true;
    }
};
struct SchedS5 {
    const char* A; const char* B; int nrt, nct, nunits, bstride_g  , ldb, nt, G, c; int ctrows = 256;
    __device__ __forceinline__ bool next(int i, Unit& u) const {
        const int L = i * G + c; if (L >= nunits) return false;
        const int per = nrt * nct, g = L / per, r = L % per, rt = r / nct, ct = r % nct;
        u.a = A + ((size_t)g * S5ROWS + rt * 256) * (UXP * 2); u.b = B + (size_t)g * bstride_g + (size_t)ct * ctrows * ldb; u.row0 = rt * 256; u.pn = ct; u.aux = g; u.nt = nt; return true;
    }
};
struct SchedFfn {
    const char* A; const char* B; int nN, lda, ldb, nt, G, c; size_t bstride_e;
    __device__ __forceinline__ bool next(int i, Unit& u) const {
        const long L = (long)i * G + c; if (L >= (long)256 * nN) return false;
        int vm, pn; pg8::tile_of((int)L, 256, nN, vm, pn);
        const int e = vm >> 4, rt = vm & 15, b = rt >> 1, half = rt & 1, row0 = (b * 16 + e) * 512 + half * 256;
        u.a = A + (size_t)row0 * lda; u.b = B + (size_t)e * bstride_e + (size_t)pn * 256 * ldb; u.row0 = row0; u.pn = pn; u.aux = e; u.nt = nt; return true;
    }
};

#define EPI_ROW(ai, m) (u.row0 + (ai) * 128 + wr * 64 + (m) * 16 + fr)
#define EPI_FENCE() asm volatile("" ::: "memory")
struct EpiInProj {
    static constexpr bool PERM = true; static constexpr int NSEG = 1;
    const GAS float* ss1; GAS bf16* ux; GAS bf16* xb; GAS bf16* qkvs; GAS float* alr; GAS bf16* gates; float accscale;
    __device__ __forceinline__ void operator()(const f32x4 (&acc)[2][2][4][2], const Unit& u, int wr, int wc, int fr, int fq) const {
        const int pn = u.pn;
        float rsv[2][4];
#pragma unroll
        for (int ai = 0; ai < 2; ++ai)
#pragma unroll
            for (int m = 0; m < 4; ++m) rsv[ai][m] = ss1[EPI_ROW(ai, m)];
#pragma unroll
        for (int ai = 0; ai < 2; ++ai)
#pragma unroll
            for (int m = 0; m < 4; ++m) rsv[ai][m] = __builtin_amdgcn_rsqf(rsv[ai][m] * (1.f / D) + EPS) * accscale;
        if (pn == 7) {
            if (wc == 0) {
#pragma unroll
                for (int ai = 0; ai < 2; ++ai)
#pragma unroll
                    for (int m = 0; m < 4; ++m) { const int row = EPI_ROW(ai, m); const float rs = rsv[ai][m]; const f32x4 a = acc[ai][0][m][0] * rs, b = acc[ai][0][m][1] * rs;
                        *(GAS f32x4*)(alr + (size_t)row * 32 + 8 * fq) = a; *(GAS f32x4*)(alr + (size_t)row * 32 + 8 * fq + 4) = b; }
            }
            return;
        }
        GAS bf16* base; int rstride = 0, mode = 0; const bool s5 = (pn == 0);
        if (pn == 0) base = ux; else if (pn <= 2) { base = xb + (pn - 1) * 256; rstride = 512; } else if (pn <= 6) { base = qkvs + (size_t)(pn - 3) * T * 256; rstride = 256; mode = (pn == 6) ? 1 : 0; } else { base = gates + (pn - 8) * 256; rstride = 3072; mode = 2; }
#pragma unroll
        for (int ai = 0; ai < 2; ++ai)
#pragma unroll
            for (int m = 0; m < 4; ++m) { const int row = EPI_ROW(ai, m); const float rs = rsv[ai][m];
                const size_t roff = s5 ? (size_t)(row >> 5) * UXP + (row & 31) * 16 : (size_t)row * rstride;
#pragma unroll
                for (int bj = 0; bj < 2; ++bj) {
                    const int c = bj * 128 + wc * 32 + 8 * fq; const size_t coff = s5 ? (size_t)(c >> 4) * S5ROWS * UXP + (c & 15) : (size_t)c;
                    float vv[8];
#pragma unroll
                    for (int j = 0; j < 4; ++j) { vv[j] = acc[ai][bj][m][0][j] * rs; vv[4 + j] = acc[ai][bj][m][1][j] * rs; }
                    if (mode != 0) {
#pragma unroll
                        for (int j = 0; j < 8; ++j) { const float sg = sigmoid_(vv[j]); vv[j] = (mode == 1) ? vv[j] * sg : sg; } }
                    *(GAS u32x4*)(base + roff + coff) = pack8(vv);
                }
                EPI_FENCE(); }
    }
};
struct EpiGates {
    static constexpr bool PERM = true; static constexpr int NSEG = 1; static constexpr int MSCALE = 0x73737373;
    static_assert(SA8 * SW8 == 4096.f, "MSCALE = 2^-12");
    GAS unsigned char* gates;
    __device__ __forceinline__ void operator()(const f32x4 (&acc)[2][2][4][2], const Unit& u, int wr, int wc, int fr, int fq) const {
#pragma unroll
        for (int ai = 0; ai < 2; ++ai)
#pragma unroll
            for (int m = 0; m < 4; ++m) { const int row = EPI_ROW(ai, m);
#pragma unroll
                for (int bj = 0; bj < 2; ++bj) { unsigned lo = 0u, hi = 0u;
#pragma unroll
                    for (int j = 0; j < 4; ++j) {
                        lo = __builtin_amdgcn_cvt_pk_u8_f32(rcpf_(__builtin_fmaf(__builtin_amdgcn_exp2f(-acc[ai][bj][m][0][j]), 1.f / 255.f, 1.f / 255.f)), j, lo);
                        hi = __builtin_amdgcn_cvt_pk_u8_f32(rcpf_(__builtin_fmaf(__builtin_amdgcn_exp2f(-acc[ai][bj][m][1][j]), 1.f / 255.f, 1.f / 255.f)), j, hi); }
                    *(GAS u32x2*)(gates + (size_t)row * 3072 + (u.pn - 8) * 256 + bj * 128 + wc * 32 + 8 * fq) = (u32x2){lo, hi}; }
                EPI_FENCE(); }
    }
};
struct EpiXloc {
    static constexpr bool PERM = false; static constexpr int NSEG = 1;
    GAS float* xloc;
    __device__ __forceinline__ void operator()(const f32x4 (&acc)[2][2][4][2], const Unit& u, int wr, int wc, int fr, int fq) const {
#pragma unroll
        for (int ai = 0; ai < 2; ++ai)
#pragma unroll
            for (int m = 0; m < 4; ++m) { const int row = EPI_ROW(ai, m);
                GAS float* rowp = xloc + ((size_t)u.aux * S5ROWS + row) * 256 + wc * 32 + 4 * fq;
#pragma unroll
                for (int bj = 0; bj < 2; ++bj)
#pragma unroll
                    for (int n = 0; n < 2; ++n) *(GAS f32x4*)(rowp + bj * 128 + n * 16) = acc[ai][bj][m][n];
                EPI_FENCE(); }
    }
};
struct EpiXlocH {
    static constexpr bool PERM = false; static constexpr int NSEG = 1;
    GAS float* xloc;
    __device__ __forceinline__ void operator()(const f32x4 (&acc)[2][2][4][2], const Unit& u, int wr, int wc, int fr, int fq) const {
#pragma unroll
        for (int ai = 0; ai < 2; ++ai)
#pragma unroll
            for (int m = 0; m < 4; ++m) { const int row = EPI_ROW(ai, m);
                GAS float* rowp = xloc + ((size_t)u.aux * S5ROWS + row) * 256 + u.pn * 128 + wc * 32 + 4 * fq;
#pragma unroll
                for (int n = 0; n < 2; ++n) *(GAS f32x4*)(rowp + n * 16) = acc[ai][0][m][n];
                EPI_FENCE(); }
    }
};
struct EpiS5Out {
    static constexpr bool PERM = true; static constexpr int NSEG = 1;
    GAS bf16* z;
    __device__ __forceinline__ void operator()(const f32x4 (&acc)[2][2][4][2], const Unit& u, int wr, int wc, int fr, int fq) const {
#pragma unroll
        for (int ai = 0; ai < 2; ++ai)
#pragma unroll
            for (int m = 0; m < 4; ++m) { const int row = EPI_ROW(ai, m);
#pragma unroll
                for (int bj = 0; bj < 2; ++bj) {
                    const int c = u.pn * 256 + bj * 128 + wc * 32 + 8 * fq, jj = c >> 4, h0 = c & 15;
                    float vv[8];
#pragma unroll
                    for (int j = 0; j < 4; ++j) { vv[j] = gelu_tanh_(acc[ai][bj][m][0][j]); vv[4 + j] = gelu_tanh_(acc[ai][bj][m][1][j]); }
                    *(GAS u32x4*)(z + ((size_t)row * S5L + jj) * 256 + u.aux * 16 + h0) = pack8(vv);
                }
                EPI_FENCE(); }
    }
};
struct EpiGlu {
    static constexpr bool PERM = true; static constexpr int NSEG = 1;
    const GAS bf16* z; GAS bf16* ycat;
    __device__ __forceinline__ void operator()(const f32x4 (&acc)[2][2][4][2], const Unit& u, int wr, int wc, int fr, int fq) const {
#pragma unroll
        for (int ai = 0; ai < 2; ++ai) {
            u32x4 ld[4][2];
#pragma unroll
            for (int m = 0; m < 4; ++m)
#pragma unroll
                for (int bj = 0; bj < 2; ++bj) ld[m][bj] = *(const GAS u32x4*)(z + (size_t)EPI_ROW(ai, m) * 256 + bj * 128 + wc * 32 + 8 * fq);
#pragma unroll
            for (int m = 0; m < 4; ++m)
#pragma unroll
                for (int bj = 0; bj < 2; ++bj) { const int c = bj * 128 + wc * 32 + 8 * fq; float zz[8], vv[8]; unpack8(ld[m][bj], zz);
#pragma unroll
                    for (int j = 0; j < 4; ++j) { vv[j] = zz[j] * sigmoid_(acc[ai][bj][m][0][j]); vv[4 + j] = zz[4 + j] * sigmoid_(acc[ai][bj][m][1][j]); }
                    *(GAS u32x4*)(ycat + (size_t)EPI_ROW(ai, m) * 1024 + c) = pack8(vv); }
            EPI_FENCE(); }
    }
};
struct EpiUp {
    static constexpr bool PERM = true; static constexpr int NSEG = 3;
    static __device__ __forceinline__ int seg_end(int sg) { return sg == 0 ? 4 : (sg == 1 ? 12 : 16); }
    const GAS unsigned char* gates; GAS bf16* merged;
    __device__ __forceinline__ void add(f32x4 (&acc)[2][2][4][2], f32x4 (&tot)[2][4][2], const LAS unsigned char* g0, const LAS unsigned char* g1, int wr, int wc, int fr, int fq) const {
        u32x2 lg[2][4];
#pragma unroll
        for (int ai = 0; ai < 2; ++ai)
#pragma unroll
            for (int m = 0; m < 4; ++m) lg[ai][m] = *(const LAS u32x2*)((ai ? g1 : g0) + (wr * 64 + m * 16 + fr) * 128 + wc * 32 + 8 * fq);
#pragma unroll
        for (int ai = 0; ai < 2; ++ai)
#pragma unroll
            for (int m = 0; m < 4; ++m) { float gg[8];
#pragma unroll
                for (int j = 0; j < 4; ++j) { gg[j] = (float)((lg[ai][m].x >> (8 * j)) & 255u); gg[4 + j] = (float)((lg[ai][m].y >> (8 * j)) & 255u); }
#pragma unroll
                for (int j = 0; j < 4; ++j) { tot[ai][m][0][j] += gg[j] * acc[ai][0][m][0][j]; tot[ai][m][1][j] += gg[4 + j] * acc[ai][0][m][1][j]; }
                acc[ai][0][m][0] = (f32x4){0.f, 0.f, 0.f, 0.f}; acc[ai][0][m][1] = (f32x4){0.f, 0.f, 0.f, 0.f}; }
    }
    __device__ __forceinline__ void mid(f32x4 (&acc)[2][2][4][2], f32x4 (&tot)[2][4][2], const LAS unsigned char* g0, const LAS unsigned char* g1, const Unit& u, int sg, int wr, int wc, int fr, int fq) const { add(acc, tot, g0, g1, wr, wc, fr, fq); }
    __device__ __forceinline__ void fin(f32x4 (&acc)[2][2][4][2], f32x4 (&tot)[2][4][2], const LAS unsigned char* g0, const LAS unsigned char* g1, const Unit& u, int wr, int wc, int fr, int fq) const {
        add(acc, tot, g0, g1, wr, wc, fr, fq);
#pragma unroll
        for (int ai = 0; ai < 2; ++ai)
#pragma unroll
            for (int m = 0; m < 4; ++m) { float vv[8];
#pragma unroll
                for (int j = 0; j < 4; ++j) { vv[j] = tot[ai][m][0][j] * (1.f / 255.f); vv[4 + j] = tot[ai][m][1][j] * (1.f / 255.f); }
                *(GAS u32x4*)(merged + (size_t)EPI_ROW(ai, m) * 1024 + u.pn * 128 + wc * 32 + 8 * fq) = pack8(vv);
                tot[ai][m][0] = (f32x4){0.f, 0.f, 0.f, 0.f}; tot[ai][m][1] = (f32x4){0.f, 0.f, 0.f, 0.f}; }
    }
    __device__ __forceinline__ void operator()(const f32x4 (&)[2][2][4][2], const Unit&, int, int, int, int) const {}
};
struct EpiMix {
    static constexpr bool PERM = true; static constexpr int NSEG = 1;
    const GAS bf16* hb; GAS bf16* hb2;
    __device__ __forceinline__ void operator()(const f32x4 (&acc)[2][2][4][2], const Unit& u, int wr, int wc, int fr, int fq) const {
        u32x4 ldq[2][4][2];
#pragma unroll
        for (int ai = 0; ai < 2; ++ai)
#pragma unroll
            for (int m = 0; m < 4; ++m)
#pragma unroll
                for (int bj = 0; bj < 2; ++bj) ldq[ai][m][bj] = *(const GAS u32x4*)(hb + (size_t)EPI_ROW(ai, m) * 1024 + u.pn * 256 + bj * 128 + wc * 32 + 8 * fq);
#pragma unroll
        for (int ai = 0; ai < 2; ++ai) {
#pragma unroll
            for (int m = 0; m < 4; ++m)
#pragma unroll
                for (int bj = 0; bj < 2; ++bj) { const int c = u.pn * 256 + bj * 128 + wc * 32 + 8 * fq; float hh[8], vv[8]; unpack8(ldq[ai][m][bj], hh);
#pragma unroll
                    for (int j = 0; j < 4; ++j) { vv[j] = hh[j] + acc[ai][bj][m][0][j]; vv[4 + j] = hh[4 + j] + acc[ai][bj][m][1][j]; }
                    *(GAS u32x4*)(hb2 + (size_t)EPI_ROW(ai, m) * 1024 + c) = pack8(vv); }
            EPI_FENCE(); }
    }
};
struct EpiFfn1 {
    static constexpr bool PERM = true; static constexpr int NSEG = 1; static constexpr int MSCALE = 0x73737373;
    static_assert(SA8 * SW8 == 4096.f, "MSCALE = 2^-12");
    GAS unsigned char* hid;
    static constexpr bool SPLIT = true;
    __device__ __forceinline__ u32x2 row(const f32x4 (&acc)[2][2][4][2], int ai, int m) const { float vv[8];
#pragma unroll
        for (int j = 0; j < 4; ++j) { const float a0 = acc[ai][0][m][0][j], a1 = acc[ai][0][m][1][j];
            vv[j] = (a0 * acc[ai][1][m][0][j]) * rcpf_(1.f + __builtin_amdgcn_exp2f(-a0)); vv[4 + j] = (a1 * acc[ai][1][m][1][j]) * rcpf_(1.f + __builtin_amdgcn_exp2f(-a1)); }
        u32x2 o; o.x = pack4_fp8(vv[0], vv[1], vv[2], vv[3]); o.y = pack4_fp8(vv[4], vv[5], vv[6], vv[7]); return o; }
    __device__ __forceinline__ void half0_compute(const f32x4 (&acc)[2][2][4][2], u32x2 (&o)[4]) const {
#pragma unroll
        for (int m = 0; m < 4; ++m) o[m] = row(acc, 0, m); }
    __device__ __forceinline__ void half0_store(const u32x2 (&o)[4], const Unit& u, int wr, int wc, int fr, int fq) const {
#pragma unroll
        for (int m = 0; m < 4; ++m) *(GAS u32x2*)(hid + (size_t)EPI_ROW(0, m) * FF + u.pn * 128 + wc * 32 + 8 * fq) = o[m]; }
    __device__ __forceinline__ void half1(const f32x4 (&acc)[2][2][4][2], const Unit& u, int wr, int wc, int fr, int fq) const {
#pragma unroll
        for (int m = 0; m < 4; ++m) { *(GAS u32x2*)(hid + (size_t)EPI_ROW(1, m) * FF + u.pn * 128 + wc * 32 + 8 * fq) = row(acc, 1, m); EPI_FENCE(); } }
    __device__ __forceinline__ void operator()(const f32x4 (&acc)[2][2][4][2], const Unit& u, int wr, int wc, int fr, int fq) const {
#pragma unroll
        for (int ai = 0; ai < 2; ++ai)
#pragma unroll
            for (int m = 0; m < 4; ++m) { *(GAS u32x2*)(hid + (size_t)EPI_ROW(ai, m) * FF + u.pn * 128 + wc * 32 + 8 * fq) = row(acc, ai, m); EPI_FENCE(); } }
};
struct EpiFfn2 {
    static constexpr bool PERM = true; static constexpr int NSEG = 1; static constexpr int MSCALE = 0x7f7f7f7f;
    const GAS float* gatep; GAS unsigned char* ye;
    __device__ __forceinline__ void operator()(const f32x4 (&acc)[2][2][4][2], const Unit& u, int wr, int wc, int fr, int fq) const {
        float gpv[2][4];
#pragma unroll
        for (int ai = 0; ai < 2; ++ai)
#pragma unroll
            for (int m = 0; m < 4; ++m) gpv[ai][m] = gatep[EPI_ROW(ai, m)];
#pragma unroll
        for (int ai = 0; ai < 2; ++ai)
#pragma unroll
            for (int m = 0; m < 4; ++m) { const int row = EPI_ROW(ai, m); const float gp = gpv[ai][m] * (SY8 / (SH8 * SW8));
#pragma unroll
                for (int bj = 0; bj < 2; ++bj) {
                    const int c = u.pn * 256 + bj * 128 + wc * 32 + 8 * fq;
                    float vv[8];
#pragma unroll
                    for (int j = 0; j < 4; ++j) { vv[j] = gp * acc[ai][bj][m][0][j]; vv[4 + j] = gp * acc[ai][bj][m][1][j]; }
                    u32x2 o; o.x = pack4_fp8(vv[0], vv[1], vv[2], vv[3]); o.y = pack4_fp8(vv[4], vv[5], vv[6], vv[7]);
                    *(GAS u32x2*)(ye + (size_t)row * 1024 + c) = o;
                }
                EPI_FENCE(); }
    }
};

__device__ __forceinline__ void cvt_tile(const bool F8, const GAS float* src, int sp, const GAS float* kscale, float mul, int valid, GAS void* dstv, int dp, LAS float* scr, int lane) {
    const int nn = (lane & 15) * 4, kq = lane >> 4;
    f32x4 v[16]; float ks[16];
    if (kscale) {
#pragma unroll
        for (int i = 0; i < 16; ++i) ks[i] = kscale[i * 4 + kq];
    } else {
#pragma unroll
        for (int i = 0; i < 16; ++i) ks[i] = 1.f;
    }
    if (nn < valid) {
#pragma unroll
        for (int i = 0; i < 16; ++i) v[i] = *(const GAS f32x4*)(src + (size_t)(i * 4 + kq) * sp + nn);
    } else {
#pragma unroll
        for (int i = 0; i < 16; ++i) v[i] = (f32x4){0.f, 0.f, 0.f, 0.f};
    }
#pragma unroll
    for (int i = 0; i < 16; ++i) { const int kk = i * 4 + kq; const float s = ks[i] * mul; LAS float* p = scr + kk * 65 + nn; p[0] = v[i].x * s; p[1] = v[i].y * s; p[2] = v[i].z * s; p[3] = v[i].w * s; }
    LDS_WAIT(); asm volatile("" ::: "memory");
    const int c = lane & 7;
#pragma unroll
    for (int j = 0; j < 8; ++j) { const int n = (lane >> 3) + 8 * j; const LAS float* s = scr + (8 * c) * 65 + n;
        if (F8) { u32x2 o; o.x = pack4_fp8(s[0 * 65], s[1 * 65], s[2 * 65], s[3 * 65]); o.y = pack4_fp8(s[4 * 65], s[5 * 65], s[6 * 65], s[7 * 65]); *(GAS u32x2*)((GAS unsigned char*)dstv + (size_t)n * dp + 8 * c) = o; }
        else { u32x4 o; o.x = cvt_pk_bf16(s[0 * 65], s[1 * 65]); o.y = cvt_pk_bf16(s[2 * 65], s[3 * 65]); o.z = cvt_pk_bf16(s[4 * 65], s[5 * 65]); o.w = cvt_pk_bf16(s[6 * 65], s[7 * 65]);
            *(GAS u32x4*)((GAS bf16*)dstv + (size_t)n * dp + 8 * c) = o; } }
    LDS_WAIT(); asm volatile("" ::: "memory");
}

constexpr int SEAM_CVT_TILES = 7 * 8;
struct W12Item { const GAS float* src; const GAS float* ksc; GAS unsigned char* dst; int sp, dp; float mul; };
__device__ __forceinline__ W12Item w12_item(int r, int l, const GAS float* wg, const GAS float* wu, const GAS float* wd, const GAS float* fng, GAS unsigned char* w1, GAS unsigned char* w2) {
    W12Item I;
    if (r < 16 * 16 * 64) { const int e = r >> 10, kt = (r >> 6) & 15, ntile = r & 63, n0 = ntile * 64, pn = n0 >> 8, rr = n0 & 255;
        I.src = (rr < 128 ? wg : wu) + ((size_t)(l * NE + e) * D + kt * 64) * FF + pn * 128 + (rr & 127); I.sp = FF; I.ksc = fng + l * D + kt * 64; I.dst = w1 + ((size_t)e * 4096 + n0) * D + kt * 64; I.dp = D;
        I.mul = rr < 128 ? 1.4426950408889634f : SH8 / 1.4426950408889634f; }
    else { r -= 16 * 16 * 64; const int e = r >> 9, kt = (r >> 4) & 31, ntile = r & 15;
        I.src = wd + ((size_t)(l * NE + e) * FF + kt * 64) * D + ntile * 64; I.sp = D; I.ksc = nullptr; I.dst = w2 + ((size_t)e * D + ntile * 64) * FF + kt * 64; I.dp = FF; I.mul = 1.f; }
    return I;
}
__device__ __forceinline__ void w12_load(const W12Item& I, int lane, f32x4 (&v)[16]) {
    const int nn = (lane & 15) * 4, kq = lane >> 4;
#pragma unroll
    for (int i = 0; i < 16; ++i) v[i] = *(const GAS f32x4*)(I.src + (size_t)(i * 4 + kq) * I.sp + nn);
}
__device__ __forceinline__ void w12_to_lds(const W12Item& I, int lane, const f32x4 (&v)[16], const float (&ks)[16], LAS float* scr) {
    const int nn = (lane & 15) * 4, kq = lane >> 4; const bool sc = I.ksc != nullptr;
#pragma unroll
    for (int i = 0; i < 16; ++i) { const int kk = i * 4 + kq; const float s = sc ? ks[i] * I.mul : SW8; LAS float* p = scr + kk * 65 + nn; p[0] = v[i].x * s; p[1] = v[i].y * s; p[2] = v[i].z * s; p[3] = v[i].w * s; }
}
__device__ __forceinline__ void w12_store(const W12Item& I, int lane, LAS float* scr, bool nostore) {
    LDS_WAIT(); asm volatile("" ::: "memory");
    const int c = lane & 7;
#pragma unroll
    for (int j = 0; j < 8; ++j) { const int n = (lane >> 3) + 8 * j; const LAS float* s = scr + (8 * c) * 65 + n;
        u32x2 o; o.x = pack4_fp8(s[0 * 65], s[1 * 65], s[2 * 65], s[3 * 65]); o.y = pack4_fp8(s[4 * 65], s[5 * 65], s[6 * 65], s[7 * 65]);
        *(GAS u32x2*)(I.dst + (size_t)n * I.dp + 8 * c) = o; }
    LDS_WAIT(); asm volatile("" ::: "memory");
}
__device__ __forceinline__ void w12_share(int bid, int G, int slot, int& first, int& step, int& cnt) {
    if (G != 256) { first = bid * 8; step = G * 8; cnt = (slot == 0) ? (1 << 30) : 0; return; }
    int start, lo, hi;
    if (bid < 48) { start = bid * 60; lo = 0; hi = (slot == 0) ? 60 : 0; }
    else if (bid < 128) { start = 2880 + (bid - 48) * 92; lo = (slot == 0) ? 0 : 63; hi = (slot == 0) ? 63 : (slot == 1 ? 92 : 63); }
    else { start = 10240 + (bid - 128) * 112; lo = (slot == 0) ? 0 : (slot == 1 ? 61 : (slot == 2 ? 87 : 102)); hi = (slot == 0) ? 61 : (slot == 1 ? 87 : (slot == 2 ? 102 : 112)); }
    first = start + lo; step = 8; cnt = hi - lo;
}
__device__ __forceinline__ void cvt_w12(const Ctx& C, int l, int slot) {
    LAS float* scr = (LAS float*)(C.lds + C.wave * 16640);
    const int lane = C.lane; constexpr int END = 16 * 16 * 64 + 16 * 32 * 16;
    int first, step, cnt; w12_share(C.bid, C.G, slot, first, step, cnt);
    if (C.G == 256 && slot == 0) return;
    const int last = (C.G == 256) ? first + cnt : END;
    int it = first + C.wave; if (cnt <= 0 || it >= last) return;
    const GAS float* wg = C.inp<28>(); const GAS float* wu = C.inp<29>(); const GAS float* wd = C.inp<30>(); const GAS float* fng = C.inp<26>(); GAS unsigned char* w1 = C.W<unsigned char>(WS_W1); GAS unsigned char* w2 = C.W<unsigned char>(WS_W2);
    f32x4 v[16]; float ks[16]; int ks_kt = -1;
    W12Item A = w12_item(it, l, wg, wu, wd, fng, w1, w2); w12_load(A, lane, v);
    for (;;) {
        if (A.ksc) { const int kt = (it >> 6) & 15; if (kt != ks_kt) {
#pragma unroll
            for (int i = 0; i < 16; ++i) ks[i] = A.ksc[i * 4 + (lane >> 4)] * SW8;
            ks_kt = kt; } }
        w12_to_lds(A, lane, v, ks, scr);
        const W12Item Cur = A; const int nx = it + step; const bool more = nx < last;
        if (more) { int ln = lane; asm volatile("" : "+v"(ln)); A = w12_item(nx, l, wg, wu, wd, fng, w1, w2); w12_load(A, ln, v); }
        w12_store(Cur, lane, scr, false);
        if (!more) break;
        it = nx;
    }
}

__device__ __forceinline__ void cvt_w12_seam(const Ctx& C, int l, int k) {
    if (C.G != 256 || C.wave == 0) return;
    int first, step, cnt; w12_share(C.bid, C.G, 0, first, step, cnt);
    const int rem = cnt - SEAM_CVT_TILES;
    if (k == 0 && C.wave - 1 >= rem) return;
    const int it = (k == 0) ? first + (C.wave - 1) : first + rem + 7 * (k - 1) + (C.wave - 1);
    LAS float* scr = (LAS float*)(C.lds + C.wave * 16640); const int lane = C.lane;
    const GAS float* wg = C.inp<28>(); const GAS float* wu = C.inp<29>(); const GAS float* wd = C.inp<30>(); const GAS float* fng = C.inp<26>(); GAS unsigned char* w1 = C.W<unsigned char>(WS_W1); GAS unsigned char* w2 = C.W<unsigned char>(WS_W2);
    f32x4 v[16]; float ks[16];
    const W12Item A = w12_item(it, l, wg, wu, wd, fng, w1, w2); w12_load(A, lane, v);
    if (A.ksc) {
#pragma unroll
        for (int i = 0; i < 16; ++i) ks[i] = A.ksc[i * 4 + (lane >> 4)] * SW8; }
    w12_to_lds(A, lane, v, ks, scr);
    w12_store(A, lane, scr, false);
}
__device__ __forceinline__ void p0_convert(const Ctx& C, int l, int pflags, const bool big) {
    LAS float* scr = (LAS float*)(C.lds + C.wave * 16640);
    const int gw = C.bid * 8 + C.wave, NGW = C.G * 8, lane = C.lane;
    constexpr int I_IN = 16 * 80, I_W1 = 16 * 16 * 64, I_W2 = 16 * 32 * 16, I_UP = 16 * 16, I_MIX = 16 * 16, I_GLU = 4 * 4, I_LRU = 32;
    constexpr int NITEMS = I_IN + I_W1 + I_W2 + I_UP + I_MIX + I_GLU + I_LRU;
    for (int it = (big ? gw : gw + I_W1 + I_W2); it < (big ? I_W1 + I_W2 : NITEMS); it += NGW) {
        int r = it; const GAS float* src; int sp; const GAS float* ksc = nullptr; float mul = 1.f; int valid = 64; GAS bf16* dst = nullptr; int dp; bool f8 = false; GAS unsigned char* dst8 = nullptr;
        if (r < I_W1) {
            const int e = r >> 10, kt = (r >> 6) & 15, ntile = r & 63, n0 = ntile * 64, pn = n0 >> 8, rr = n0 & 255;
            src = (rr < 128 ? C.inp<28>() : C.inp<29>()) + ((size_t)(l * NE + e) * D + kt * 64) * FF + pn * 128 + (rr & 127); sp = FF; ksc = C.inp<26>() + l * D + kt * 64;
            continue; }
        else if ((r -= I_W1) < I_W2) {
            const int e = r >> 9, kt = (r >> 4) & 31, ntile = r & 15;
            continue; }
        else if ((r -= I_W2) < I_IN) {
            const int kt = r / 80, ntile = r % 80, n0 = ntile * 64;
            int sc0; if (n0 < 1792) { sc0 = n0; } else if (n0 == 1792) { sc0 = 1792; valid = 32; } else if (n0 < 2048) { sc0 = 0; valid = 0; } else { sc0 = n0 - 224; }
            mul = (n0 >= 768 && n0 < 1024) ? 0.125f : 1.f;
            src = C.inp<2>() + ((size_t)l * D + kt * 64) * IN_W + sc0; sp = IN_W; ksc = C.inp<1>() + l * D + kt * 64; dst = C.W<bf16>(WS_WIN) + (size_t)n0 * D + kt * 64; dp = D;
            if (n0 >= 2048) { f8 = true; mul = SW8 * 1.4426950408889634f; dst8 = C.W<unsigned char>(WS_WIN8) + (size_t)(n0 - 2048) * D + kt * 64; } }
        else if ((r -= I_IN) < I_UP) {
            const int kt = r >> 4, ntile = r & 15, k0 = kt * 64;
            src = ((k0 < 256) ? C.inp<22>() + ((size_t)l * 256 + k0) * D : (k0 < 768) ? C.inp<23>() + ((size_t)l * 512 + (k0 - 256)) * D : C.inp<24>() + ((size_t)l * 256 + (k0 - 768)) * D) + ntile * 64;
            sp = D; dst = C.W<bf16>(WS_WUP) + (size_t)ntile * 64 * D + k0; dp = D; }
        else if ((r -= I_UP) < I_MIX) { const int kt = r >> 4, ntile = r & 15;
            src = C.inp<25>() + ((size_t)l * D + kt * 64) * D + ntile * 64; sp = D; dst = C.W<bf16>(WS_WMIX) + (size_t)ntile * 64 * D + kt * 64; dp = D; }
        else if ((r -= I_MIX) < I_GLU) { const int kt = r >> 2, ntile = r & 3;
            src = C.inp<11>() + ((size_t)l * 256 + kt * 64) * 256 + ntile * 64; sp = 256; dst = C.W<bf16>(WS_WGLU) + (size_t)ntile * 64 * 256 + kt * 64; dp = 256; }
        else { r -= I_GLU;
            const int dir = r >> 4, gate = (r >> 3) & 1, nb = r & 7;
            src = (gate ? C.inp<16>() : C.inp<14>()) + ((size_t)((l * 2 + dir) * 8 + nb)) * 4096; sp = 64; dst = C.W<bf16>(WS_LRUW) + (size_t)((dir * 2 + gate) * 8 + nb) * 4096; dp = 64; }
        cvt_tile(f8, src, sp, ksc, mul, valid, f8 ? (GAS void*)dst8 : (GAS void*)dst, dp, scr, lane);
    }
    if (big) return;
    { const GAS float* plam = C.inp<18>(); for (int i = C.bid * 512 + C.tid; i < 1024; i += C.G * 512) C.W<float>(WS_LRUC8)[i] = 8.f * 1.4426950408889634f * log1pf(expf(-plam[l * 1024 + i])); }
    const GAS float* fng = C.inp<26>(); const GAS float* wrt = C.inp<27>();
    for (int i = C.bid * 512 + C.tid; i < NE * D; i += C.G * 512) { const int e = i >> 10, k = i & 1023;
        const float w = fng[l * D + k] * wrt[((size_t)l * D + k) * NE + e]; const unsigned hi = f2bf(w); const float lo = w - bf2f(hi);
        C.W<bf16>(WS_WRT)[i] = (bf16)hi; C.W<bf16>(WS_WRT)[NE * D + i] = (bf16)f2bf(lo); }
}

__device__ __forceinline__ void s5_tables(const Ctx& C, int l, int g) {
    LAS f32x2* AP = (LAS f32x2*)(C.lds);
    LAS f32x2* BB = (LAS f32x2*)(C.lds + 33792);
    LAS f32x2* CC = (LAS f32x2*)(C.lds + 50176);
    const int tid = C.tid, dp = tid & 127, dir = dp >> 6, p = dp & 63, grp = tid >> 7; const size_t pi = ((size_t)(l * 2 + dir) * 16 + g) * 64 + p;
    const GAS float* plr = C.inp<3>(); const GAS float* pli = C.inp<4>(); const GAS float* pdt = C.inp<5>();
    const float lr = fminf(plr[pi], -1e-4f), li = pli[pi], dt = expf(pdt[(l * 2 + dir) * 16 + g]);
    for (int e = grp; e <= 32; e += 4) { const float mg = __expf((float)e * lr * dt); float sn, cs; __sincosf((float)e * li * dt, &sn, &cs); AP[(dir * 33 + e) * 64 + p] = (f32x2){mg * cs, mg * sn}; }
    { const float mg = __expf(lr * dt); float sn, cs; __sincosf(li * dt, &sn, &cs); const float are = mg * cs, aim = mg * sn, den = lr * lr + li * li;
      const float kre = ((are - 1.f) * lr + aim * li) / den, kim = (aim * lr - (are - 1.f) * li) / den;
      const GAS float* pbre = C.inp<6>(); const GAS float* pbim = C.inp<7>(); const GAS float* pcre = C.inp<8>(); const GAS float* pcim = C.inp<9>();
#pragma unroll
      for (int hh = 0; hh < 4; ++hh) { const int h = grp * 4 + hh; const float bre = pbre[pi * 16 + h], bim = pbim[pi * 16 + h]; BB[(dir * 64 + p) * 16 + h] = (f32x2){kre * bre - kim * bim, kre * bim + kim * bre};
          const size_t ci = (((size_t)(l * 2 + dir) * 16 + g) * 16 + h) * 64 + p; CC[(dir * 16 + h) * 64 + p] = (f32x2){pcre[ci], pcim[ci]}; } }
    __syncthreads();
}
__device__ __forceinline__ void p0_s5_kt(const Ctx& C, int l) {
    GAS float* ktg = C.W<float>(WS_PROBS);
    for (int item = C.bid; item < 256; item += C.G) {
        const int g = item >> 4, part = item & 15;
        __syncthreads(); s5_tables(C, l, g);
        const LAS f32x2* AP = (const LAS f32x2*)(C.lds); const LAS f32x2* BB = (const LAS f32x2*)(C.lds + 33792); const LAS f32x2* CC = (const LAS f32x2*)(C.lds + 50176);
#pragma unroll
        for (int q = 0; q < 2; ++q) { const int en = part * 1024 + q * 512 + C.tid, dir = en >> 13, lag = (en >> 8) & 31, h = (en >> 4) & 15, h2 = en & 15; float s = 0.f;
#pragma unroll 8
            for (int p = 0; p < 64; ++p) { const f32x2 c = CC[(dir * 16 + h) * 64 + p], a = AP[(dir * 33 + lag) * 64 + p], b = BB[(dir * 64 + p) * 16 + h2];
                const float cre = c.x * a.x - c.y * a.y, cim = c.x * a.y + c.y * a.x; s += cre * b.x - cim * b.y; }
            ktg[(size_t)g * 16384 + en] = s; }
    }
    __syncthreads();
}
template <int WHICH>
__device__ __forceinline__ void p1_s5_assemble(const Ctx& C, int l, int bid0, int nblk) {
    const GAS float* ktg = C.W<float>(WS_PROBS); const GAS float* s5d = C.inp<10>();
    for (int item = C.bid - bid0; item < 256; item += nblk) {
        const int g = item >> 4, part = item & 15, tid = C.tid;
        __syncthreads(); s5_tables(C, l, g);
        const LAS f32x2* AP = (const LAS f32x2*)(C.lds); const LAS f32x2* BB = (const LAS f32x2*)(C.lds + 33792); const LAS f32x2* CC = (const LAS f32x2*)(C.lds + 50176);
        LAS float* KT = (LAS float*)(C.lds + 66560);
        for (int i = tid; i < 4096; i += 512) *(LAS f32x4*)(KT + i * 4) = *(const GAS f32x4*)(ktg + (size_t)g * 16384 + i * 4);
        __syncthreads();
        GAS bf16* bt2 = C.W<bf16>(WS_S5BT2) + (size_t)g * 512 * UXP;
        if constexpr (WHICH == 1)
        for (int ch = tid; ch < 32 * 96; ch += 512) {
            const int row = part * 32 + ch / 96, cc = (ch % 96) * 8, t = row >> 4, h = row & 15; float vv[8];
            if (cc < 512) { const int s = cc >> 4, h0 = cc & 15;
#pragma unroll
                for (int j = 0; j < 8; ++j) { const int h2 = h0 + j; float x;
                    if (t > s) x = KT[((0 * 32 + (t - s)) * 16 + h) * 16 + h2]; else if (t < s) x = KT[((1 * 32 + (s - t)) * 16 + h) * 16 + h2];
                    else x = KT[(0 * 16 + h) * 16 + h2] + KT[((32) * 16 + h) * 16 + h2] + (h == h2 ? s5d[l * 256 + g * 16 + h] : 0.f);
                    vv[j] = x; } }
            else { const int sc = cc - 512, dir = sc >> 7, p0 = (sc & 127) >> 1; const int e = dir ? (32 - t) : (t + 1);
#pragma unroll
                for (int j = 0; j < 4; ++j) { const f32x2 c = CC[(dir * 16 + h) * 64 + p0 + j], a = AP[(dir * 33 + e) * 64 + p0 + j];
                    vv[2 * j] = c.x * a.x - c.y * a.y; vv[2 * j + 1] = -(c.x * a.y + c.y * a.x); } }
            *(GAS u32x4*)(bt2 + (size_t)row * UXP + cc) = pack8(vv);
        }
        GAS bf16* mn = C.W<bf16>(WS_S5MIN) + (size_t)g * 256 * 512;
        if constexpr (WHICH == 0)
        for (int ch = tid; ch < 16 * 64; ch += 512) {
            const int row = part * 16 + (ch >> 6), cc = (ch & 63) * 8, dir = row >> 7, p = (row & 127) >> 1, ri = row & 1, s = cc >> 4, h0 = cc & 15, e = dir ? s : (31 - s);
            const f32x2 a = AP[(dir * 33 + e) * 64 + p]; float vv[8];
#pragma unroll
            for (int j = 0; j < 8; ++j) { const f32x2 b = BB[(dir * 64 + p) * 16 + h0 + j]; vv[j] = ri ? (a.x * b.y + a.y * b.x) : (a.x * b.x - a.y * b.y); }
            *(GAS u32x4*)(mn + (size_t)row * 512 + cc) = pack8(vv);
        }
    }
    __syncthreads();
}

__device__ __forceinline__ void p0_x_to_hb(const Ctx& C) {
    const int gw = C.bid * 8 + C.wave, NGW = C.G * 8; const GAS float* xin = C.inp<0>();
    for (int t0 = gw; t0 < T; t0 += 2 * NGW) {
        f32x4 v[2][4]; bool ok[2];
#pragma unroll
        for (int q = 0; q < 2; ++q) { const int t = t0 + q * NGW; ok[q] = t < T; const GAS f32x4* xr = (const GAS f32x4*)(xin + (size_t)(ok[q] ? t : 0) * D) + C.lane * 2;
            v[q][0] = xr[0]; v[q][1] = xr[1]; v[q][2] = xr[128]; v[q][3] = xr[129]; }
#pragma unroll
        for (int q = 0; q < 2; ++q) if (ok[q]) { const int t = t0 + q * NGW; GAS bf16* o = C.W<bf16>(WS_HB) + (size_t)t * D + C.lane * 8; float ss = 0.f; float rr[2][8];
#pragma unroll
            for (int j = 0; j < 2; ++j) { const f32x4 a = v[q][2 * j], b = v[q][2 * j + 1]; float vv[8] = {a.x, a.y, a.z, a.w, b.x, b.y, b.z, b.w}; const u32x4 w = pack8(vv); unpack8(w, rr[j]);
#pragma unroll
                for (int i = 0; i < 8; ++i) ss += rr[j][i] * rr[j][i];
                *(GAS u32x4*)(o + j * 512) = w; }
#pragma unroll
            for (int off = 1; off < 64; off <<= 1) ss += shxf_(ss, off, C.lane);
            const float sa = __builtin_amdgcn_rsqf(ss * (1.f / D) + EPS) * SA8;
#pragma unroll
            for (int j = 0; j < 2; ++j) { u32x2 o8; o8.x = pack4_fp8(rr[j][0] * sa, rr[j][1] * sa, rr[j][2] * sa, rr[j][3] * sa); o8.y = pack4_fp8(rr[j][4] * sa, rr[j][5] * sa, rr[j][6] * sa, rr[j][7] * sa);
                *(GAS u32x2*)(C.W<unsigned char>(WS_HB8) + (size_t)t * D + C.lane * 8 + j * 512) = o8; }
            if (C.lane == 0) C.W<float>(WS_SS1)[t] = ss; }
    }
}

constexpr int LRU_CH = 128, LRU_NCH = SEQ / LRU_CH;
struct LruK { float ba[2][4], bx[2][4], c8[2][4]; float w0, w1, w2, w3, cb; };
__device__ __forceinline__ void lru_setup(const Ctx& C, int l, int nb, LruK& K) {
    const int lane = C.lane, fr = lane & 15, ch0 = nb * 64, tid = C.tid;
    const GAS float* pba = C.inp<15>(); const GAS float* pbx = C.inp<17>(); const GAS float* lc8 = C.W<float>(WS_LRUC8);
#pragma unroll
    for (int dir = 0; dir < 2; ++dir)
#pragma unroll
        for (int cb4 = 0; cb4 < 4; ++cb4) { const int chn = ch0 + cb4 * 16 + fr; K.ba[dir][cb4] = pba[(l * 2 + dir) * 512 + chn]; K.bx[dir][cb4] = pbx[(l * 2 + dir) * 512 + chn];
            K.c8[dir][cb4] = lc8[dir * 512 + chn]; }
    const GAS float* cw = C.inp<12>(); const int ch = ch0 + lane;
    K.w0 = cw[(l * 4 + 0) * 512 + ch]; K.w1 = cw[(l * 4 + 1) * 512 + ch]; K.w2 = cw[(l * 4 + 2) * 512 + ch]; K.w3 = cw[(l * 4 + 3) * 512 + ch]; K.cb = C.inp<13>()[l * 512 + ch];
    const GAS bf16* wt = C.W<bf16>(WS_LRUW);
    __syncthreads();
#pragma unroll
    for (int i = 0; i < 4; ++i) { const int e = (i * 512 + tid) * 8, mtx = e >> 12, d = (e >> 6) & 63, c = e & 63;
        *(LAS u32x4*)(C.lds + (mtx * 64 + d) * 144 + c * 2) = *(const GAS u32x4*)(wt + ((size_t)(mtx * 8 + nb) * 64 + d) * 64 + c); }
    __syncthreads();
}
__device__ __forceinline__ void lru_load_x(const Ctx& C, int unit, u32x4 (&xr)[3]) {
    const int bc = unit >> 3, nb = unit & 7, b = bc / LRU_NCH, s0 = (bc % LRU_NCH) * LRU_CH, r8 = C.lane >> 3, ck = (C.lane & 7) * 8; const GAS bf16* xb = C.W<bf16>(WS_XB);
#pragma unroll
    for (int i = 0; i < 3; ++i) { const int s = s0 + C.wave * 16 + i * 8 + r8 - 2; xr[i] = (s >= 0 && s < SEQ && i * 8 + r8 < 19) ? *(const GAS u32x4*)(xb + ((size_t)b * SEQ + s) * 512 + nb * 64 + ck) : (u32x4){0u, 0u, 0u, 0u}; }
}
__device__ __forceinline__ void lru_pass1_unit(const Ctx& C, int unit, int par, const LruK& K, const u32x4 (&xr)[3]) {
    const int lane = C.lane, w = C.wave, fr = lane & 15, fq = lane >> 4;
    const int bc = unit >> 3, nb = unit & 7, t0 = bc * LRU_CH + w * 16, ch0 = nb * 64;
    LAS unsigned char* WT = C.lds; LAS unsigned char* WV = C.lds + 36864 + w * 11008;
    LAS bf16* XCb = (LAS bf16*)WV; LAS float* LA = (LAS float*)(WV + 2304); LAS float* LB = (LAS float*)(WV + 2304 + 4352);
    LAS float* SEG = (LAS float*)(C.lds + 124928) + par * 2048;
    {
        LAS bf16* XS = (LAS bf16*)(WV + 2304);
#pragma unroll
        for (int i = 0; i < 3; ++i) *(LAS u32x4*)(XS + (i * 8 + (lane >> 3)) * 64 + (lane & 7) * 8) = xr[i];
        float xv[19];
#pragma unroll
        for (int i = 0; i < 19; ++i) xv[i] = bf2f(XS[i * 64 + lane]);
#pragma unroll
        for (int j = 0; j < 16; ++j) { const float xc = K.cb + K.w0 * xv[j] + K.w1 * xv[j + 1] + K.w2 * xv[j + 2] + K.w3 * xv[j + 3]; XCb[j * 72 + lane] = (bf16)f2bf(xc); }
    }
    bf16x8 af[2];
#pragma unroll
    for (int kk = 0; kk < 2; ++kk) af[kk] = *(const LAS bf16x8*)((LAS unsigned char*)XCb + fr * 144 + (kk * 32 + fq * 8) * 2);
    float hs[2][16], ps[2][16];
    float xcv[4][4];
#pragma unroll
    for (int cb4 = 0; cb4 < 4; ++cb4)
#pragma unroll
        for (int r = 0; r < 4; ++r) xcv[cb4][r] = bf2f(XCb[(4 * fq + r) * 72 + cb4 * 16 + fr]);
#pragma unroll
    for (int dir = 0; dir < 2; ++dir) {
        bf16x8 bR[4][2], bI[4][2];
#pragma unroll
        for (int cb4 = 0; cb4 < 4; ++cb4)
#pragma unroll
            for (int kk = 0; kk < 2; ++kk) { bR[cb4][kk] = *(const LAS bf16x8*)(WT + ((dir * 2 + 0) * 64 + cb4 * 16 + fr) * 144 + (kk * 32 + fq * 8) * 2); bI[cb4][kk] = *(const LAS bf16x8*)(WT + ((dir * 2 + 1) * 64 + cb4 * 16 + fr) * 144 + (kk * 32 + fq * 8) * 2); }
        f32x4 aR[4], aI[4];
#pragma unroll
        for (int cb4 = 0; cb4 < 4; ++cb4) { aR[cb4] = (f32x4){0.f, 0.f, 0.f, 0.f}; aI[cb4] = (f32x4){0.f, 0.f, 0.f, 0.f};
#pragma unroll
            for (int kk = 0; kk < 2; ++kk) { aR[cb4] = MFMA16(af[kk], bR[cb4][kk], aR[cb4]); aI[cb4] = MFMA16(af[kk], bI[cb4][kk], aI[cb4]); } }
        float va[4][4], vb[4][4];
#pragma unroll
        for (int cb4 = 0; cb4 < 4; ++cb4) { const float ba = K.ba[dir][cb4], bx = K.bx[dir][cb4], c8 = K.c8[dir][cb4];
#pragma unroll
            for (int r = 0; r < 4; ++r) { const float rg = sigmoid_(aR[cb4][r] + ba), ig = sigmoid_(aI[cb4][r] + bx), a = __builtin_amdgcn_exp2f(-c8 * rg), mlt = __builtin_amdgcn_sqrtf(fmaxf(1.f - a * a, 0.f));
                va[cb4][r] = a; vb[cb4][r] = mlt * ig * xcv[cb4][r]; } }
#pragma unroll
        for (int cb4 = 0; cb4 < 4; ++cb4)
#pragma unroll
            for (int r = 0; r < 4; ++r) { const int tok = 4 * fq + r, d = cb4 * 16 + fr; LA[tok * 68 + d] = va[cb4][r]; LB[tok * 68 + d] = vb[cb4][r]; }
        float h = 0.f, P = 1.f;
#pragma unroll
        for (int i = 0; i < 16; ++i) { const int tok = dir ? 15 - i : i; const float a = LA[tok * 68 + lane], bb = LB[tok * 68 + lane]; h = a * h + bb; P *= a; hs[dir][tok] = h; ps[dir][tok] = P; }
        SEG[((dir * 2 + 0) * 8 + w) * 64 + lane] = P; SEG[((dir * 2 + 1) * 8 + w) * 64 + lane] = h;
    }
    __syncthreads();
    float cin = 0.f, Pin = 1.f, cib = 0.f, Pib = 1.f;
    for (int s = 0; s < w; ++s) { const float A = SEG[(0 * 8 + s) * 64 + lane], H = SEG[(8 + s) * 64 + lane]; cin = A * cin + H; Pin *= A; }
    for (int s = 7; s > w; --s) { const float A = SEG[(16 + s) * 64 + lane], H = SEG[(24 + s) * 64 + lane]; cib = A * cib + H; Pib *= A; }
    GAS bf16* yl = C.W<bf16>(WS_YLOC); GAS bf16* gpf = C.W<bf16>(WS_PF); GAS bf16* gpb = C.W<bf16>(WS_PB);
    float yfl = 0.f, pfl = 0.f, ybf = 0.f, pbf = 0.f;
    LAS bf16* ST = (LAS bf16*)(WV + 2304);
#pragma unroll
    for (int j = 0; j < 16; ++j) {
        const float yf = hs[0][j] + ps[0][j] * cin, pcf = ps[0][j] * Pin, yb = hs[1][j] + ps[1][j] * cib, pcb = ps[1][j] * Pib;
        const unsigned p0 = cvt_pk_bf16(yf + yb, pcf), p1 = cvt_pk_bf16(pcb, 0.f);
        ST[(0 * 16 + j) * 64 + lane] = (bf16)(p0 & 0xffffu); ST[(1 * 16 + j) * 64 + lane] = (bf16)(p0 >> 16); ST[(2 * 16 + j) * 64 + lane] = (bf16)(p1 & 0xffffu);
        if (j == 15) { yfl = yf; pfl = pcf; } if (j == 0) { ybf = yb; pbf = pcb; } }
    { const int tok = lane >> 2, ck = (lane & 3) * 16; const size_t o = (size_t)(t0 + tok) * 512 + ch0 + ck;
#pragma unroll
      for (int arr = 0; arr < 3; ++arr) { GAS bf16* gp = arr == 0 ? yl : (arr == 1 ? gpf : gpb);
          const u32x4 v0 = *(const LAS u32x4*)(ST + (arr * 16 + tok) * 64 + ck), v1 = *(const LAS u32x4*)(ST + (arr * 16 + tok) * 64 + ck + 8);
          *(GAS u32x4*)(gp + o) = v0; *(GAS u32x4*)(gp + o + 8) = v1; } }
    GAS float* sm = C.W<float>(WS_LSUM) + ((size_t)bc * 512 + ch0 + lane) * 4;
    if (w == 7) { sm[0] = pfl; sm[1] = yfl; }
    if (w == 0) { sm[2] = pbf; sm[3] = ybf; }
}
__device__ __forceinline__ void lru_pass1_all(const Ctx& C, int l) {
    constexpr int NU = (T / LRU_CH) * 8;
    LruK K; int cur_nb = -1, par = 0; u32x4 xr[3], xn[3];
    int u = C.bid; if (u >= NU) return;
    lru_load_x(C, u, xr);
    for (; u < NU; u += C.G) {
        const int nb = u & 7; if (nb != cur_nb) { lru_setup(C, l, nb, K); cur_nb = nb; }
        const int un = u + C.G; if (un < NU) lru_load_x(C, un, xn);
        lru_pass1_unit(C, u, par, K, xr); par ^= 1;
#pragma unroll
        for (int i = 0; i < 3; ++i) xr[i] = xn[i];
    }
    __syncthreads();
}
__device__ __forceinline__ void lru_carry(const Ctx& C) {
    const int gid = C.bid * 512 + C.tid; if (gid >= 8192) return;
    const int dir = gid >> 12, b = (gid >> 9) & 7, ch = gid & 511; const GAS float* sm = C.W<float>(WS_LSUM); GAS float* car = C.W<float>(WS_LCAR); float c = 0.f;
    for (int i0 = 0; i0 < LRU_NCH; i0 += 8) {
        f32x2 ah[8];
#pragma unroll
        for (int j = 0; j < 8; ++j) { const int cc = dir ? LRU_NCH - 1 - (i0 + j) : (i0 + j); ah[j] = *(const GAS f32x2*)(sm + ((size_t)(b * LRU_NCH + cc) * 512 + ch) * 4 + dir * 2); }
#pragma unroll
        for (int j = 0; j < 8; ++j) { const int cc = dir ? LRU_NCH - 1 - (i0 + j) : (i0 + j); car[((size_t)(b * LRU_NCH + cc) * 512 + ch) * 2 + dir] = c; c = ah[j].x * c + ah[j].y; }
    }
}
__device__ __forceinline__ void lru_pass2(const Ctx& C) {
    const GAS bf16* yl = C.W<bf16>(WS_YLOC); const GAS bf16* gpf = C.W<bf16>(WS_PF); const GAS bf16* gpb = C.W<bf16>(WS_PB); const GAS float* car = C.W<float>(WS_LCAR); GAS bf16* ycat = C.W<bf16>(WS_YCAT);
    int start, cnt;
    if (C.G == 256) { if (C.bid < 128) { start = C.bid * 4608; cnt = 9; } else { start = 128 * 4608 + (C.bid - 128) * 11776; cnt = 23; } }
    else { const int per = (T * 64 / 512 + C.G - 1) / C.G; start = C.bid * per * 512; cnt = per; }
    for (int j = 0; j < cnt; j += 4) {
        u32x4 ly[4], lf[4], lb[4]; f32x4 cv[4][4]; int tt[4], cc[4]; bool ok[4];
#pragma unroll
        for (int q = 0; q < 4; ++q) { const int i = start + (j + q) * 512 + C.tid; ok[q] = (j + q < cnt) && i < T * 64; const int ii = ok[q] ? i : 0; tt[q] = ii >> 6; cc[q] = (ii & 63) * 8;
            ly[q] = *(const GAS u32x4*)(yl + (size_t)tt[q] * 512 + cc[q]); lf[q] = *(const GAS u32x4*)(gpf + (size_t)tt[q] * 512 + cc[q]); lb[q] = *(const GAS u32x4*)(gpb + (size_t)tt[q] * 512 + cc[q]);
            const GAS f32x4* cp = (const GAS f32x4*)(car + ((size_t)(tt[q] / LRU_CH) * 512 + cc[q]) * 2);
#pragma unroll
            for (int k = 0; k < 4; ++k) cv[q][k] = cp[k]; }
#pragma unroll
        for (int q = 0; q < 4; ++q) { float y[8], pf[8], pb[8], o[8]; unpack8(ly[q], y); unpack8(lf[q], pf); unpack8(lb[q], pb);
#pragma unroll
            for (int k = 0; k < 4; ++k) { o[2 * k] = y[2 * k] + pf[2 * k] * cv[q][k].x + pb[2 * k] * cv[q][k].y; o[2 * k + 1] = y[2 * k + 1] + pf[2 * k + 1] * cv[q][k].z + pb[2 * k + 1] * cv[q][k].w; }
            if (ok[q]) *(GAS u32x4*)(ycat + (size_t)tt[q] * 1024 + 256 + cc[q]) = pack8(o); }
    }
}

struct GlaConsts { bf16x8 bh[4], bl[4]; float baf, bab; };
__device__ __forceinline__ void gla_load_consts(const Ctx& C, int l, int h, GlaConsts& K) {
    const int d = C.lane, col0 = h * 64, dir = C.wave >> 2, n = C.lane & 15, kq = C.lane >> 4; const GAS float* pwa = C.inp<19>(); const GAS float* pbal = C.inp<20>();
#pragma unroll
    for (int dt = 0; dt < 4; ++dt) { float hv[8], lv[8];
#pragma unroll
        for (int i = 0; i < 8; ++i) { const float wv = pwa[((size_t)(l * 2 + dir) * 16 + (kq & 1) * 8 + i) * 256 + col0 + dt * 16 + n]; hv[i] = bf2f(f2bf(wv)); lv[i] = wv - hv[i]; }
        K.bh[dt] = __builtin_bit_cast(bf16x8, pack8(hv)); K.bl[dt] = __builtin_bit_cast(bf16x8, pack8(lv)); }
    K.baf = pbal[(l * 2 + 0) * 256 + col0 + d]; K.bab = pbal[(l * 2 + 1) * 256 + col0 + d];
}
struct GlaIn { u32x4 q, k, v; f32x4 alr; };
__device__ __forceinline__ void gla_load_in(const Ctx& C, int u, GlaIn& I) {
    const int b = u >> 8, h = (u >> 6) & 3, n = u & 63, t0 = b * SEQ + n * 64, col0 = h * 64, w = C.wave, tid = C.tid, lane = C.lane;
    const size_t o = (size_t)(t0 + w * 8 + (lane >> 3)) * 256 + col0 + (lane & 7) * 8;
    I.q = *(const GAS u32x4*)(C.W<bf16>(WS_Q) + o); I.k = *(const GAS u32x4*)(C.W<bf16>(WS_K) + o); I.v = *(const GAS u32x4*)(C.W<bf16>(WS_V) + o);
    I.alr = *(const GAS f32x4*)(C.W<float>(WS_ALR) + (size_t)(t0 + (tid >> 3)) * 32 + (tid & 7) * 4);
}
__device__ __forceinline__ void gla_pass1_unit(const Ctx& C, int u, const GlaConsts& K, const GlaIn& I) {
    const int lane = C.lane, w = C.wave, tid = C.tid, fr = lane & 15, fq = lane >> 4;
    const int b = u >> 8, h = (u >> 6) & 3, n = u & 63, t0 = b * SEQ + n * 64, col0 = h * 64;
    LAS unsigned char* L = C.lds;
    LAS float* ALR = (LAS float*)L;
    LAS float* SEGF = (LAS float*)(L + 8192);
    LAS float* SEGB = (LAS float*)(L + 10240);
    LAS unsigned char* QDF = L + 12288, *KDF = L + 21504, *QDB = L + 30720, *KDB = L + 39936, *KRFT = L + 49152, *KRBT = L + 58368, *VT = L + 67584, *SS = L + 76800;
    *(LAS f32x4*)(ALR + (tid >> 3) * 32 + (tid & 7) * 4) = I.alr;
    LAS bf16* QKV = (LAS bf16*)(L + 86016);
    { const int row = w * 8 + (lane >> 3), ck = (lane & 7) * 8; *(LAS u32x4*)(QKV + (0 * 64 + row) * 64 + ck) = I.q; *(LAS u32x4*)(QKV + (1 * 64 + row) * 64 + ck) = I.k; *(LAS u32x4*)(QKV + (2 * 64 + row) * 64 + ck) = I.v; }
    __syncthreads();
    LAS float* XT = (LAS float*)(L + 110592);
    {
        const int dir = w >> 2, tt = w & 3; const LAS float* ap = ALR + (tt * 16 + fr) * 32 + dir * 16 + (fq & 1) * 8;
        const f32x4 x0 = *(const LAS f32x4*)ap, x1 = *(const LAS f32x4*)(ap + 4); float xs[8] = {x0.x, x0.y, x0.z, x0.w, x1.x, x1.y, x1.z, x1.w};
#pragma unroll
        for (int i = 0; i < 8; ++i) { const float hi = bf2f(f2bf(xs[i])); xs[i] = (fq >= 2) ? xs[i] - hi : hi; }
        const bf16x8 af = __builtin_bit_cast(bf16x8, pack8(xs));
#pragma unroll
        for (int dt = 0; dt < 4; ++dt) { f32x4 c = {0.f, 0.f, 0.f, 0.f}; c = MFMA16(af, K.bh[dt], c); c = MFMA16(af, K.bl[dt], c);
            *(LAS f32x4*)(XT + (dir * 64 + dt * 16 + fr) * 68 + tt * 16 + 4 * fq) = c; }
    }
    __syncthreads();
    float bfw[8], bbw[8], allF, allB;
    {
        const int d = lane;
        float gf[8], gb[8];
        { const f32x4 f0 = *(const LAS f32x4*)(XT + d * 68 + 8 * w), f1 = *(const LAS f32x4*)(XT + d * 68 + 8 * w + 4), b0 = *(const LAS f32x4*)(XT + (64 + d) * 68 + 8 * w), b1 = *(const LAS f32x4*)(XT + (64 + d) * 68 + 8 * w + 4);
          const float xfv[8] = {f0.x, f0.y, f0.z, f0.w, f1.x, f1.y, f1.z, f1.w}, xbv[8] = {b0.x, b0.y, b0.z, b0.w, b1.x, b1.y, b1.z, b1.w};
#pragma unroll
          for (int j = 0; j < 8; ++j) { gf[j] = logsig_(xfv[j] + K.baf) * (1.f / 16.f); gb[j] = logsig_(xbv[j] + K.bab) * (1.f / 16.f); } }
        float s = 0.f;
#pragma unroll
        for (int j = 0; j < 8; ++j) { s += gf[j]; bfw[j] = s; }
        SEGF[w * 64 + d] = s; s = 0.f;
#pragma unroll
        for (int j = 7; j >= 0; --j) { s += gb[j]; bbw[j] = s; }
        SEGB[w * 64 + d] = s;
    }
    __syncthreads();
    {
        const int d = lane; float offF = 0.f, offB = 0.f; allF = 0.f; allB = 0.f;
#pragma unroll
        for (int s = 0; s < 8; ++s) { const float a = SEGF[s * 64 + d], c = SEGB[s * 64 + d]; allF += a; allB += c; if (s < w) offF += a; if (s > w) offB += c; }
        GAS bf16* gqdf = C.W<bf16>(WS_QDF); GAS bf16* gqdb = C.W<bf16>(WS_QDB);
        float krf[8], krb[8], vt[8];
#pragma unroll
        for (int j = 0; j < 8; ++j) { const int tok = w * 8 + j; const size_t o = (size_t)(t0 + tok) * 256 + col0 + d;
            const float qv = bf2f(QKV[(0 * 64 + tok) * 64 + d]), kv = bf2f(QKV[(1 * 64 + tok) * 64 + d]), vv = bf2f(QKV[(2 * 64 + tok) * 64 + d]); const float cf = offF + bfw[j], cb = offB + bbw[j];
            const float qdf = qv * __expf(cf), kdf = kv * __expf(-cf), qdb = qv * __expf(cb), kdb = kv * __expf(-cb);
            krf[j] = kv * __expf(allF - cf); krb[j] = kv * __expf(allB - cb); vt[j] = vv;
            const unsigned hq = f2bf(qdf), hb = f2bf(qdb);
            *(LAS bf16*)(QDF + tok * 144 + d * 2) = (bf16)hq; *(LAS bf16*)(KDF + tok * 144 + d * 2) = (bf16)f2bf(kdf); *(LAS bf16*)(QDB + tok * 144 + d * 2) = (bf16)hb; *(LAS bf16*)(KDB + tok * 144 + d * 2) = (bf16)f2bf(kdb);
            (void)o; }
        *(LAS u32x4*)(KRFT + d * 144 + w * 16) = pack8(krf); *(LAS u32x4*)(KRBT + d * 144 + w * 16) = pack8(krb); *(LAS u32x4*)(VT + d * 144 + w * 16) = pack8(vt);
        { const int row = w * 8 + (lane >> 3), ck = (lane & 7) * 8; const size_t go = (size_t)(t0 + row) * 256 + col0 + ck;
          *(GAS u32x4*)(gqdf + go) = *(const LAS u32x4*)(QDF + row * 144 + ck * 2); *(GAS u32x4*)(gqdb + go) = *(const LAS u32x4*)(QDB + row * 144 + ck * 2); }
        if (w == 0) { GAS float* gd = C.W<float>(WS_GDEC) + (size_t)u * 128; gd[d] = __expf(allF); gd[64 + d] = __expf(allB); }
    }
    __syncthreads();
    {
        const int dir = w >> 2, ib = w & 3; const LAS unsigned char* QD = dir ? QDB : QDF; const LAS unsigned char* KD = dir ? KDB : KDF;
        bf16x8 af[2];
#pragma unroll
        for (int kk = 0; kk < 2; ++kk) af[kk] = *(const LAS bf16x8*)(QD + (ib * 16 + fr) * 144 + (kk * 32 + fq * 8) * 2);
        for (int jb = 0; jb < 4; ++jb) {
            if (dir == 0 ? (jb > ib) : (jb < ib)) continue;
            f32x4 a = {0.f, 0.f, 0.f, 0.f};
#pragma unroll
            for (int kk = 0; kk < 2; ++kk) { const bf16x8 bfrag = *(const LAS bf16x8*)(KD + (jb * 16 + fr) * 144 + (kk * 32 + fq * 8) * 2); a = MFMA16(af[kk], bfrag, a); }
#pragma unroll
            for (int r = 0; r < 4; ++r) { const int i = ib * 16 + 4 * fq + r, j = jb * 16 + fr; const bool keep = dir == 0 ? (j <= i) : (j > i); if (keep) *(LAS bf16*)(SS + i * 144 + j * 2) = (bf16)f2bf(a[r]); }
        }
    }
    __syncthreads();
    {
        GAS bf16* goin = C.W<bf16>(WS_OIN);
#pragma unroll
        for (int tt = 0; tt < 2; ++tt) { const int tile = w * 2 + tt, dvb = tile >> 2, ib = tile & 3; f32x4 a = {0.f, 0.f, 0.f, 0.f};
#pragma unroll
            for (int kk = 0; kk < 2; ++kk) { const bf16x8 x = *(const LAS bf16x8*)(VT + (dvb * 16 + fr) * 144 + (kk * 32 + fq * 8) * 2), y = *(const LAS bf16x8*)(SS + (ib * 16 + fr) * 144 + (kk * 32 + fq * 8) * 2); a = MFMA16(x, y, a); }
            u32x2 o; o.x = cvt_pk_bf16(a[0], a[1]); o.y = cvt_pk_bf16(a[2], a[3]);
            *(GAS u32x2*)(goin + (size_t)(t0 + ib * 16 + fr) * 256 + col0 + dvb * 16 + 4 * fq) = o; }
        const int dir = w >> 2, dkb = w & 3; const LAS unsigned char* KR = dir ? KRBT : KRFT; GAS bf16* gkv = C.W<bf16>(WS_KV) + ((size_t)u * 2 + dir) * 4096;
        bf16x8 af[2];
#pragma unroll
        for (int kk = 0; kk < 2; ++kk) af[kk] = *(const LAS bf16x8*)(KR + (dkb * 16 + fr) * 144 + (kk * 32 + fq * 8) * 2);
#pragma unroll
        for (int dvb = 0; dvb < 4; ++dvb) { f32x4 a = {0.f, 0.f, 0.f, 0.f};
#pragma unroll
            for (int kk = 0; kk < 2; ++kk) { const bf16x8 y = *(const LAS bf16x8*)(VT + (dvb * 16 + fr) * 144 + (kk * 32 + fq * 8) * 2); a = MFMA16(af[kk], y, a); }
            u32x2 o; o.x = cvt_pk_bf16(a[0], a[1]); o.y = cvt_pk_bf16(a[2], a[3]);
            *(GAS u32x2*)(gkv + (size_t)(dvb * 16 + fr) * 64 + dkb * 16 + 4 * fq) = o; }
    }
    __syncthreads();
}
__device__ __forceinline__ void gla_pass1_all(const Ctx& C, int l) {
    GlaConsts K; int cur_h = -1; GlaIn I, In;
    int u = C.bid; if (u >= 2048) return;
    gla_load_in(C, u, I);
    for (; u < 2048; u += C.G) {
        const int h = (u >> 6) & 3; if (h != cur_h) { gla_load_consts(C, l, h, K); cur_h = h; }
        const int un = u + C.G; if (un < 2048) gla_load_in(C, un, In);
        gla_pass1_unit(C, u, K, I);
        I = In;
    }
}
__device__ __forceinline__ void gla_scan(const Ctx& C) {
    GAS bf16* kv = C.W<bf16>(WS_KV); const GAS float* gd = C.W<float>(WS_GDEC);
    const int NT = C.G * 512;
    for (int e0 = C.bid * 512 + C.tid; e0 < 64 * 4096; e0 += 2 * NT) {
        const int e1 = e0 + NT; const bool two = e1 < 64 * 4096;
        const int sq0 = e0 >> 12, el0 = e0 & 4095, dk0 = el0 & 63, dir0 = sq0 & 1, bh0 = sq0 >> 1;
        const int e1c = two ? e1 : e0; const int sq1 = e1c >> 12, el1 = e1c & 4095, dk1 = el1 & 63, dir1 = sq1 & 1, bh1 = sq1 >> 1;
        float S0 = 0.f, S1 = 0.f;
        for (int i0 = 0; i0 < 64; i0 += 8) {
            float k0[8], d0[8], k1[8], d1[8];
#pragma unroll
            for (int j = 0; j < 8; ++j) { const int n0 = dir0 ? 63 - (i0 + j) : (i0 + j), u0 = bh0 * 64 + n0, n1 = dir1 ? 63 - (i0 + j) : (i0 + j), u1 = bh1 * 64 + n1;
                k0[j] = bf2f(kv[((size_t)u0 * 2 + dir0) * 4096 + el0]); d0[j] = gd[(size_t)u0 * 128 + dir0 * 64 + dk0];
                k1[j] = bf2f(kv[((size_t)u1 * 2 + dir1) * 4096 + el1]); d1[j] = gd[(size_t)u1 * 128 + dir1 * 64 + dk1]; }
#pragma unroll
            for (int j = 0; j < 8; ++j) { const int n0 = dir0 ? 63 - (i0 + j) : (i0 + j), u0 = bh0 * 64 + n0, n1 = dir1 ? 63 - (i0 + j) : (i0 + j), u1 = bh1 * 64 + n1;
                kv[((size_t)u0 * 2 + dir0) * 4096 + el0] = (bf16)f2bf(S0); S0 = d0[j] * S0 + k0[j];
                if (two) { kv[((size_t)u1 * 2 + dir1) * 4096 + el1] = (bf16)f2bf(S1); S1 = d1[j] * S1 + k1[j]; } }
        }
    }
}
__device__ __forceinline__ void gla_pass2_unit(const Ctx& C, int l, int unit) {
    const int lane = C.lane, w = C.wave, fr = lane & 15, fq = lane >> 4; const int b = unit >> 6, n = unit & 63, t0 = b * SEQ + n * 64;
    const GAS bf16* gqdf = C.W<bf16>(WS_QDF); const GAS bf16* gqdb = C.W<bf16>(WS_QDB); const GAS bf16* kv = C.W<bf16>(WS_KV); const GAS bf16* goin = C.W<bf16>(WS_OIN); const GAS bf16* sog = C.W<bf16>(WS_SOG); GAS bf16* ycat = C.W<bf16>(WS_YCAT); const GAS float* gng = C.inp<21>();
#pragma unroll
    for (int pp = 0; pp < 2; ++pp) {
        const int p = w * 2 + pp, h = p >> 2, ib = p & 3, u = b * 256 + h * 64 + n, tok = t0 + ib * 16 + fr;
        bf16x8 qf[2], qb[2];
#pragma unroll
        for (int kk = 0; kk < 2; ++kk) { qf[kk] = *(const GAS bf16x8*)(gqdf + (size_t)tok * 256 + h * 64 + kk * 32 + fq * 8); qb[kk] = *(const GAS bf16x8*)(gqdb + (size_t)tok * 256 + h * 64 + kk * 32 + fq * 8); }
        f32x4 o[4]; float ssq = 0.f;
#pragma unroll
        for (int dvb = 0; dvb < 4; ++dvb) { f32x4 a = {0.f, 0.f, 0.f, 0.f};
#pragma unroll
            for (int kk = 0; kk < 2; ++kk) { const bf16x8 pf = *(const GAS bf16x8*)(kv + ((size_t)u * 2 + 0) * 4096 + (dvb * 16 + fr) * 64 + kk * 32 + fq * 8), pb = *(const GAS bf16x8*)(kv + ((size_t)u * 2 + 1) * 4096 + (dvb * 16 + fr) * 64 + kk * 32 + fq * 8);
                a = MFMA16(pf, qf[kk], a); a = MFMA16(pb, qb[kk], a); }
            const u32x2 oi = *(const GAS u32x2*)(goin + (size_t)tok * 256 + h * 64 + dvb * 16 + 4 * fq);
            a[0] += bflo(oi.x); a[1] += bfhi(oi.x); a[2] += bflo(oi.y); a[3] += bfhi(oi.y); o[dvb] = a; ssq += a[0] * a[0] + a[1] * a[1] + a[2] * a[2] + a[3] * a[3]; }
        ssq += __shfl_xor(ssq, 16); ssq += __shfl_xor(ssq, 32);
        const float rs = __builtin_amdgcn_rsqf(ssq * (1.f / 64.f) + EPS);
#pragma unroll
        for (int dvb = 0; dvb < 4; ++dvb) { const int dv = dvb * 16 + 4 * fq; const f32x4 g = *(const GAS f32x4*)(gng + l * 64 + dv); const u32x2 sg = *(const GAS u32x2*)(sog + (size_t)tok * 256 + h * 64 + dv);
            u32x2 r; r.x = cvt_pk_bf16(o[dvb][0] * rs * g.x * bflo(sg.x), o[dvb][1] * rs * g.y * bfhi(sg.x)); r.y = cvt_pk_bf16(o[dvb][2] * rs * g.z * bflo(sg.y), o[dvb][3] * rs * g.w * bfhi(sg.y));
            *(GAS u32x2*)(ycat + (size_t)tok * 1024 + 768 + h * 64 + dv) = r; }
    }
}

__device__ __forceinline__ void s5_scan(const Ctx& C, int l) {
    const int gid = C.bid * 512 + C.tid; if (gid >= 16384) return;
    const int p = gid & 63, dir = (gid >> 6) & 1, b = (gid >> 7) & 7, g = gid >> 10; const size_t pi = ((size_t)(l * 2 + dir) * 16 + g) * 64 + p;
    const float lr = fminf(C.inp<3>()[pi], -1e-4f), li = C.inp<4>()[pi], dt = expf(C.inp<5>()[(l * 2 + dir) * 16 + g]); const float mg = expf(32.f * lr * dt); float sn, cs; sincosf(32.f * li * dt, &sn, &cs);
    const float are = mg * cs, aim = mg * sn; const GAS float* xl = C.W<float>(WS_XLOC); GAS bf16* ux = C.W<bf16>(WS_UX); float xr = 0.f, xi = 0.f;
    for (int i0 = 0; i0 < S5NCH; i0 += 16) {
        f32x2 v[16];
#pragma unroll
        for (int j = 0; j < 16; ++j) { const int c = dir ? (S5NCH - 1 - (i0 + j)) : (i0 + j); const size_t row = (size_t)g * S5ROWS + b * S5NCH + c; v[j] = *(const GAS f32x2*)(xl + row * 256 + dir * 128 + 2 * p); }
#pragma unroll
        for (int j = 0; j < 16; ++j) { const int c = dir ? (S5NCH - 1 - (i0 + j)) : (i0 + j); const size_t row = (size_t)g * S5ROWS + b * S5NCH + c;
            *(GAS unsigned*)(ux + row * UXP + 512 + dir * 128 + 2 * p) = cvt_pk_bf16(xr, xi);
            const float nr = are * xr - aim * xi + v[j].x, ni = are * xi + aim * xr + v[j].y; xr = nr; xi = ni; }
    }
}

__device__ __forceinline__ void router_phase(const Ctx& C) {
    const int lane = C.lane, fr = lane & 15, fq = lane >> 4; const int gw = C.bid * 8 + C.wave, NGW = C.G * 8;
    const GAS bf16* hb2 = C.W<bf16>(WS_HB2); const GAS bf16* wr = C.W<bf16>(WS_WRT); GAS float* probs = C.W<float>(WS_PROBS); GAS float* ss2 = C.W<float>(WS_SS2);
    for (int tg = gw; tg < T / 16; tg += NGW) {
        const int tok0 = tg * 16; f32x4 acc = {0.f, 0.f, 0.f, 0.f}; float ss = 0.f;
#pragma unroll
        for (int half = 0; half < 2; ++half) {
            u32x4 aw[16];
#pragma unroll
            for (int k2 = 0; k2 < 16; ++k2) aw[k2] = *(const GAS u32x4*)(hb2 + (size_t)(tok0 + fr) * D + (half * 16 + k2) * 32 + fq * 8);
#pragma unroll
            for (int k2 = 0; k2 < 16; ++k2) { const int kk = half * 16 + k2; float av[8]; unpack8(aw[k2], av);
#pragma unroll
                for (int i = 0; i < 8; ++i) ss += av[i] * av[i];
                const bf16x8 a = __builtin_bit_cast(bf16x8, aw[k2]);
                const bf16x8 bh = *(const GAS bf16x8*)(wr + (size_t)fr * D + kk * 32 + fq * 8), bl = *(const GAS bf16x8*)(wr + (size_t)(NE + fr) * D + kk * 32 + fq * 8);
                acc = MFMA16(a, bh, acc); acc = MFMA16(a, bl, acc); }
        }
        ss += __shfl_xor(ss, 16); ss += __shfl_xor(ss, 32);
        if (fq == 0) ss2[tok0 + fr] = ss;
        float pr[4];
#pragma unroll
        for (int r = 0; r < 4; ++r) { const float rs = __builtin_amdgcn_rsqf(__shfl(ss, 4 * fq + r) * (1.f / D) + EPS); const float lg = acc[r] * rs; float mx = lg;
#pragma unroll
            for (int off = 1; off < 16; off <<= 1) mx = fmaxf(mx, __shfl_xor(mx, off));
            const float e = __expf(lg - mx); float sm = e;
#pragma unroll
            for (int off = 1; off < 16; off <<= 1) sm += __shfl_xor(sm, off);
            pr[r] = e / sm; }
        const int b = tok0 >> 12, s = (tok0 & 4095) + 4 * fq;
        *(GAS f32x4*)(probs + ((size_t)(b * NE + fr)) * SEQ + s) = (f32x4){pr[0], pr[1], pr[2], pr[3]};
    }
}
__device__ __forceinline__ void xn8_rows(const Ctx& C, int b0, int nb) {
    const int lane = C.lane; const GAS bf16* hb2 = C.W<bf16>(WS_HB2); const GAS float* ss2 = C.W<float>(WS_SS2); GAS unsigned char* xn8 = C.W<unsigned char>(WS_XN8);
    const int w0 = (C.bid - b0) * 8 + C.wave, nw = nb * 8;
    for (int t0 = w0; t0 < T; t0 += 4 * nw) {
        u32x4 a[4], c[4]; float sq[4]; bool ok[4];
#pragma unroll
        for (int q = 0; q < 4; ++q) { const int t = t0 + q * nw; ok[q] = t < T; const int tt = ok[q] ? t : 0; sq[q] = ss2[tt]; a[q] = *(const GAS u32x4*)(hb2 + (size_t)tt * D + lane * 16); c[q] = *(const GAS u32x4*)(hb2 + (size_t)tt * D + lane * 16 + 8); }
#pragma unroll
        for (int q = 0; q < 4; ++q) if (ok[q]) { const int t = t0 + q * nw; const float rs16 = __builtin_amdgcn_rsqf(sq[q] * (1.f / D) + EPS) * SA8; float av[8], cv[8]; unpack8(a[q], av); unpack8(c[q], cv);
            u32x4 o; o.x = pack4_fp8(av[0] * rs16, av[1] * rs16, av[2] * rs16, av[3] * rs16); o.y = pack4_fp8(av[4] * rs16, av[5] * rs16, av[6] * rs16, av[7] * rs16);
            o.z = pack4_fp8(cv[0] * rs16, cv[1] * rs16, cv[2] * rs16, cv[3] * rs16); o.w = pack4_fp8(cv[4] * rs16, cv[5] * rs16, cv[6] * rs16, cv[7] * rs16);
            *(GAS u32x4*)(xn8 + (size_t)t * D + lane * 16) = o; }
    }
}
__device__ __forceinline__ void topk_phase(const Ctx& C) {
    if (C.bid >= NBATCH * NE) { if (C.G > NBATCH * NE) xn8_rows(C, NBATCH * NE, C.G - NBATCH * NE); return; }
    if (C.G <= NBATCH * NE) xn8_rows(C, 0, C.G);
    const int tid = C.tid, lane = C.lane, w = C.wave; const int be = C.bid, b = be >> 4, e = be & 15;
    LAS unsigned* hist = (LAS unsigned*)C.lds;
    LAS unsigned* wsum = (LAS unsigned*)(C.lds + 1024);
    LAS unsigned* sh = (LAS unsigned*)(C.lds + 1152);
    const GAS float* pp = C.W<float>(WS_PROBS) + (size_t)be * SEQ + tid * 8;
    unsigned v[8]; { const u32x4 a = *(const u32x4*)pp, c = *(const GAS u32x4*)(pp + 4); v[0] = a.x; v[1] = a.y; v[2] = a.z; v[3] = a.w; v[4] = c.x; v[5] = c.y; v[6] = c.z; v[7] = c.w; }
    unsigned prefix = 0u, mask = 0u, need = CAP;
    for (int pass = 0; pass < 4; ++pass) {
        const int shift = 24 - 8 * pass;
        if (tid < 256) hist[tid] = 0u;
        __syncthreads();
#pragma unroll
        for (int i = 0; i < 8; ++i) if ((v[i] & mask) == prefix) __hip_atomic_fetch_add(&hist[(v[i] >> shift) & 255u], 1u, __ATOMIC_RELAXED, __HIP_MEMORY_SCOPE_WORKGROUP);
        __syncthreads();
        unsigned cnt = 0u, suf = 0u;
        if (tid < 256) { cnt = hist[tid]; suf = cnt;
#pragma unroll
            for (int off = 1; off < 64; off <<= 1) { const unsigned o = shdn_(suf, off, lane); if (lane + off < 64) suf += o; }
            if (lane == 0) wsum[w] = suf; }
        __syncthreads();
        if (tid < 256) { for (int ww = w + 1; ww < 4; ++ww) suf += wsum[ww];
            const unsigned above = suf - cnt; if (suf >= need && above < need) { sh[0] = (unsigned)tid; sh[1] = need - above; } }
        __syncthreads();
        prefix |= sh[0] << shift; mask |= 255u << shift; need = sh[1];
        __syncthreads();
    }
    const unsigned thr = prefix;
    unsigned cg = 0u, ce = 0u;
#pragma unroll
    for (int i = 0; i < 8; ++i) { cg += v[i] > thr; ce += v[i] == thr; }
    unsigned pk = cg | (ce << 16), inc = pk;
#pragma unroll
    for (int off = 1; off < 64; off <<= 1) { const unsigned o = shup_(inc, off, lane); if (lane >= off) inc += o; }
    if (lane == 63) wsum[w] = inc;
    __syncthreads();
    unsigned base = 0u, tot = 0u; for (int ww = 0; ww < 8; ++ww) { const unsigned x = wsum[ww]; if (ww < w) base += x; tot += x; }
    const unsigned ex = base + inc - pk; unsigned sg = ex & 0xffffu, se = ex >> 16; const unsigned totg = tot & 0xffffu;
    GAS int* idx = C.W<int>(WS_IDX) + be * CAP; GAS float* gp = C.W<float>(WS_GATEP) + be * CAP; GAS short* sel = C.W<short>(WS_SEL);
#pragma unroll
    for (int i = 0; i < 8; ++i) { const int s = tid * 8 + i; int slot = -1;
        if (v[i] > thr) slot = (int)sg++; else if (v[i] == thr) { if (se < need) slot = (int)(totg + se); ++se; }
        if (slot >= 0) { idx[slot] = s; gp[slot] = __builtin_bit_cast(float, v[i]); }
        sel[((size_t)b * SEQ + s) * NE + e] = (short)slot; }
    __syncthreads();
}
__device__ __forceinline__ void gather_phase(const Ctx& C) {
    const int gw = C.bid * 8 + C.wave, NGW = C.G * 8, lane = C.lane; const GAS bf16* hb2 = C.W<bf16>(WS_HB2); GAS bf16* xe = C.W<bf16>(WS_XE); const GAS int* idx = C.W<int>(WS_IDX); const GAS float* ss2 = C.W<float>(WS_SS2);
    for (int r = gw; r < NBATCH * NE * CAP; r += NGW) { const int b = r >> 13, tok = b * SEQ + idx[r]; const float rs = __builtin_amdgcn_rsqf(ss2[tok] * (1.f / D) + EPS);
#pragma unroll
        for (int j = 0; j < 2; ++j) { float vv[8]; unpack8(*(const GAS u32x4*)(hb2 + (size_t)tok * D + j * 512 + lane * 8), vv);
#pragma unroll
            for (int i = 0; i < 8; ++i) vv[i] *= rs;
            *(GAS u32x4*)(xe + (size_t)r * D + j * 512 + lane * 8) = pack8(vv); } }
}
__device__ __forceinline__ void combine_phase(const Ctx& C, int l) {
    const int gw = C.bid * 8 + C.wave, NGW = C.G * 8, lane = C.lane; const GAS bf16* hb2 = C.W<bf16>(WS_HB2); const GAS unsigned char* ye = C.W<unsigned char>(WS_XE); const GAS short* sel = C.W<short>(WS_SEL); GAS bf16* hb = C.W<bf16>(WS_HB); const GAS float* fg = C.inp<31>();
    u32x4 r1lo = {0u, 0u, 0u, 0u}, r1hi = r1lo, r2lo = r1lo, r2hi = r1lo; int s1 = -1, s2 = -1;
    u32x2 yA[4], yC[4], zA[4], zC[4]; bool yon[4] = {false, false, false, false}, zon[4] = {false, false, false, false}; unsigned yrest = 0u, zrest = 0u;
    u32x4 r0lo = r1lo, r0hi = r1lo; int s0 = -1;
#define CB_ROW(tt, rlo, rhi, sv_) do { if ((tt) < T) { rlo = *(const GAS u32x4*)(hb2 + (size_t)(tt) * D + lane * 8); rhi = *(const GAS u32x4*)(hb2 + (size_t)(tt) * D + 512 + lane * 8); sv_ = (lane < 16) ? (int)sel[(size_t)(tt) * NE + lane] : -1; } else sv_ = -1; } while (0)
#define CB_YE(tt, sv_, A_, C_, on_, rest_) do { unsigned _m = (unsigned)(__ballot((sv_) >= 0) & 0xffffull); const int _b = (tt) >> 12; \
        _Pragma("unroll") for (int q = 0; q < 4; ++q) { on_[q] = _m != 0u; if (on_[q]) { const int e = __builtin_ctz(_m); _m &= _m - 1u; const int slot = __builtin_amdgcn_readlane((sv_), e); \
            const GAS unsigned char* yr = ye + ((size_t)(_b * NE + e) * CAP + slot) * D; A_[q] = *(const GAS u32x2*)(yr + lane * 8); C_[q] = *(const GAS u32x2*)(yr + 512 + lane * 8); } } rest_ = _m; } while (0)
    CB_ROW(gw, r0lo, r0hi, s0); CB_ROW(gw + NGW, r1lo, r1hi, s1);
    if (gw < T) CB_YE(gw, s0, yA, yC, yon, yrest);
    for (int t = gw; t < T; t += NGW) { const int b = t >> 12; float lo[8], hi[8];
        if (t + NGW < T) CB_YE(t + NGW, s1, zA, zC, zon, zrest); else { zrest = 0u; _Pragma("unroll") for (int q = 0; q < 4; ++q) zon[q] = false; }
        CB_ROW(t + 2 * NGW, r2lo, r2hi, s2);
        unpack8(r0lo, lo); unpack8(r0hi, hi);
#pragma unroll
        for (int q = 0; q < 4; ++q) if (yon[q]) { float a[8], c[8]; unpack8_fp8(yA[q], a); unpack8_fp8(yC[q], c);
#pragma unroll
            for (int i = 0; i < 8; ++i) { lo[i] += a[i] * (1.f / SY8); hi[i] += c[i] * (1.f / SY8); } }
        for (unsigned m = yrest; m; ) {
            const int e = __builtin_ctz(m); m &= m - 1u; const int slot = __builtin_amdgcn_readlane(s0, e); const GAS unsigned char* yr = ye + ((size_t)(b * NE + e) * CAP + slot) * D;
            float a[8], c[8]; unpack8_fp8(*(const GAS u32x2*)(yr + lane * 8), a); unpack8_fp8(*(const GAS u32x2*)(yr + 512 + lane * 8), c);
#pragma unroll
            for (int i = 0; i < 8; ++i) { lo[i] += a[i] * (1.f / SY8); hi[i] += c[i] * (1.f / SY8); } }
        r0lo = r1lo; r0hi = r1hi; s0 = s1; r1lo = r2lo; r1hi = r2hi; s1 = s2; yrest = zrest;
#pragma unroll
        for (int q = 0; q < 4; ++q) { yA[q] = zA[q]; yC[q] = zC[q]; yon[q] = zon[q]; }
        if (l + 1 < DEPTH) {
            const u32x4 w0 = pack8(lo), w1 = pack8(hi); float r0[8], r1[8]; unpack8(w0, r0); unpack8(w1, r1); float ss = 0.f;
#pragma unroll
            for (int i = 0; i < 8; ++i) ss += r0[i] * r0[i] + r1[i] * r1[i];
#pragma unroll
            for (int off = 1; off < 64; off <<= 1) ss += shxf_(ss, off, lane);
            *(GAS u32x4*)(hb + (size_t)t * D + lane * 8) = w0; *(GAS u32x4*)(hb + (size_t)t * D + 512 + lane * 8) = w1; if (lane == 0) C.W<float>(WS_SS1)[t] = ss;
            { const float sa = __builtin_amdgcn_rsqf(ss * (1.f / D) + EPS) * SA8;
              u32x2 o8; o8.x = pack4_fp8(r0[0] * sa, r0[1] * sa, r0[2] * sa, r0[3] * sa); o8.y = pack4_fp8(r0[4] * sa, r0[5] * sa, r0[6] * sa, r0[7] * sa); *(GAS u32x2*)(C.W<unsigned char>(WS_HB8) + (size_t)t * D + lane * 8) = o8;
              o8.x = pack4_fp8(r1[0] * sa, r1[1] * sa, r1[2] * sa, r1[3] * sa); o8.y = pack4_fp8(r1[4] * sa, r1[5] * sa, r1[6] * sa, r1[7] * sa); *(GAS u32x2*)(C.W<unsigned char>(WS_HB8) + (size_t)t * D + 512 + lane * 8) = o8; }
        } else { float ss = 0.f;
#pragma unroll
            for (int i = 0; i < 8; ++i) ss += lo[i] * lo[i] + hi[i] * hi[i];
#pragma unroll
            for (int off = 1; off < 64; off <<= 1) ss += shxf_(ss, off, lane);
            const float rs = __builtin_amdgcn_rsqf(ss * (1.f / D) + EPS); const GAS float* g = fg;
            { const f32x4 g0 = *(const GAS f32x4*)(g + lane * 8), g1 = *(const GAS f32x4*)(g + lane * 8 + 4); float* o = C.out + (size_t)t * D + lane * 8;
                *(GAS f32x4*)o = (f32x4){lo[0] * rs * g0.x, lo[1] * rs * g0.y, lo[2] * rs * g0.z, lo[3] * rs * g0.w};
                *(GAS f32x4*)(o + 4) = (f32x4){lo[4] * rs * g1.x, lo[5] * rs * g1.y, lo[6] * rs * g1.z, lo[7] * rs * g1.w}; }
            { const f32x4 g0 = *(const GAS f32x4*)(g + 512 + lane * 8), g1 = *(const GAS f32x4*)(g + 512 + lane * 8 + 4); float* o = C.out + (size_t)t * D + 512 + lane * 8;
                *(GAS f32x4*)o = (f32x4){hi[0] * rs * g0.x, hi[1] * rs * g0.y, hi[2] * rs * g0.z, hi[3] * rs * g0.w};
                *(GAS f32x4*)(o + 4) = (f32x4){hi[4] * rs * g1.x, hi[5] * rs * g1.y, hi[6] * rs * g1.z, hi[7] * rs * g1.w}; }
        }
    }
}

#ifndef MK_REPEAT
#define MK_REPEAT 0
#endif
#if MK_REPEAT
__device__ __forceinline__ int rep_count(int n) { asm volatile("" : "+s"(n)); return n; }
#define REPLOOP(k) for (int rep_ = 0, nrep_ = (((MK_REPEAT >> (k)) & 1) ? rep_count(2) : 1); rep_ < nrep_; ++rep_)
#define REP0 (rep_ == 0)
#else
#define REPLOOP(k)
#define REP0 true
#endif
__global__ void __launch_bounds__(512, 2) mega_fwd(Args args) {
    extern __shared__ __attribute__((aligned(16))) unsigned char lds_raw[];
    asm volatile("s_setreg_imm32_b32 hwreg(HW_REG_MODE, 23, 1), 1" ::: "memory");
    Ctx C0; C0.karg = (unsigned long long)__builtin_amdgcn_kernarg_segment_ptr(); C0.out = args.out; C0.ws = args.ws; C0.lds = (LAS unsigned char*)lds_raw;
    C0.tid = threadIdx.x; C0.lane = C0.tid & 63; C0.wave = __builtin_amdgcn_readfirstlane(C0.tid >> 6); C0.G = gridDim.x; C0.bid = blockIdx.x;
    volatile LAS unsigned* MISC = (volatile LAS unsigned*)(C0.lds + LDSCTL_OFF);
    if (C0.tid < 64) MISC[C0.tid] = 0u;
    __syncthreads();
    const int lo = args.ph_lo, hi = args.ph_hi;
    XcdBarrier bar; bar.bar = (unsigned*)(C0.ws + WS_CTL) + 4096 + args.li * XCD_BAR_WORDS; bar.x = 0; bar.st = nullptr;
    if (hi - lo > 1) bar = xcd_barrier_post((unsigned*)(C0.ws + WS_CTL) + 4096 + args.li * XCD_BAR_WORDS, MISC + 8);
    const bool skip_inplace = (args.flags & 1) != 0; const int pflags = args.flags;
#ifndef SUB_MASK
#define SUB_MASK 0xffff
#endif
#define SUB(k) ((SUB_MASK >> (k)) & 1)
#ifndef PHASE_MASK
#define PHASE_MASK 0x3fff
#endif
#define IN(p) (((PHASE_MASK >> ((p) - P)) & 1) && lo <= (p) && (p) < hi)
  \
#define SEAM(p) do { const int k_ = (p) - P; const bool nl_ = (k_ == 13) && (l + 1 < DEPTH); if ((k_ >= 0 && k_ <= 8) || nl_) { asm volatile("s_waitcnt vmcnt(0)" ::: "memory"); __syncthreads(); \
        if (threadIdx.x == 0) { if ((p) + 1 < hi) xcd_barrier_core(bar); } else { const Ctx Cs = fresh(C0); cvt_w12_seam(Cs, nl_ ? l + 1 : l, nl_ ? 0 : k_); } __syncthreads(); } \
        else if ((p) + 1 < hi) xcd_barrier(bar); } while (0)
    LAS unsigned char* lds = C0.lds;
    for (int l = 0; l < DEPTH; ++l) {
        const int P = l * NPH;
        if (l == 0 && IN(P + 0)) { const Ctx C = fresh(C0); REPLOOP(0) {
            if (SUB(0)) p0_convert(C, l, pflags, false);
            if (SUB(1)) if (l == 0) p0_x_to_hb(C);
            if (SUB(2)) p0_s5_kt(C, l);
            __syncthreads(); }
            SEAM(P + 0);
        }
        if (IN(P + 1)) { const Ctx C = fresh(C0); REPLOOP(1) {
            p1_s5_assemble<0>(C, l, 0, C.G);
            const int slot = C.bid % 3;
            if (slot == 0) cvt_w12(C, l, 0);
            __syncthreads();
            {
                int tid2 = C.tid; asm volatile("" : "+v"(tid2));
                SchedGrid S{(const char*)C.W<bf16>(WS_HB), (const char*)C.W<bf16>(WS_WIN), T / 256, 8, D * 2, D * 2, C.G, C.bid, D / 64};
                EpiInProj E{C.W<float>(WS_SS1), C.W<bf16>(WS_UX), C.W<bf16>(WS_XB), C.W<bf16>(WS_Q), C.W<float>(WS_ALR), C.W<bf16>(WS_GATES), 1.f};
                pg8::gemm_phase(lds, tid2, D * 2, D * 2, S, E); }
            __syncthreads();
            if (slot == 1) cvt_w12(C, l, 0);
            __syncthreads();
            {
                int tid2 = C.tid; asm volatile("" : "+v"(tid2));
                SchedGrid S{(const char*)C.W<unsigned char>(WS_HB8), (const char*)C.W<unsigned char>(WS_WIN8), T / 256, 12, D, D, C.G, C.bid, D / 128, 0, 1 << 30, 8};
                EpiGates E{C.W<unsigned char>(WS_GATES)};
                pg8::gemm_phase<EpiGates, SchedGrid, true, false>(lds, tid2, D, D, S, E); }
            __syncthreads();
            if (slot == 2) cvt_w12(C, l, 0);
            __syncthreads(); }
            SEAM(P + 1);
        }
        if (IN(P + 2)) { const Ctx C = fresh(C0); REPLOOP(2) {
            if (SUB(0) && !(pflags & 8)) { SchedS5 S{(const char*)C.W<bf16>(WS_UX), (const char*)C.W<bf16>(WS_S5MIN), 4, 2, 128, 256 * 512 * 2, 512 * 2, 8, C.G, C.bid, 128}; EpiXlocH E{C.W<float>(WS_XLOC)};
              pg8::gemm_phase<EpiXlocH, SchedS5, false, false, true>(lds, C.tid, UXP * 2, 512 * 2, S, E); }
            __syncthreads();
            if (SUB(1) && !(pflags & 2)) lru_pass1_all(C, l);
            if (SUB(2) && !(pflags & 4)) gla_pass1_all(C, l);
            __syncthreads(); }
            SEAM(P + 2);
        }
        if (IN(P + 3)) { const Ctx C = fresh(C0); REPLOOP(3) {
            s5_scan(C, l);
            if (C.bid >= 32) { Ctx C2 = C; C2.bid = C.bid - 32; lru_carry(C2); }
            if (!skip_inplace) gla_scan(C);
            if (C.G > 96) { if (C.bid >= 48) p1_s5_assemble<1>(C, l, 48, C.G - 48); } else p1_s5_assemble<1>(C, l, 0, C.G);
            __syncthreads(); cvt_w12(C, l, 1);
            __syncthreads(); }
            SEAM(P + 3);
        }
        if (IN(P + 4)) { const Ctx C = fresh(C0); REPLOOP(4) {
            if (SUB(0)) { SchedS5 S{(const char*)C.W<bf16>(WS_UX), (const char*)C.W<bf16>(WS_S5BT2), 4, 2, 128, 512 * UXP * 2, UXP * 2, 12, C.G, C.bid}; EpiS5Out E{C.W<bf16>(WS_Z)};
              pg8::gemm_phase(lds, C.tid, UXP * 2, UXP * 2, S, E); }
            if (SUB(1)) lru_pass2(C);
            if (SUB(2)) for (int u = C.bid; u < 512; u += C.G) gla_pass2_unit(C, l, u);
            __syncthreads(); }
            SEAM(P + 4);
        }
        if (IN(P + 5)) { const Ctx C = fresh(C0); REPLOOP(5) {
            SchedGrid S{(const char*)C.W<bf16>(WS_Z), (const char*)C.W<bf16>(WS_WGLU), T / 256, 1, 512, 512, C.G, C.bid, 4}; EpiGlu E{C.W<bf16>(WS_Z), C.W<bf16>(WS_YCAT)};
            pg8::gemm_phase(lds, C.tid, 512, 512, S, E);
            __syncthreads(); cvt_w12(C, l, 2);
            __syncthreads(); }
            SEAM(P + 5);
        }
        if (IN(P + 6)) { const Ctx C = fresh(C0); REPLOOP(6) {
            SchedUp S{(const char*)C.W<bf16>(WS_YCAT), (const char*)C.W<bf16>(WS_WUP), C.G, C.bid}; EpiUp E{C.W<unsigned char>(WS_GATES), C.W<bf16>(WS_MERGED)};
            pg8::gemm_phase<EpiUp, SchedUp, false, false, true>(lds, C.tid, D * 2, D * 2, S, E);
            __syncthreads(); }
            SEAM(P + 6);
        }
        if (IN(P + 7)) { const Ctx C = fresh(C0); REPLOOP(7) {
            SchedGrid S{(const char*)C.W<bf16>(WS_MERGED), (const char*)C.W<bf16>(WS_WMIX), T / 256, 4, D * 2, D * 2, C.G, C.bid, 16}; EpiMix E{C.W<bf16>(WS_HB), C.W<bf16>(WS_HB2)};
            pg8::gemm_phase(lds, C.tid, D * 2, D * 2, S, E);
            __syncthreads(); }
            SEAM(P + 7);
        }
        if (IN(P + 8)) { const Ctx C = fresh(C0); REPLOOP(8) { router_phase(C); __syncthreads(); } SEAM(P + 8); }
        if (IN(P + 9)) { const Ctx C = fresh(C0); REPLOOP(9) { topk_phase(C); __syncthreads(); cvt_w12(C, l, 3); __syncthreads(); } SEAM(P + 9); }
        if (IN(P + 11)) { const Ctx C = fresh(C0); REPLOOP(11) {
            SchedFfn S{(const char*)C.W<unsigned char>(WS_XN8), (const char*)C.W<unsigned char>(WS_W1), 16, D, D, 8, C.G, C.bid, (size_t)4096 * D}; EpiFfn1 E{C.W<unsigned char>(WS_HID)};
            pg8::gemm_phase<EpiFfn1, SchedFfn, true, true>(lds, C.tid, D, D, S, E, C.W<int>(WS_IDX), (const char*)C.W<unsigned char>(WS_XN8));
            __syncthreads(); }
            SEAM(P + 11);
        }
        if (IN(P + 12)) { const Ctx C = fresh(C0); REPLOOP(12) {
            SchedFfn S{(const char*)C.W<unsigned char>(WS_HID), (const char*)C.W<unsigned char>(WS_W2), 4, FF, FF, 16, C.G, C.bid, (size_t)D * FF}; EpiFfn2 E{C.W<float>(WS_GATEP), C.W<unsigned char>(WS_XE)};
            pg8::gemm_phase<EpiFfn2, SchedFfn, true, false>(lds, C.tid, FF, FF, S, E);
            __syncthreads(); }
            SEAM(P + 12);
        }
        if (IN(P + 13)) { const Ctx C = fresh(C0); REPLOOP(13) { combine_phase(C, l); if (l + 1 < DEPTH) { p0_convert(C, l + 1, pflags, false); p0_s5_kt(C, l + 1); } __syncthreads(); } SEAM(P + 13); }
    }
#undef IN
#undef SEAM
}


#ifndef MK_DEBUG
#define MK_DEBUG 0
#endif
#if MK_DEBUG
constexpr size_t WS_DIAG = 512 * 1024;
__global__ void dbg_scan(const void* p, size_t n, int is_f32, unsigned code, unsigned* diag, float thr = 3e38f) {
    bool bad = false;
    for (size_t i = (size_t)blockIdx.x * blockDim.x + threadIdx.x; i < n; i += (size_t)gridDim.x * blockDim.x) {
        float v; if (is_f32) v = ((const float*)p)[i]; else v = __builtin_bit_cast(float, (unsigned)((const unsigned short*)p)[i] << 16);
        bad |= !(fabsf(v) <= thr); }
    if (bad) atomicMin(diag + 2, code);
}
__global__ void dbg_oin(const unsigned short* p, unsigned* diag) {
    unsigned fl = 0;
    for (size_t i = (size_t)blockIdx.x * blockDim.x + threadIdx.x; i < (size_t)T * 256; i += (size_t)gridDim.x * blockDim.x) {
        const float v = __builtin_bit_cast(float, (unsigned)p[i] << 16); if (!(fabsf(v) <= 1e30f)) { const int col = (int)(i & 255), row = (int)(i >> 8); fl |= 1u << ((col & 63) >> 4); fl |= 16u << ((row & 63) >> 5); atomicAdd(diag + 1, 1u); } }
    if (fl) atomicOr(diag, fl);
}
__global__ void dbg_report(float* out, size_t n, const unsigned* diag) {
    unsigned k = diag[2]; if (k > 60u) return;
    const float c = sqrtf((float)k * 0.1f);
    for (size_t i = (size_t)blockIdx.x * blockDim.x + threadIdx.x; i < n; i += (size_t)gridDim.x * blockDim.x) out[i] = c;
}
#endif

extern "C" void kernel_launch(void* const* d_in, const int* in_sizes, int n_in, void* d_out, int out_size, void* d_ws, size_t ws_size, hipStream_t stream) {
    static int grid = 0;
    if (grid == 0) {
        if (n_in != 32 || ws_size < WS_END) { fprintf(stderr, "kernel_launch: unexpected n_in %d or ws_size %zu (need %zu)\n", n_in, ws_size, (size_t)WS_END); grid = -1; return; }
        int dev = 0, cus = 0, per_cu = 0;
        if (hipGetDevice(&dev) != hipSuccess || hipDeviceGetAttribute(&cus, hipDeviceAttributeMultiprocessorCount, dev) != hipSuccess) { grid = -1; return; }
        if (hipFuncSetAttribute((const void*)mega_fwd, hipFuncAttributeMaxDynamicSharedMemorySize, LDS_BYTES) != hipSuccess) { fprintf(stderr, "kernel_launch: hipFuncSetAttribute failed\n"); grid = -1; return; }
        if (hipOccupancyMaxActiveBlocksPerMultiprocessor(&per_cu, (const void*)mega_fwd, 512, LDS_BYTES) != hipSuccess || per_cu < 1) fprintf(stderr, "kernel_launch: occupancy query says %d\n", per_cu);
        (void)hipGetLastError();
        grid = cus;
    }
    if (grid < 0) return;
    (void)hipMemsetAsync((char*)d_ws + WS_CTL, 0, CTL_BYTES, stream);
#if MK_DEBUG
    (void)hipMemsetAsync((char*)d_ws + WS_DIAG, 0x7f, 64, stream);
#endif
    Args a{};
    for (int i = 0; i < 32; ++i) a.in[i] = (const float*)d_in[i];
    a.out = (float*)d_out; a.ws = (unsigned char*)d_ws;
#if MK_PER_PHASE
    for (int p = 0; p < DEPTH * NPH; ++p) { a.ph_lo = p; a.ph_hi = p + 1; a.li = 0; a.flags = 0; hipLaunchKernelGGL(mega_fwd, dim3(grid), dim3(512), LDS_BYTES, stream, a);
#if MK_DEBUG
        { unsigned char* w = (unsigned char*)d_ws; unsigned* diag = (unsigned*)(w + WS_DIAG); const unsigned code = (unsigned)p + 1u; const int ph = p % NPH, l = p / NPH;
#define SCAN(off, n, f) hipLaunchKernelGGL(dbg_scan, dim3(1024), dim3(256), 0, stream, (const void*)(w + (off)), (size_t)(n), (f), code, diag, 1e30f)
          if (ph == 0) { SCAN(WS_WIN, (size_t)NIN * D, 0); SCAN(WS_W1, (size_t)NE * 4096 * D, 0); SCAN(WS_W2, (size_t)NE * D * FF, 0); SCAN(WS_WUP, (size_t)D * D, 0); SCAN(WS_WMIX, (size_t)D * D, 0); SCAN(WS_WGLU, 65536, 0);
                         SCAN(WS_S5MIN, (size_t)16 * 256 * 512, 0); SCAN(WS_S5BT2, (size_t)16 * 512 * 768, 0); SCAN(WS_LRUW, 131072, 0); SCAN(WS_WRT, 32768, 0); if (l == 0) { SCAN(WS_HB, (size_t)T * D, 0); SCAN(WS_SS1, T, 1); } }
          if (ph == 1) { SCAN(WS_XB, (size_t)T * 512, 0); SCAN(WS_Q, (size_t)T * 1024, 0); SCAN(WS_ALR, (size_t)T * 32, 1); SCAN(WS_GATES, (size_t)T * 3072, 0); }
          if (false) hipLaunchKernelGGL(dbg_oin, dim3(1024), dim3(256), 0, stream, (const unsigned short*)(w + WS_OIN), diag);
          if (false) {
#define SCANT(off, n, f, cd, th) hipLaunchKernelGGL(dbg_scan, dim3(1024), dim3(256), 0, stream, (const void*)(w + (off)), (size_t)(n), (f), (unsigned)(cd), diag, (float)(th))
              SCANT(WS_HB, (size_t)T * D, 0, 1, 10.f); SCANT(WS_SS1, T, 1, 2, 3000.f); SCANT(WS_XB, (size_t)T * 512, 0, 4, 30.f); SCANT(WS_Q, (size_t)T * 1024, 0, 8, 30.f); SCANT(WS_GATES, (size_t)T * 3072, 0, 16, 1.01f); SCANT(WS_WIN, (size_t)NIN * D, 0, 32, 1.f); }
          if (ph == 2) { SCAN(WS_XLOC, (size_t)16 * 1024 * 256, 1); SCAN(WS_YLOC, (size_t)T * 512 * 3, 0); SCAN(WS_LSUM, (size_t)512 * 512 * 4, 1); SCAN(WS_OIN, (size_t)T * 256 * 3, 0); SCAN(WS_KV, (size_t)2048 * 2 * 4096, 0); SCAN(WS_GDEC, (size_t)2048 * 128, 1); }
          if (ph == 3) { SCAN(WS_UX, (size_t)16 * 1024 * 768, 0); SCAN(WS_LCAR, (size_t)512 * 512 * 2, 1); SCAN(WS_KV, (size_t)2048 * 2 * 4096, 0); }
          if (ph == 4) { SCAN(WS_Z, (size_t)T * 256, 0); }
          if (ph == 5) { SCAN(WS_YCAT, (size_t)T * 1024, 0); }
          if (ph == 6) { SCAN(WS_MERGED, (size_t)T * 1024, 0); }
          if (ph == 7) { SCAN(WS_HB2, (size_t)T * 1024, 0); }
          if (ph == 8) { SCAN(WS_PROBS, (size_t)128 * 4096, 1); SCAN(WS_SS2, T, 1); }
          if (ph == 9) { SCAN(WS_GATEP, 65536, 1); }
          if (ph == 10) { SCAN(WS_XE, (size_t)65536 * 1024, 0); }
          if (ph == 11) { SCAN(WS_HID, (size_t)65536 * 2048, 0); }
          if (ph == 12) { SCAN(WS_XE, (size_t)65536 * 1024, 0); }
          if (ph == 13) { if (l == 0) { SCAN(WS_HB, (size_t)T * D, 0); SCAN(WS_SS1, T, 1); } else hipLaunchKernelGGL(dbg_scan, dim3(1024), dim3(256), 0, stream, (const void*)d_out, (size_t)T * D, 1, code, diag, 1e30f); }
#undef SCAN
        }
#endif
    }
#if MK_DEBUG
    hipLaunchKernelGGL(dbg_report, dim3(1024), dim3(256), 0, stream, (float*)d_out, (size_t)T * D, (const unsigned*)((unsigned char*)d_ws + WS_DIAG));
#endif
#elif MK_PROBE >= 0
    { const int k = MK_PROBE; const int seg[6][3] = {{0, k + 1, 0}, {k, k + 1, MK_PROBE_FLAGS_SET}, {k + 1, NPH + k + 1, 0}, {NPH + k, NPH + k + 1, MK_PROBE_FLAGS_SET}, {NPH + k + 1, 2 * NPH, 0}, {0, 0, 0}};
      for (int i = 0; i < 5; ++i) { if (seg[i][1] <= seg[i][0]) continue; a.ph_lo = seg[i][0]; a.ph_hi = seg[i][1]; a.li = i; a.flags = seg[i][2]; hipLaunchKernelGGL(mega_fwd, dim3(grid), dim3(512), LDS_BYTES, stream, a); } }
#else
    a.ph_lo = 0; a.ph_hi = DEPTH * NPH; a.li = 0; a.flags = 0;
    hipLaunchKernelGGL(mega_fwd, dim3(grid), dim3(512), LDS_BYTES, stream, a);
#endif
    (void)out_size; (void)in_sizes;
}
```

```cpp
#include <hip/hip_runtime.h>
#include <cstdio>
#include <cstdint>

#define MK_PROBE_SET -1
#define MK_PROBE_FLAGS_SET 1
#define MK_PROBE MK_PROBE_SET
#define MK_REPEAT 0
#ifndef MK_PER_PHASE
#define MK_PER_PHASE 0
#endif

#define GAS __attribute__((address_space(1)))
#define LAS __attribute__((address_space(3)))
typedef unsigned short bf16;
typedef short bf16x8 __attribute__((ext_vector_type(8)));
typedef float f32x4 __attribute__((ext_vector_type(4)));
typedef float f32x2 __attribute__((ext_vector_type(2)));
typedef unsigned u32x4 __attribute__((ext_vector_type(4)));
typedef unsigned u32x2 __attribute__((ext_vector_type(2)));

constexpr int NBATCH = 8, SEQ = 4096, T = NBATCH * SEQ, D = 1024, DEPTH = 2;
constexpr int NIN = 5120;
constexpr int IN_W = 4896;
constexpr int NE = 16, FF = 2048, CAP = 512;
constexpr int S5L = 32, S5NCH = SEQ / S5L;
constexpr int S5ROWS = NBATCH * S5NCH;
constexpr int UXP = 768;
constexpr float EPS = 1e-6f;
constexpr float SA8 = 16.f, SW8 = 256.f, SH8 = 8.f, SY8 = 64.f;
constexpr int NPH = 14;

constexpr size_t MiB = 1u << 20;
constexpr size_t WS_CTL = 0, CTL_BYTES = 1 * MiB;
constexpr size_t WS_SS1 = 1 * MiB;
constexpr size_t WS_SS2 = WS_SS1 + 128 * 1024;
constexpr size_t WS_IDX = WS_SS2 + 128 * 1024;
constexpr size_t WS_GATEP = WS_IDX + 256 * 1024;
constexpr size_t WS_LRUW = WS_GATEP + 256 * 1024;
constexpr size_t WS_WRT = 2 * MiB;
constexpr size_t WS_LRUC8 = 2 * MiB + 128 * 1024;
constexpr size_t WS_SEL = 3 * MiB;
constexpr size_t WS_GDEC = 4 * MiB;
constexpr size_t WS_PROBS = 5 * MiB;
constexpr size_t WS_LSUM = 7 * MiB;
constexpr size_t WS_LCAR = 11 * MiB;
constexpr size_t WS_XLOC = 13 * MiB;
constexpr size_t WS_WGLU = 29 * MiB;
constexpr size_t WS_WUP = 30 * MiB;
constexpr size_t WS_WMIX = 32 * MiB;
constexpr size_t WS_S5MIN = 34 * MiB;
constexpr size_t WS_S5BT2 = 38 * MiB;
constexpr size_t WS_WIN = 50 * MiB;
constexpr size_t WS_WIN8 = 54 * MiB;
constexpr size_t WS_W1 = 60 * MiB;
constexpr size_t WS_W2 = 188 * MiB;
constexpr size_t WS_HB = 252 * MiB;
constexpr size_t WS_HB2 = 316 * MiB;
constexpr size_t WS_STAGE = 380 * MiB;
constexpr size_t WS_UX = WS_STAGE;
constexpr size_t WS_XB = WS_UX + 24 * MiB;
constexpr size_t WS_Q = WS_XB + 32 * MiB;
constexpr size_t WS_K = WS_Q + 16 * MiB;
constexpr size_t WS_V = WS_K + 16 * MiB;
constexpr size_t WS_SOG = WS_V + 16 * MiB;
constexpr size_t WS_ALR = WS_SOG + 16 * MiB;
constexpr size_t WS_GATES = WS_ALR + 4 * MiB;
constexpr size_t WS_YLOC = WS_GATES + 192 * MiB;
constexpr size_t WS_PF = WS_YLOC + 32 * MiB;
constexpr size_t WS_PB = WS_PF + 32 * MiB;
constexpr size_t WS_OIN = WS_PB + 32 * MiB;
constexpr size_t WS_QDF = WS_OIN + 16 * MiB;
constexpr size_t WS_QDB = WS_QDF + 16 * MiB;
constexpr size_t WS_KV = WS_QDB + 16 * MiB;
constexpr size_t WS_Z = WS_KV + 32 * MiB;
constexpr size_t WS_YCAT = WS_Z + 16 * MiB;
constexpr size_t WS_MIXEND = WS_YCAT + 64 * MiB;
constexpr size_t WS_MERGED = WS_XB;
constexpr size_t WS_XE = WS_STAGE;
constexpr size_t WS_HB8 = WS_STAGE + 400 * MiB;
constexpr size_t WS_XN8 = WS_STAGE + 400 * MiB;
constexpr size_t WS_HID = WS_STAGE + 128 * MiB;
constexpr size_t WS_END = (WS_MIXEND > WS_HID + 256 * MiB) ? WS_MIXEND : (WS_HID + 256 * MiB);
static_assert(WS_END <= 1000 * MiB && WS_XN8 >= WS_HID + 256 * MiB && WS_XN8 + 32 * MiB <= WS_END, "workspace map");

constexpr int LDS_BYTES = 160 * 1024;
constexpr int LDSCTL_OFF = LDS_BYTES - 1024;

__device__ __forceinline__ unsigned f2bf(float f) { unsigned u = __builtin_bit_cast(unsigned, f); return (u + 0x7fffu + ((u >> 16) & 1u)) >> 16; }
__device__ __forceinline__ float bf2f(unsigned h) { return __builtin_bit_cast(float, h << 16); }
typedef __bf16 bf16x2_t __attribute__((ext_vector_type(2)));
__device__ __forceinline__ unsigned cvt_pk_bf16(float lo, float hi) { const f32x2 v = {lo, hi}; return __builtin_bit_cast(unsigned, __builtin_convertvector(v, bf16x2_t)); }
__device__ __forceinline__ float bflo(unsigned w) { return __builtin_bit_cast(float, w << 16); }
__device__ __forceinline__ float bfhi(unsigned w) { return __builtin_bit_cast(float, w & 0xffff0000u); }
__device__ __forceinline__ float rcpf_(float x) { return __builtin_amdgcn_rcpf(x); }
__device__ __forceinline__ int   shx_(int v, int off, int lane)   { return __builtin_amdgcn_ds_bpermute((lane ^ off) << 2, v); }
__device__ __forceinline__ float shxf_(float v, int off, int lane) { return __builtin_bit_cast(float, __builtin_amdgcn_ds_bpermute((lane ^ off) << 2, __builtin_bit_cast(int, v))); }
__device__ __forceinline__ unsigned shdn_(unsigned v, int off, int lane) { return (unsigned)__builtin_amdgcn_ds_bpermute(((lane + off) & 63) << 2, (int)v); }
__device__ __forceinline__ unsigned shup_(unsigned v, int off, int lane) { return (unsigned)__builtin_amdgcn_ds_bpermute(((lane - off) & 63) << 2, (int)v); }
__device__ __forceinline__ float sigmoid_(float x) { return rcpf_(1.f + __expf(-x)); }
__device__ __forceinline__ float silu_(float x) { return x * sigmoid_(x); }
__device__ __forceinline__ float gelu_tanh_(float x) { const float u = 0.7978845608028654f * (x + 0.044715f * x * x * x); return x * sigmoid_(2.f * u); }
__device__ __forceinline__ float logsig_(float x) { return fminf(x, 0.f) - __logf(1.f + __expf(-fabsf(x))); }
__device__ __forceinline__ void unpack8(const u32x4 w, float (&o)[8]) { o[0] = bflo(w.x); o[1] = bfhi(w.x); o[2] = bflo(w.y); o[3] = bfhi(w.y); o[4] = bflo(w.z); o[5] = bfhi(w.z); o[6] = bflo(w.w); o[7] = bfhi(w.w); }
__device__ __forceinline__ u32x4 pack8(const float (&v)[8]) { u32x4 w; w.x = cvt_pk_bf16(v[0], v[1]); w.y = cvt_pk_bf16(v[2], v[3]); w.z = cvt_pk_bf16(v[4], v[5]); w.w = cvt_pk_bf16(v[6], v[7]); return w; }
__device__ __forceinline__ float clamp8_(float x) { return __builtin_amdgcn_fmed3f(x, -448.f, 448.f); }
__device__ __forceinline__ void unpack8_fp8(const u32x2 w, float (&o)[8]) { const f32x2 a = __builtin_amdgcn_cvt_pk_f32_fp8((int)w.x, false), b = __builtin_amdgcn_cvt_pk_f32_fp8((int)w.x, true), c = __builtin_amdgcn_cvt_pk_f32_fp8((int)w.y, false), d = __builtin_amdgcn_cvt_pk_f32_fp8((int)w.y, true);
    o[0] = a.x; o[1] = a.y; o[2] = b.x; o[3] = b.y; o[4] = c.x; o[5] = c.y; o[6] = d.x; o[7] = d.y; }
__device__ __forceinline__ unsigned pack4_fp8(float a, float b, float c, float d) { int r = 0; r = __builtin_amdgcn_cvt_pk_fp8_f32(a, b, r, false); r = __builtin_amdgcn_cvt_pk_fp8_f32(c, d, r, true); return (unsigned)r; }
typedef int i32x8 __attribute__((ext_vector_type(8)));
typedef int i32x4 __attribute__((ext_vector_type(4)));
#define LDS_WAIT() asm volatile("s_waitcnt lgkmcnt(0)" ::: "memory")
#define VM_WAIT() asm volatile("s_waitcnt vmcnt(0)" ::: "memory")
#define MFMA16(a, b, c) __builtin_amdgcn_mfma_f32_16x16x32_bf16((a), (b), (c), 0, 0, 0)

#define XB_TMO      128
#define XB_XCNT(j)  (256  + 64 * (j))
#define XB_XSUB(j)  (1280 + 64 * (j))
#define XB_XGEN(j)  (2304 + 64 * (j))
#define XB_TOP      3328
#define XB_TOPGEN   3392
#define XCD_BAR_WORDS 3456
#define XB_SPIN_CAP (1u << 18)
__device__ __forceinline__ unsigned xb_ld(unsigned* p)              { return __hip_atomic_load(p, __ATOMIC_RELAXED, __HIP_MEMORY_SCOPE_AGENT); }
__device__ __forceinline__ unsigned xb_add(unsigned* p, unsigned v) { return __hip_atomic_fetch_add(p, v, __ATOMIC_RELAXED, __HIP_MEMORY_SCOPE_AGENT); }
__device__ __forceinline__ unsigned xb_xcc_id() { return (unsigned)__builtin_amdgcn_s_getreg((3 << 11) | 20) & 0xFu; }
#define XB_SPIN(cond, bar) do { unsigned _sp = 0; while (cond) { __builtin_amdgcn_s_sleep(1); \
    if ((++_sp & 255u) == 0u) { if (xb_ld(&(bar)[XB_TMO])) break; if (_sp > XB_SPIN_CAP) { atomicAdd(&(bar)[XB_TMO], 1u); break; } } } } while (0)
struct XcdBarrier { unsigned* bar; unsigned x; volatile LAS unsigned* st; };
__device__ __forceinline__ XcdBarrier xcd_barrier_post(unsigned* bar, volatile LAS unsigned* st) {
    XcdBarrier b; b.bar = bar; b.x = xb_xcc_id(); b.st = st;
    if (threadIdx.x == 0) (void)xb_add(&bar[XB_XCNT(b.x)], 1u);
    return b;
}
__device__ __forceinline__ void xcd_barrier_complete(unsigned* bar, unsigned x, unsigned& nloc, unsigned& nx) {
    const unsigned G = gridDim.x * gridDim.y * gridDim.z;
    unsigned sum, cnt, mine, sp = 0u;
    for (;;) {
        sum = 0u; cnt = 0u; mine = 0u;
#pragma unroll
        for (unsigned j = 0; j < 16; ++j) { const unsigned c = xb_ld(&bar[XB_XCNT(j)]); sum += c; cnt += (c > 0u) ? 1u : 0u; mine = (j == x) ? c : mine; }
        if (sum == G) break;
        __builtin_amdgcn_s_sleep(1);
        if ((++sp & 255u) == 0u) { if (xb_ld(&bar[XB_TMO])) break; if (sp > XB_SPIN_CAP) { atomicAdd(&bar[XB_TMO], 1u); break; } }
    }
    nloc = mine > 0u ? mine : 1u; nx = cnt > 0u ? cnt : 1u;
}
__device__ __forceinline__ void xcd_barrier_core(const XcdBarrier& b) {
    {
        unsigned* bar = b.bar;
        __builtin_amdgcn_s_waitcnt(0);
        unsigned nloc = b.st[0], nx = b.st[1];
        if (nloc == 0u) { xcd_barrier_complete(bar, b.x, nloc, nx); b.st[0] = nloc; b.st[1] = nx; }
        const unsigned old = xb_add(&bar[XB_XSUB(b.x)], 1u);
        const unsigned gen = old / nloc;
        if (old + 1u == (gen + 1u) * nloc) {
            __builtin_amdgcn_fence(__ATOMIC_RELEASE, "agent");
            asm volatile("s_waitcnt vmcnt(0)" ::: "memory");
            const unsigned og = xb_add(&bar[XB_TOP], 1u);
            const unsigned tg = og / nx, target = (tg + 1u) * nx;
            if (og + 1u != target) XB_SPIN(xb_ld(&bar[XB_TOP]) < target, bar);
            __builtin_amdgcn_fence(__ATOMIC_ACQUIRE, "agent");
            asm volatile("s_waitcnt vmcnt(0)" ::: "memory");
        } else {
            const unsigned target = (gen + 1u) * nx;
            XB_SPIN(xb_ld(&bar[XB_TOP]) < target, bar);
            __builtin_amdgcn_fence(__ATOMIC_ACQUIRE, "agent");
            asm volatile("s_waitcnt vmcnt(0)" ::: "memory");
        }
    }
}
__device__ __forceinline__ void xcd_barrier(const XcdBarrier& b) {
    asm volatile("s_waitcnt vmcnt(0)" ::: "memory");
    __syncthreads();
    if (threadIdx.x == 0) xcd_barrier_core(b);
    __syncthreads();
}

namespace pg8 {
template <class E, class = void> struct acc0_of { static constexpr float v = 0.f; };
template <class E> struct acc0_of<E, decltype((void)E::ACC0)> { static constexpr float v = E::ACC0; };
constexpr int BM = 256, BK = 64, HALF = 128, HTB = HALF * BK * 2, STAGE_BYTES = 8 * HTB, NXCD = 8, WGM = 8;
__host__ __device__ __forceinline__ int lds_byte(int r, int c) { const int st = (r >> 4) * 2 + (c >> 5), rr = r & 15, cc = c & 31, ob = rr * 64 + cc * 2; return st * 1024 + (ob ^ (((ob >> 9) & 1) << 5)); }
__host__ __device__ __forceinline__ void stage_rc(int b, int& R, int& C) { const int st = b / 1024, sb = b % 1024, swz = sb ^ (((sb >> 9) & 1) << 5); R = (st >> 1) * 16 + swz / 64; C = (st & 1) * 32 + (swz % 64) / 2; }
__host__ __device__ __forceinline__ int perm32(int rho) { const int n = rho >> 4, i = rho & 15; return 8 * (i >> 2) + 4 * n + (i & 3); }

struct Unit { const char* a; const char* b; int row0, pn, aux, nt; };

__device__ __forceinline__ void tile_of(int L, int nM, int nN, int& pm, int& pn) {
    const int nwg = nM * nN; int wgid = L;
    { const int q = nwg / NXCD, r = nwg % NXCD, xcd = wgid % NXCD, off = wgid / NXCD; wgid = (xcd < r ? xcd * (q + 1) : r * (q + 1) + (xcd - r) * q) + off; }
    const int nig = WGM * nN, gid = wgid / nig, fm = gid * WGM, gsz = (nM - fm) < WGM ? (nM - fm) : WGM;
    pm = fm + ((wgid % nig) % gsz); pn = (wgid % nig) / gsz;
}

template <class Epi, class Sched, bool FP8 = false, bool GATHER = false, bool HALFN = false>
__device__ __forceinline__ void gemm_phase(LAS unsigned char* lds, const int tid, const int lda, const int ldb, const Sched& S, const Epi& E, const GAS int* gidx = nullptr, const char* gbaseA = nullptr) {
    const int wid = __builtin_amdgcn_readfirstlane(tid >> 6), lane = tid & 63, wr = wid >> 2, wc = wid & 3, fr = lane & 15, fq = lane >> 4;
    unsigned voffA[2], voffB[2]; unsigned gC = 0; int gR0 = 0;
#pragma unroll
    for (int i = 0; i < 2; ++i) { int R, C; stage_rc(tid * 16 + i * 8192, R, C); const int Rb = Epi::PERM ? ((R & ~31) + perm32(R & 31)) : R;
        voffA[i] = (unsigned)(R * lda + C * 2); voffB[i] = (unsigned)(Rb * ldb + C * 2); if (i == 0) { gR0 = R; gC = (unsigned)(C * 2); } }
    LAS unsigned* gtab = (LAS unsigned*)(lds + STAGE_BYTES);
    const size_t kstep = (size_t)(BK * 2);
    const size_t hstepA = (size_t)HALF * lda, hstepB = (size_t)HALF * ldb;
    const unsigned ldsw = (unsigned)wid * 1024u;
    const int aoff = lds_byte(wr * 64 + fr, fq * 8), boff = lds_byte(wc * 32 + fr, fq * 8);
    unsigned voffG[2] = {0u, 0u}; const char* gatesb = nullptr;
    if constexpr (HALFN && Epi::NSEG > 1) { gatesb = (const char*)E.gates;
#pragma unroll
        for (int i = 0; i < 2; ++i) { const int q = (i * 512 + tid) * 16; voffG[i] = (unsigned)((q >> 7) * 3072 + (q & 127)); } }
#define PG8_GPF(c, h) (gatesb + (size_t)(cur.row0 + 128 * (h)) * 3072 + (((c) >= 4) + ((c) >= 12)) * 1024 + cur.pn * 128)
#define PG8_STAGE_B1(bufoff, gaddr, c, h) do { if constexpr (HALFN && Epi::NSEG > 1) { PG8_STAGE(bufoff, PG8_GPF(c, h), voffG); } else { PG8_STAGE(bufoff, gaddr, voffB); } } while (0)
#define PG8_SA(b, h) (((b) * 2 + (h)) * HTB)
#define PG8_SB(b, h) ((4 + (b) * 2 + (h)) * HTB)
#define PG8_STAGE(bufoff, gbase, voff) do { _Pragma("unroll") for (int _i = 0; _i < 2; ++_i) \
        __builtin_amdgcn_global_load_lds((const unsigned*)((const char*)(gbase) + (voff)[_i]), (LAS unsigned*)(lds + (bufoff) + ldsw + _i * 8192), 16, 0, 0); } while (0)
#define PG8_LD8(p, koff) __builtin_shufflevector(*(const LAS i32x4*)(p), *(const LAS i32x4*)((p) + (koff)), 0, 1, 2, 3, 4, 5, 6, 7)
#define PG8_LDA(dst, b, h) do { _Pragma("unroll") for (int m = 0; m < 4; ++m) dst[m] = PG8_LD8(lds + PG8_SA(b, h) + aoff + m * 2048, 1024); } while (0)
#define PG8_LDB(dst, b, h) do { _Pragma("unroll") for (int n = 0; n < 2; ++n) dst[n] = PG8_LD8(lds + PG8_SB(b, h) + boff + n * 2048, 1024); } while (0)
#define PG8_LO(x) __builtin_bit_cast(bf16x8, __builtin_shufflevector((x), (x), 0, 1, 2, 3))
#define PG8_HI(x) __builtin_bit_cast(bf16x8, __builtin_shufflevector((x), (x), 4, 5, 6, 7))
#define PG8_MMA(ai, bj, At, Bt) do { if constexpr (FP8) { asm volatile("s_setprio 1"); _Pragma("unroll") for (int m = 0; m < 4; ++m) _Pragma("unroll") for (int n = 0; n < 2; ++n) \
        asm volatile("v_mfma_scale_f32_16x16x128_f8f6f4 %0, %1, %2, %0, %3, %4 op_sel_hi:[0,0,0]" : "+v"(acc[ai][bj][m][n]) : "v"(Bt[n]), "v"(At[m]), "v"(mscale), "v"(mscale2)); asm volatile("s_setprio 0"); } else { \
        asm volatile("s_setprio 1");   \
        _Pragma("unroll") for (int m = 0; m < 4; ++m) _Pragma("unroll") for (int n = 0; n < 2; ++n) asm volatile("v_mfma_f32_16x16x32_bf16 %0, %1, %2, %0" : "+v"(acc[ai][bj][m][n]) : "v"(PG8_LO(Bt[n])), "v"(PG8_LO(At[m]))); \
        _Pragma("unroll") for (int m = 0; m < 4; ++m) _Pragma("unroll") for (int n = 0; n < 2; ++n) asm volatile("v_mfma_f32_16x16x32_bf16 %0, %1, %2, %0" : "+v"(acc[ai][bj][m][n]) : "v"(PG8_HI(Bt[n])), "v"(PG8_HI(At[m]))); \
        asm volatile("s_setprio 0"); } } while (0)
#define PG8_MMAZ(ai, bj, At, Bt) do { if constexpr (FP8) { asm volatile("s_setprio 1"); _Pragma("unroll") for (int m = 0; m < 4; ++m) _Pragma("unroll") for (int n = 0; n < 2; ++n) \
        asm volatile("v_mfma_scale_f32_16x16x128_f8f6f4 %0, %1, %2, 0, %3, %4 op_sel_hi:[0,0,0]" : "=&v"(acc[ai][bj][m][n]) : "v"(Bt[n]), "v"(At[m]), "v"(mscale), "v"(mscale2)); asm volatile("s_setprio 0"); } else { \
        asm volatile("s_setprio 1"); \
        _Pragma("unroll") for (int m = 0; m < 4; ++m) _Pragma("unroll") for (int n = 0; n < 2; ++n) asm volatile("v_mfma_f32_16x16x32_bf16 %0, %1, %2, 0" : "=&v"(acc[ai][bj][m][n]) : "v"(PG8_LO(Bt[n])), "v"(PG8_LO(At[m]))); \
        _Pragma("unroll") for (int m = 0; m < 4; ++m) _Pragma("unroll") for (int n = 0; n < 2; ++n) asm volatile("v_mfma_f32_16x16x32_bf16 %0, %1, %2, %0" : "+v"(acc[ai][bj][m][n]) : "v"(PG8_HI(Bt[n])), "v"(PG8_HI(At[m]))); \
        asm volatile("s_setprio 0"); } } while (0)
#define PG8_WAIT_V(n) asm volatile("s_waitcnt vmcnt(" #n ")" ::: "memory")
#define PG8_WAIT_L(n) asm volatile("s_waitcnt lgkmcnt(" #n ")" ::: "memory")
#define PG8_BAR __builtin_amdgcn_s_barrier()
#define PG8_SCHED __builtin_amdgcn_sched_barrier(0)
    Unit cur, nxt; int ui = 0;
    constexpr bool ZINIT = (Epi::NSEG == 1) && (acc0_of<Epi>::v == 0.f);
    if (!S.next(0, cur)) return;
    f32x4 acc[2][2][4][2];
    if constexpr (!ZINIT && Epi::NSEG == 1) {
#pragma unroll
    for (int a = 0; a < 2; ++a)
#pragma unroll
        for (int b = 0; b < 2; ++b)
#pragma unroll
            for (int m = 0; m < 4; ++m)
#pragma unroll
                for (int n = 0; n < 2; ++n) acc[a][b][m][n] = (f32x4){acc0_of<Epi>::v, acc0_of<Epi>::v, acc0_of<Epi>::v, acc0_of<Epi>::v}; }
    i32x8 At[4], B0[2], B1[2];
    int mscale = 0x7f7f7f7f, mscale2 = 0x7f7f7f7f;
    if constexpr (FP8) mscale2 = Epi::MSCALE;
    asm volatile("" : "+v"(mscale), "+v"(mscale2)); (void)mscale; (void)mscale2;
    f32x4 tot[2][4][2];
    if constexpr (Epi::NSEG > 1) {
#pragma unroll
        for (int a = 0; a < 2; ++a)
#pragma unroll
            for (int m = 0; m < 4; ++m)
#pragma unroll
                for (int n = 0; n < 2; ++n) tot[a][m][n] = (f32x4){0.f, 0.f, 0.f, 0.f}; }
    const char* cA = GATHER ? gbaseA : cur.a; const char* cB = cur.b;
    int gpar = 0;
    if constexpr (GATHER) { gtab[tid & 255] = (unsigned)gidx[cur.row0 + (tid & 255)]; __syncthreads(); }
#define PG8_STAGE_A(bufoff, h, ko, nx) do { if constexpr (GATHER) { const LAS unsigned* _t = gtab + (((nx) ? (gpar ^ 1) : gpar) * 256) + (h) * HALF + gR0; const unsigned _b = (unsigned)((((nx) ? nxt.row0 : cur.row0) >> 13) * SEQ); \
        unsigned _vo[2]; _vo[0] = (_t[0] + _b) * (unsigned)lda + gC; _vo[1] = (_t[64] + _b) * (unsigned)lda + gC; PG8_STAGE(bufoff, gbaseA + (ko), _vo); } \
        else { PG8_STAGE(bufoff, ((nx) ? nA : cA) + (h) * hstepA + (ko), voffA); } } while (0)
    const char* nA = cA;
    PG8_STAGE(PG8_SB(0, 0), cB, voffB); PG8_STAGE_B1(PG8_SB(0, 1), cB + hstepB, 0, 0); PG8_STAGE_A(PG8_SA(0, 0), 0, (size_t)0, false); PG8_STAGE_A(PG8_SA(0, 1), 1, (size_t)0, false);
    if (wr == 1) PG8_BAR;
    PG8_WAIT_V(2); PG8_BAR;
    PG8_STAGE(PG8_SB(1, 0), cB + kstep, voffB); PG8_STAGE_A(PG8_SA(1, 0), 0, kstep, false); PG8_STAGE_B1(PG8_SB(1, 1), cB + hstepB + kstep, 0, 1);
    PG8_WAIT_V(6); PG8_BAR;
#define PG8_ITER(MM) do { const bool last = (t == nt - 2); \
            const size_t k1 = (size_t)(t + 1) * kstep, k2 = last ? (size_t)0 : (size_t)(t + 2) * kstep, k3 = k2 + kstep; \
            const char* b2 = last ? nB : cB + (size_t)(t + 2) * kstep; const char* b3 = b2 + kstep; \
            PG8_LDB(B0, 0, 0); if constexpr (!HALFN) PG8_LDB(B1, 0, 1); PG8_SCHED; PG8_LDA(At, 0, 0); PG8_STAGE_A(PG8_SA(1, 1), 1, k1, false); \
            PG8_WAIT_V(8); PG8_WAIT_L(0); PG8_BAR; MM(0, 0, At, B0); if constexpr (!HALFN) MM(0, 1, At, B1); PG8_BAR; PG8_SCHED; \
            PG8_LDA(At, 0, 1); PG8_STAGE(PG8_SB(0, 0), b2, voffB); PG8_STAGE_B1(PG8_SB(0, 1), b2 + hstepB, t, 0); PG8_STAGE_A(PG8_SA(0, 0), 0, k2, last); \
            PG8_WAIT_V(8); PG8_WAIT_L(0); PG8_BAR; MM(1, 0, At, B0); if constexpr (!HALFN) MM(1, 1, At, B1); PG8_BAR; PG8_SCHED; \
            PG8_LDB(B0, 1, 0); if constexpr (!HALFN) PG8_LDB(B1, 1, 1); PG8_SCHED; PG8_LDA(At, 1, 0); PG8_STAGE_A(PG8_SA(0, 1), 1, k2, last); \
            PG8_WAIT_V(8); PG8_WAIT_L(0); PG8_BAR; PG8_MMA(0, 0, At, B0); if constexpr (!HALFN) PG8_MMA(0, 1, At, B1); PG8_BAR; PG8_SCHED; \
            PG8_LDA(At, 1, 1); PG8_STAGE(PG8_SB(1, 0), b3, voffB); PG8_STAGE_B1(PG8_SB(1, 1), b3 + hstepB, t, 1); PG8_STAGE_A(PG8_SA(1, 0), 0, k3, last); \
            PG8_WAIT_V(8); PG8_WAIT_L(0); PG8_BAR; PG8_MMA(1, 0, At, B0); if constexpr (!HALFN) PG8_MMA(1, 1, At, B1); PG8_BAR; PG8_SCHED; } while (0)
    for (;;) {
        const bool has_next = S.next(ui + 1, nxt);
        nA = GATHER ? cA : (has_next ? nxt.a : cA); const char* nB = has_next ? nxt.b : cB;
        if constexpr (GATHER) { if (!has_next) nxt = cur;
            if (wid < 4) __builtin_amdgcn_global_load_lds((const unsigned*)(gidx + nxt.row0 + wid * 64 + lane), (LAS unsigned*)(gtab + (gpar ^ 1) * 256 + wid * 64), 4, 0, 0); }
        const int nt = cur.nt;
        int t = 0;
#pragma unroll 1
        for (int sg = 0; sg < Epi::NSEG; ++sg) {
        int tend = nt; if constexpr (Epi::NSEG > 1) tend = Epi::seg_end(sg);
        if constexpr (ZINIT) { PG8_ITER(PG8_MMAZ); t = 2; }
        if constexpr (Epi::NSEG > 1) { PG8_ITER(PG8_MMAZ); t += 2; }
#pragma unroll 1
        for (; t < tend; t += 2) {
            PG8_ITER(PG8_MMA);
        }
        if constexpr (Epi::NSEG > 1) { asm volatile("s_nop 15\n\ts_nop 15" ::: "memory"); if (sg + 1 < Epi::NSEG) E.mid(acc, tot, lds + PG8_SB(0, 1), lds + PG8_SB(1, 1), cur, sg, wr, wc, fr, fq); }
        }
        asm volatile("s_nop 15\n\ts_nop 15" ::: "memory");
        if (wr == 0) PG8_BAR;
        if constexpr (Epi::NSEG > 1) E.fin(acc, tot, lds + PG8_SB(0, 1), lds + PG8_SB(1, 1), cur, wr, wc, fr, fq); else E(acc, cur, wr, wc, fr, fq);
        if (!has_next) break;
        if constexpr (!ZINIT && Epi::NSEG == 1) {
#pragma unroll
        for (int a = 0; a < 2; ++a)
#pragma unroll
            for (int b = 0; b < 2; ++b)
#pragma unroll
                for (int m = 0; m < 4; ++m)
#pragma unroll
                    for (int n = 0; n < 2; ++n) acc[a][b][m][n] = (f32x4){acc0_of<Epi>::v, acc0_of<Epi>::v, acc0_of<Epi>::v, acc0_of<Epi>::v}; }
        cur = nxt; cA = nA; cB = nB; ++ui;
        if constexpr (GATHER) gpar ^= 1;
        if (wr == 1) PG8_BAR;
    }
    PG8_WAIT_V(0);
    PG8_BAR;
#undef PG8_SA
#undef PG8_GPF
#undef PG8_STAGE_B1
#undef PG8_SB
#undef PG8_STAGE
#undef PG8_STAGE_A
#undef PG8_LD8
#undef PG8_LO
#undef PG8_HI
#undef PG8_LDA
#undef PG8_LDB
#undef PG8_MMA
#undef PG8_MMAZ
#undef PG8_ITER
#undef PG8_WAIT_V
#undef PG8_WAIT_L
#undef PG8_BAR
#undef PG8_SCHED
}
}
using pg8::Unit;

struct Args { const float* in[32]; float* out; unsigned char* ws; int ph_lo, ph_hi, li, flags; };
struct Ctx {
    unsigned long long karg; float* out; unsigned char* ws; LAS unsigned char* lds; int tid, lane, wave, G, bid;
    template <class Tp> __device__ __forceinline__ GAS Tp* W(size_t off) const { return (GAS Tp*)(ws + off); }
    template <int I> __device__ __forceinline__ const GAS float* inp() const { const float* p; asm volatile("s_load_dwordx2 %0, %1, %2\n\ts_waitcnt lgkmcnt(0)" : "=s"(p) : "s"(karg), "n"(I * 8) : "memory"); return (const GAS float*)p; }
};

__device__ __forceinline__ Ctx fresh(const Ctx& C0) {
    Ctx R = C0; asm volatile("" : "+s"(R.ws), "+s"(R.karg), "+s"(R.out));
    int ln; asm volatile("v_mbcnt_lo_u32_b32 %0, -1, 0\n\tv_mbcnt_hi_u32_b32 %0, -1, %0" : "=v"(ln));
    int t = (C0.wave << 6) | ln, b = C0.bid, g = C0.G; asm volatile("" : "+v"(t), "+s"(b), "+s"(g));
    R.out = (float*)(GAS float*)R.out; R.tid = t; R.lane = t & 63; R.wave = __builtin_amdgcn_readfirstlane(t >> 6); R.bid = b; R.G = g; return R;
}

struct SchedGrid {
    const char* A; const char* B; int nM, nN, lda, ldb, G, c, nt; int i0 = 0, i1 = 1 << 30; int pn0 = 0;
    __device__ __forceinline__ bool next(int i, Unit& u) const {
        i += i0; if (i >= i1) return false;
        const long L = (long)i * G + c; if (L >= (long)nM * nN) return false;
        int pm, pn; pg8::tile_of((int)L, nM, nN, pm, pn);
        u.a = A + (size_t)pm * 256 * lda; u.b = B + (size_t)pn * 256 * ldb; u.row0 = pm * 256; u.pn = pn + pn0; u.aux = 0; u.nt = nt; return true;
    }
};
struct SchedUp {
    const char* A; const char* B; int G, c;
    __device__ __forceinline__ bool next(int i, Unit& u) const {
        const long L = (long)i * G + c; if (L >= (long)(T / 256) * 8) return false;
        int pm, pn; pg8::tile_of((int)L, T / 256, 8, pm, pn);
        u.a = A + (size_t)pm * 256 * (D * 2); u.b = B + (size_t)pn * 128 * (D * 2); u.row0 = pm * 256; u.pn = pn; u.aux = 0; u.nt = 16; return true;
    }
};
struct SchedS5 {
    const char* A; const char* B; int nrt, nct, nunits, bstride_g  , ldb, nt, G, c; int ctrows = 256;
    __device__ __forceinline__ bool next(int i, Unit& u) const {
        const int L = i * G + c; if (L >= nunits) return false;
        const int per = nrt * nct, g = L / per, r = L % per, rt = r / nct, ct = r % nct;
        u.a = A + ((size_t)g * S5ROWS + rt * 256) * (UXP * 2); u.b = B + (size_t)g * bstride_g + (size_t)ct * ctrows * ldb; u.row0 = rt * 256; u.pn = ct; u.aux = g; u.nt = nt; return true;
    }
};
struct SchedFfn {
    const char* A; const char* B; int nN, lda, ldb, nt, G, c; size_t bstride_e;
    __device__ __forceinline__ bool next(int i, Unit& u) const {
        const long L = (long)i * G + c; if (L >= (long)256 * nN) return false;
        int vm, pn; pg8::tile_of((int)L, 256, nN, vm, pn);
        const int e = vm >> 4, rt = vm & 15, b = rt >> 1, half = rt & 1, row0 = (b * 16 + e) * 512 + half * 256;
        u.a = A + (size_t)row0 * lda; u.b = B + (size_t)e * bstride_e + (size_t)pn * 256 * ldb; u.row0 = row0; u.pn = pn; u.aux = e; u.nt = nt; return true;
    }
};

#define EPI_ROW(ai, m) (u.row0 + (ai) * 128 + wr * 64 + (m) * 16 + fr)
#define EPI_FENCE() asm volatile("" ::: "memory")
struct EpiInProj {
    static constexpr bool PERM = true; static constexpr int NSEG = 1;
    const GAS float* ss1; GAS bf16* ux; GAS bf16* xb; GAS bf16* qkvs; GAS float* alr; GAS bf16* gates; float accscale;
    __device__ __forceinline__ void operator()(const f32x4 (&acc)[2][2][4][2], const Unit& u, int wr, int wc, int fr, int fq) const {
        const int pn = u.pn;
        float rsv[2][4];
#pragma unroll
        for (int ai = 0; ai < 2; ++ai)
#pragma unroll
            for (int m = 0; m < 4; ++m) rsv[ai][m] = ss1[EPI_ROW(ai, m)];
#pragma unroll
        for (int ai = 0; ai < 2; ++ai)
#pragma unroll
            for (int m = 0; m < 4; ++m) rsv[ai][m] = __builtin_amdgcn_rsqf(rsv[ai][m] * (1.f / D) + EPS) * accscale;
        if (pn == 7) {
            if (wc == 0) {
#pragma unroll
                for (int ai = 0; ai < 2; ++ai)
#pragma unroll
                    for (int m = 0; m < 4; ++m) { const int row = EPI_ROW(ai, m); const float rs = rsv[ai][m]; const f32x4 a = acc[ai][0][m][0] * rs, b = acc[ai][0][m][1] * rs;
                        *(GAS f32x4*)(alr + (size_t)row * 32 + 8 * fq) = a; *(GAS f32x4*)(alr + (size_t)row * 32 + 8 * fq + 4) = b; }
            }
            return;
        }
        GAS bf16* base; int rstride = 0, mode = 0; const bool s5 = (pn == 0);
        if (pn == 0) base = ux; else if (pn <= 2) { base = xb + (pn - 1) * 256; rstride = 512; } else if (pn <= 6) { base = qkvs + (size_t)(pn - 3) * T * 256; rstride = 256; mode = (pn == 6) ? 1 : 0; } else { base = gates + (pn - 8) * 256; rstride = 3072; mode = 2; }
#pragma unroll
        for (int ai = 0; ai < 2; ++ai)
#pragma unroll
            for (int m = 0; m < 4; ++m) { const int row = EPI_ROW(ai, m); const float rs = rsv[ai][m];
                const size_t roff = s5 ? (size_t)(row >> 5) * UXP + (row & 31) * 16 : (size_t)row * rstride;
#pragma unroll
                for (int bj = 0; bj < 2; ++bj) {
                    const int c = bj * 128 + wc * 32 + 8 * fq; const size_t coff = s5 ? (size_t)(c >> 4) * S5ROWS * UXP + (c & 15) : (size_t)c;
                    float vv[8];
#pragma unroll
                    for (int j = 0; j < 4; ++j) { vv[j] = acc[ai][bj][m][0][j] * rs; vv[4 + j] = acc[ai][bj][m][1][j] * rs; }
                    if (mode != 0) {
#pragma unroll
                        for (int j = 0; j < 8; ++j) { const float sg = sigmoid_(vv[j]); vv[j] = (mode == 1) ? vv[j] * sg : sg; } }
                    *(GAS u32x4*)(base + roff + coff) = pack8(vv);
                }
                EPI_FENCE(); }
    }
};
struct EpiGates {
    static constexpr bool PERM = true; static constexpr int NSEG = 1; static constexpr int MSCALE = 0x73737373;
    static_assert(SA8 * SW8 == 4096.f, "MSCALE = 2^-12");
    GAS unsigned char* gates;
    __device__ __forceinline__ void operator()(const f32x4 (&acc)[2][2][4][2], const Unit& u, int wr, int wc, int fr, int fq) const {
#pragma unroll
        for (int ai = 0; ai < 2; ++ai)
#pragma unroll
            for (int m = 0; m < 4; ++m) { const int row = EPI_ROW(ai, m);
#pragma unroll
                for (int bj = 0; bj < 2; ++bj) { unsigned lo = 0u, hi = 0u;
#pragma unroll
                    for (int j = 0; j < 4; ++j) {
                        lo = __builtin_amdgcn_cvt_pk_u8_f32(rcpf_(__builtin_fmaf(__builtin_amdgcn_exp2f(-acc[ai][bj][m][0][j]), 1.f / 255.f, 1.f / 255.f)), j, lo);
                        hi = __builtin_amdgcn_cvt_pk_u8_f32(rcpf_(__builtin_fmaf(__builtin_amdgcn_exp2f(-acc[ai][bj][m][1][j]), 1.f / 255.f, 1.f / 255.f)), j, hi); }
                    *(GAS u32x2*)(gates + (size_t)row * 3072 + (u.pn - 8) * 256 + bj * 128 + wc * 32 + 8 * fq) = (u32x2){lo, hi}; }
                EPI_FENCE(); }
    }
};
struct EpiXloc {
    static constexpr bool PERM = false; static constexpr int NSEG = 1;
    GAS float* xloc;
    __device__ __forceinline__ void operator()(const f32x4 (&acc)[2][2][4][2], const Unit& u, int wr, int wc, int fr, int fq) const {
#pragma unroll
        for (int ai = 0; ai < 2; ++ai)
#pragma unroll
            for (int m = 0; m < 4; ++m) { const int row = EPI_ROW(ai, m);
                GAS float* rowp = xloc + ((size_t)u.aux * S5ROWS + row) * 256 + wc * 32 + 4 * fq;
#pragma unroll
                for (int bj = 0; bj < 2; ++bj)
#pragma unroll
                    for (int n = 0; n < 2; ++n) *(GAS f32x4*)(rowp + bj * 128 + n * 16) = acc[ai][bj][m][n];
                EPI_FENCE(); }
    }
};
struct EpiXlocH {
    static constexpr bool PERM = false; static constexpr int NSEG = 1;
    GAS float* xloc;
    __device__ __forceinline__ void operator()(const f32x4 (&acc)[2][2][4][2], const Unit& u, int wr, int wc, int fr, int fq) const {
#pragma unroll
        for (int ai = 0; ai < 2; ++ai)
#pragma unroll
            for (int m = 0; m < 4; ++m) { const int row = EPI_ROW(ai, m);
                GAS float* rowp = xloc + ((size_t)u.aux * S5ROWS + row) * 256 + u.pn * 128 + wc * 32 + 4 * fq;
#pragma unroll
                for (int n = 0; n < 2; ++n) *(GAS f32x4*)(rowp + n * 16) = acc[ai][0][m][n];
                EPI_FENCE(); }
    }
};
struct EpiS5Out {
    static constexpr bool PERM = true; static constexpr int NSEG = 1;
    GAS bf16* z;
    __device__ __forceinline__ void operator()(const f32x4 (&acc)[2][2][4][2], const Unit& u, int wr, int wc, int fr, int fq) const {
#pragma unroll
        for (int ai = 0; ai < 2; ++ai)
#pragma unroll
            for (int m = 0; m < 4; ++m) { const int row = EPI_ROW(ai, m);
#pragma unroll
                for (int bj = 0; bj < 2; ++bj) {
                    const int c = u.pn * 256 + bj * 128 + wc * 32 + 8 * fq, jj = c >> 4, h0 = c & 15;
                    float vv[8];
#pragma unroll
                    for (int j = 0; j < 4; ++j) { vv[j] = gelu_tanh_(acc[ai][bj][m][0][j]); vv[4 + j] = gelu_tanh_(acc[ai][bj][m][1][j]); }
                    *(GAS u32x4*)(z + ((size_t)row * S5L + jj) * 256 + u.aux * 16 + h0) = pack8(vv);
                }
                EPI_FENCE(); }
    }
};
struct EpiGlu {
    static constexpr bool PERM = true; static constexpr int NSEG = 1;
    const GAS bf16* z; GAS bf16* ycat;
    __device__ __forceinline__ void operator()(const f32x4 (&acc)[2][2][4][2], const Unit& u, int wr, int wc, int fr, int fq) const {
#pragma unroll
        for (int ai = 0; ai < 2; ++ai) {
            u32x4 ld[4][2];
#pragma unroll
            for (int m = 0; m < 4; ++m)
#pragma unroll
                for (int bj = 0; bj < 2; ++bj) ld[m][bj] = *(const GAS u32x4*)(z + (size_t)EPI_ROW(ai, m) * 256 + bj * 128 + wc * 32 + 8 * fq);
#pragma unroll
            for (int m = 0; m < 4; ++m)
#pragma unroll
                for (int bj = 0; bj < 2; ++bj) { const int c = bj * 128 + wc * 32 + 8 * fq; float zz[8], vv[8]; unpack8(ld[m][bj], zz);
#pragma unroll
                    for (int j = 0; j < 4; ++j) { vv[j] = zz[j] * sigmoid_(acc[ai][bj][m][0][j]); vv[4 + j] = zz[4 + j] * sigmoid_(acc[ai][bj][m][1][j]); }
                    *(GAS u32x4*)(ycat + (size_t)EPI_ROW(ai, m) * 1024 + c) = pack8(vv); }
            EPI_FENCE(); }
    }
};
struct EpiUp {
    static constexpr bool PERM = true; static constexpr int NSEG = 3;
    static __device__ __forceinline__ int seg_end(int sg) { return sg == 0 ? 4 : (sg == 1 ? 12 : 16); }
    const GAS unsigned char* gates; GAS bf16* merged;
    __device__ __forceinline__ void add(f32x4 (&acc)[2][2][4][2], f32x4 (&tot)[2][4][2], const LAS unsigned char* g0, const LAS unsigned char* g1, int wr, int wc, int fr, int fq) const {
        u32x2 lg[2][4];
#pragma unroll
        for (int ai = 0; ai < 2; ++ai)
#pragma unroll
            for (int m = 0; m < 4; ++m) lg[ai][m] = *(const LAS u32x2*)((ai ? g1 : g0) + (wr * 64 + m * 16 + fr) * 128 + wc * 32 + 8 * fq);
#pragma unroll
        for (int ai = 0; ai < 2; ++ai)
#pragma unroll
            for (int m = 0; m < 4; ++m) { float gg[8];
#pragma unroll
                for (int j = 0; j < 4; ++j) { gg[j] = (float)((lg[ai][m].x >> (8 * j)) & 255u); gg[4 + j] = (float)((lg[ai][m].y >> (8 * j)) & 255u); }
#pragma unroll
                for (int j = 0; j < 4; ++j) { tot[ai][m][0][j] += gg[j] * acc[ai][0][m][0][j]; tot[ai][m][1][j] += gg[4 + j] * acc[ai][0][m][1][j]; }
                }
    }
    __device__ __forceinline__ void mid(f32x4 (&acc)[2][2][4][2], f32x4 (&tot)[2][4][2], const LAS unsigned char* g0, const LAS unsigned char* g1, const Unit& u, int sg, int wr, int wc, int fr, int fq) const { add(acc, tot, g0, g1, wr, wc, fr, fq); }
    __device__ __forceinline__ void fin(f32x4 (&acc)[2][2][4][2], f32x4 (&tot)[2][4][2], const LAS unsigned char* g0, const LAS unsigned char* g1, const Unit& u, int wr, int wc, int fr, int fq) const {
        add(acc, tot, g0, g1, wr, wc, fr, fq);
#pragma unroll
        for (int ai = 0; ai < 2; ++ai)
#pragma unroll
            for (int m = 0; m < 4; ++m) { float vv[8];
#pragma unroll
                for (int j = 0; j < 4; ++j) { vv[j] = tot[ai][m][0][j] * (1.f / 255.f); vv[4 + j] = tot[ai][m][1][j] * (1.f / 255.f); }
                *(GAS u32x4*)(merged + (size_t)EPI_ROW(ai, m) * 1024 + u.pn * 128 + wc * 32 + 8 * fq) = pack8(vv);
                tot[ai][m][0] = (f32x4){0.f, 0.f, 0.f, 0.f}; tot[ai][m][1] = (f32x4){0.f, 0.f, 0.f, 0.f}; }
    }
    __device__ __forceinline__ void operator()(const f32x4 (&)[2][2][4][2], const Unit&, int, int, int, int) const {}
};
struct EpiMix {
    static constexpr bool PERM = true; static constexpr int NSEG = 1;
    const GAS bf16* hb; GAS bf16* hb2;
    __device__ __forceinline__ void operator()(const f32x4 (&acc)[2][2][4][2], const Unit& u, int wr, int wc, int fr, int fq) const {
        u32x4 ldq[2][4][2];
#pragma unroll
        for (int ai = 0; ai < 2; ++ai)
#pragma unroll
            for (int m = 0; m < 4; ++m)
#pragma unroll
                for (int bj = 0; bj < 2; ++bj) ldq[ai][m][bj] = *(const GAS u32x4*)(hb + (size_t)EPI_ROW(ai, m) * 1024 + u.pn * 256 + bj * 128 + wc * 32 + 8 * fq);
#pragma unroll
        for (int ai = 0; ai < 2; ++ai) {
#pragma unroll
            for (int m = 0; m < 4; ++m)
#pragma unroll
                for (int bj = 0; bj < 2; ++bj) { const int c = u.pn * 256 + bj * 128 + wc * 32 + 8 * fq; float hh[8], vv[8]; unpack8(ldq[ai][m][bj], hh);
#pragma unroll
                    for (int j = 0; j < 4; ++j) { vv[j] = hh[j] + acc[ai][bj][m][0][j]; vv[4 + j] = hh[4 + j] + acc[ai][bj][m][1][j]; }
                    *(GAS u32x4*)(hb2 + (size_t)EPI_ROW(ai, m) * 1024 + c) = pack8(vv); }
            EPI_FENCE(); }
    }
};
struct EpiFfn1 {
    static constexpr bool PERM = true; static constexpr int NSEG = 1; static constexpr int MSCALE = 0x73737373;
    static_assert(SA8 * SW8 == 4096.f, "MSCALE = 2^-12");
    GAS unsigned char* hid;
    __device__ __forceinline__ void operator()(const f32x4 (&acc)[2][2][4][2], const Unit& u, int wr, int wc, int fr, int fq) const {
#pragma unroll
        for (int ai = 0; ai < 2; ++ai)
#pragma unroll
            for (int m = 0; m < 4; ++m) { const int row = EPI_ROW(ai, m); float vv[8];
#pragma unroll
                for (int j = 0; j < 4; ++j) { const float a0 = acc[ai][0][m][0][j], a1 = acc[ai][0][m][1][j];
                    vv[j] = (a0 * acc[ai][1][m][0][j]) * rcpf_(1.f + __builtin_amdgcn_exp2f(-a0)); vv[4 + j] = (a1 * acc[ai][1][m][1][j]) * rcpf_(1.f + __builtin_amdgcn_exp2f(-a1)); }
                u32x2 o; o.x = pack4_fp8(vv[0], vv[1], vv[2], vv[3]); o.y = pack4_fp8(vv[4], vv[5], vv[6], vv[7]);
                *(GAS u32x2*)(hid + (size_t)row * FF + u.pn * 128 + wc * 32 + 8 * fq) = o;
                EPI_FENCE(); }
    }
};
struct EpiFfn2 {
    static constexpr bool PERM = true; static constexpr int NSEG = 1; static constexpr int MSCALE = 0x7f7f7f7f;
    const GAS float* gatep; GAS unsigned char* ye;
    __device__ __forceinline__ void operator()(const f32x4 (&acc)[2][2][4][2], const Unit& u, int wr, int wc, int fr, int fq) const {
        float gpv[2][4];
#pragma unroll
        for (int ai = 0; ai < 2; ++ai)
#pragma unroll
            for (int m = 0; m < 4; ++m) gpv[ai][m] = gatep[EPI_ROW(ai, m)];
#pragma unroll
        for (int ai = 0; ai < 2; ++ai)
#pragma unroll
            for (int m = 0; m < 4; ++m) { const int row = EPI_ROW(ai, m); const float gp = gpv[ai][m] * (SY8 / (SH8 * SW8));
#pragma unroll
                for (int bj = 0; bj < 2; ++bj) {
                    const int c = u.pn * 256 + bj * 128 + wc * 32 + 8 * fq;
                    float vv[8];
#pragma unroll
                    for (int j = 0; j < 4; ++j) { vv[j] = gp * acc[ai][bj][m][0][j]; vv[4 + j] = gp * acc[ai][bj][m][1][j]; }
                    u32x2 o; o.x = pack4_fp8(vv[0], vv[1], vv[2], vv[3]); o.y = pack4_fp8(vv[4], vv[5], vv[6], vv[7]);
                    *(GAS u32x2*)(ye + (size_t)row * 1024 + c) = o;
                }
                EPI_FENCE(); }
    }
};

__device__ __forceinline__ void cvt_tile(const bool F8, const GAS float* src, int sp, const GAS float* kscale, float mul, int valid, GAS void* dstv, int dp, LAS float* scr, int lane) {
    const int nn = (lane & 15) * 4, kq = lane >> 4;
    f32x4 v[16]; float ks[16];
    if (kscale) {
#pragma unroll
        for (int i = 0; i < 16; ++i) ks[i] = kscale[i * 4 + kq];
    } else {
#pragma unroll
        for (int i = 0; i < 16; ++i) ks[i] = 1.f;
    }
    if (nn < valid) {
#pragma unroll
        for (int i = 0; i < 16; ++i) v[i] = *(const GAS f32x4*)(src + (size_t)(i * 4 + kq) * sp + nn);
    } else {
#pragma unroll
        for (int i = 0; i < 16; ++i) v[i] = (f32x4){0.f, 0.f, 0.f, 0.f};
    }
#pragma unroll
    for (int i = 0; i < 16; ++i) { const int kk = i * 4 + kq; const float s = ks[i] * mul; LAS float* p = scr + kk * 65 + nn; p[0] = v[i].x * s; p[1] = v[i].y * s; p[2] = v[i].z * s; p[3] = v[i].w * s; }
    LDS_WAIT(); asm volatile("" ::: "memory");
    const int c = lane & 7;
#pragma unroll
    for (int j = 0; j < 8; ++j) { const int n = (lane >> 3) + 8 * j; const LAS float* s = scr + (8 * c) * 65 + n;
        if (F8) { u32x2 o; o.x = pack4_fp8(s[0 * 65], s[1 * 65], s[2 * 65], s[3 * 65]); o.y = pack4_fp8(s[4 * 65], s[5 * 65], s[6 * 65], s[7 * 65]); *(GAS u32x2*)((GAS unsigned char*)dstv + (size_t)n * dp + 8 * c) = o; }
        else { u32x4 o; o.x = cvt_pk_bf16(s[0 * 65], s[1 * 65]); o.y = cvt_pk_bf16(s[2 * 65], s[3 * 65]); o.z = cvt_pk_bf16(s[4 * 65], s[5 * 65]); o.w = cvt_pk_bf16(s[6 * 65], s[7 * 65]);
            *(GAS u32x4*)((GAS bf16*)dstv + (size_t)n * dp + 8 * c) = o; } }
    LDS_WAIT(); asm volatile("" ::: "memory");
}

constexpr int SEAM_CVT_TILES = 7 * 8;
struct W12Item { const GAS float* src; const GAS float* ksc; GAS unsigned char* dst; int sp, dp; float mul; };
__device__ __forceinline__ W12Item w12_item(int r, int l, const GAS float* wg, const GAS float* wu, const GAS float* wd, const GAS float* fng, GAS unsigned char* w1, GAS unsigned char* w2) {
    W12Item I;
    if (r < 16 * 16 * 64) { const int e = r >> 10, kt = (r >> 6) & 15, ntile = r & 63, n0 = ntile * 64, pn = n0 >> 8, rr = n0 & 255;
        I.src = (rr < 128 ? wg : wu) + ((size_t)(l * NE + e) * D + kt * 64) * FF + pn * 128 + (rr & 127); I.sp = FF; I.ksc = fng + l * D + kt * 64; I.dst = w1 + ((size_t)e * 4096 + n0) * D + kt * 64; I.dp = D;
        I.mul = rr < 128 ? 1.4426950408889634f : SH8 / 1.4426950408889634f; }
    else { r -= 16 * 16 * 64; const int e = r >> 9, kt = (r >> 4) & 31, ntile = r & 15;
        I.src = wd + ((size_t)(l * NE + e) * FF + kt * 64) * D + ntile * 64; I.sp = D; I.ksc = nullptr; I.dst = w2 + ((size_t)e * D + ntile * 64) * FF + kt * 64; I.dp = FF; I.mul = 1.f; }
    return I;
}
__device__ __forceinline__ void w12_load(const W12Item& I, int lane, f32x4 (&v)[16]) {
    const int nn = (lane & 15) * 4, kq = lane >> 4;
#pragma unroll
    for (int i = 0; i < 16; ++i) v[i] = *(const GAS f32x4*)(I.src + (size_t)(i * 4 + kq) * I.sp + nn);
}
__device__ __forceinline__ void w12_to_lds(const W12Item& I, int lane, const f32x4 (&v)[16], const float (&ks)[16], LAS float* scr) {
    const int nn = (lane & 15) * 4, kq = lane >> 4; const bool sc = I.ksc != nullptr;
#pragma unroll
    for (int i = 0; i < 16; ++i) { const int kk = i * 4 + kq; const float s = sc ? ks[i] * I.mul : SW8; LAS float* p = scr + kk * 65 + nn; p[0] = v[i].x * s; p[1] = v[i].y * s; p[2] = v[i].z * s; p[3] = v[i].w * s; }
}
__device__ __forceinline__ void w12_store(const W12Item& I, int lane, LAS float* scr, bool nostore) {
    LDS_WAIT(); asm volatile("" ::: "memory");
    const int c = lane & 7;
#pragma unroll
    for (int j = 0; j < 8; ++j) { const int n = (lane >> 3) + 8 * j; const LAS float* s = scr + (8 * c) * 65 + n;
        u32x2 o; o.x = pack4_fp8(s[0 * 65], s[1 * 65], s[2 * 65], s[3 * 65]); o.y = pack4_fp8(s[4 * 65], s[5 * 65], s[6 * 65], s[7 * 65]);
        *(GAS u32x2*)(I.dst + (size_t)n * I.dp + 8 * c) = o; }
    LDS_WAIT(); asm volatile("" ::: "memory");
}
__device__ __forceinline__ void w12_share(int bid, int G, int slot, int& first, int& step, int& cnt) {
    if (G != 256) { first = bid * 8; step = G * 8; cnt = (slot == 0) ? (1 << 30) : 0; return; }
    int start, lo, hi;
    if (bid < 48) { start = bid * 60; lo = 0; hi = (slot == 0) ? 60 : 0; }
    else if (bid < 128) { start = 2880 + (bid - 48) * 92; lo = (slot == 0) ? 0 : 63; hi = (slot == 0) ? 63 : (slot == 1 ? 92 : 63); }
    else { start = 10240 + (bid - 128) * 112; lo = (slot == 0) ? 0 : (slot == 1 ? 61 : (slot == 2 ? 87 : 102)); hi = (slot == 0) ? 61 : (slot == 1 ? 87 : (slot == 2 ? 102 : 112)); }
    first = start + lo; step = 8; cnt = hi - lo;
}
__device__ __forceinline__ void cvt_w12(const Ctx& C, int l, int slot) {
    LAS float* scr = (LAS float*)(C.lds + C.wave * 16640);
    const int lane = C.lane; constexpr int END = 16 * 16 * 64 + 16 * 32 * 16;
    int first, step, cnt; w12_share(C.bid, C.G, slot, first, step, cnt);
    if (C.G == 256 && slot == 0) return;
    const int last = (C.G == 256) ? first + cnt : END;
    int it = first + C.wave; if (cnt <= 0 || it >= last) return;
    const GAS float* wg = C.inp<28>(); const GAS float* wu = C.inp<29>(); const GAS float* wd = C.inp<30>(); const GAS float* fng = C.inp<26>(); GAS unsigned char* w1 = C.W<unsigned char>(WS_W1); GAS unsigned char* w2 = C.W<unsigned char>(WS_W2);
    f32x4 v[16]; float ks[16]; int ks_kt = -1;
    W12Item A = w12_item(it, l, wg, wu, wd, fng, w1, w2); w12_load(A, lane, v);
    for (;;) {
        if (A.ksc) { const int kt = (it >> 6) & 15; if (kt != ks_kt) {
#pragma unroll
            for (int i = 0; i < 16; ++i) ks[i] = A.ksc[i * 4 + (lane >> 4)] * SW8;
            ks_kt = kt; } }
        w12_to_lds(A, lane, v, ks, scr);
        const W12Item Cur = A; const int nx = it + step; const bool more = nx < last;
        if (more) { int ln = lane; asm volatile("" : "+v"(ln)); A = w12_item(nx, l, wg, wu, wd, fng, w1, w2); w12_load(A, ln, v); }
        w12_store(Cur, lane, scr, false);
        if (!more) break;
        it = nx;
    }
}

__device__ __forceinline__ void cvt_w12_seam(const Ctx& C, int l, int k) {
    if (C.G != 256 || C.wave == 0) return;
    int first, step, cnt; w12_share(C.bid, C.G, 0, first, step, cnt);
    const int rem = cnt - SEAM_CVT_TILES;
    if (k == 0 && C.wave - 1 >= rem) return;
    const int it = (k == 0) ? first + (C.wave - 1) : first + rem + 7 * (k - 1) + (C.wave - 1);
    LAS float* scr = (LAS float*)(C.lds + C.wave * 16640); const int lane = C.lane;
    const GAS float* wg = C.inp<28>(); const GAS float* wu = C.inp<29>(); const GAS float* wd = C.inp<30>(); const GAS float* fng = C.inp<26>(); GAS unsigned char* w1 = C.W<unsigned char>(WS_W1); GAS unsigned char* w2 = C.W<unsigned char>(WS_W2);
    f32x4 v[16]; float ks[16];
    const W12Item A = w12_item(it, l, wg, wu, wd, fng, w1, w2); w12_load(A, lane, v);
    if (A.ksc) {
#pragma unroll
        for (int i = 0; i < 16; ++i) ks[i] = A.ksc[i * 4 + (lane >> 4)] * SW8; }
    w12_to_lds(A, lane, v, ks, scr);
    w12_store(A, lane, scr, false);
}
__device__ __forceinline__ void p0_convert(const Ctx& C, int l, int pflags, const bool big) {
    LAS float* scr = (LAS float*)(C.lds + C.wave * 16640);
    const int gw = C.bid * 8 + C.wave, NGW = C.G * 8, lane = C.lane;
    constexpr int I_IN = 16 * 80, I_W1 = 16 * 16 * 64, I_W2 = 16 * 32 * 16, I_UP = 16 * 16, I_MIX = 16 * 16, I_GLU = 4 * 4, I_LRU = 32;
    constexpr int NITEMS = I_IN + I_W1 + I_W2 + I_UP + I_MIX + I_GLU + I_LRU;
    for (int it = (big ? gw : gw + I_W1 + I_W2); it < (big ? I_W1 + I_W2 : NITEMS); it += NGW) {
        int r = it; const GAS float* src; int sp; const GAS float* ksc = nullptr; float mul = 1.f; int valid = 64; GAS bf16* dst = nullptr; int dp; bool f8 = false; GAS unsigned char* dst8 = nullptr;
        if (r < I_W1) {
            const int e = r >> 10, kt = (r >> 6) & 15, ntile = r & 63, n0 = ntile * 64, pn = n0 >> 8, rr = n0 & 255;
            src = (rr < 128 ? C.inp<28>() : C.inp<29>()) + ((size_t)(l * NE + e) * D + kt * 64) * FF + pn * 128 + (rr & 127); sp = FF; ksc = C.inp<26>() + l * D + kt * 64;
            continue; }
        else if ((r -= I_W1) < I_W2) {
            const int e = r >> 9, kt = (r >> 4) & 31, ntile = r & 15;
            continue; }
        else if ((r -= I_W2) < I_IN) {
            const int kt = r / 80, ntile = r % 80, n0 = ntile * 64;
            int sc0; if (n0 < 1792) { sc0 = n0; } else if (n0 == 1792) { sc0 = 1792; valid = 32; } else if (n0 < 2048) { sc0 = 0; valid = 0; } else { sc0 = n0 - 224; }
            mul = (n0 >= 768 && n0 < 1024) ? 0.125f : 1.f;
            src = C.inp<2>() + ((size_t)l * D + kt * 64) * IN_W + sc0; sp = IN_W; ksc = C.inp<1>() + l * D + kt * 64; dst = C.W<bf16>(WS_WIN) + (size_t)n0 * D + kt * 64; dp = D;
            if (n0 >= 2048) { f8 = true; mul = SW8 * 1.4426950408889634f; dst8 = C.W<unsigned char>(WS_WIN8) + (size_t)(n0 - 2048) * D + kt * 64; } }
        else if ((r -= I_IN) < I_UP) {
            const int kt = r >> 4, ntile = r & 15, k0 = kt * 64;
            src = ((k0 < 256) ? C.inp<22>() + ((size_t)l * 256 + k0) * D : (k0 < 768) ? C.inp<23>() + ((size_t)l * 512 + (k0 - 256)) * D : C.inp<24>() + ((size_t)l * 256 + (k0 - 768)) * D) + ntile * 64;
            sp = D; dst = C.W<bf16>(WS_WUP) + (size_t)ntile * 64 * D + k0; dp = D; }
        else if ((r -= I_UP) < I_MIX) { const int kt = r >> 4, ntile = r & 15;
            src = C.inp<25>() + ((size_t)l * D + kt * 64) * D + ntile * 64; sp = D; dst = C.W<bf16>(WS_WMIX) + (size_t)ntile * 64 * D + kt * 64; dp = D; }
        else if ((r -= I_MIX) < I_GLU) { const int kt = r >> 2, ntile = r & 3;
            src = C.inp<11>() + ((size_t)l * 256 + kt * 64) * 256 + ntile * 64; sp = 256; dst = C.W<bf16>(WS_WGLU) + (size_t)ntile * 64 * 256 + kt * 64; dp = 256; }
        else { r -= I_GLU;
            const int dir = r >> 4, gate = (r >> 3) & 1, nb = r & 7;
            src = (gate ? C.inp<16>() : C.inp<14>()) + ((size_t)((l * 2 + dir) * 8 + nb)) * 4096; sp = 64; dst = C.W<bf16>(WS_LRUW) + (size_t)((dir * 2 + gate) * 8 + nb) * 4096; dp = 64; }
        cvt_tile(f8, src, sp, ksc, mul, valid, f8 ? (GAS void*)dst8 : (GAS void*)dst, dp, scr, lane);
    }
    if (big) return;
    { const GAS float* plam = C.inp<18>(); for (int i = C.bid * 512 + C.tid; i < 1024; i += C.G * 512) C.W<float>(WS_LRUC8)[i] = 8.f * 1.4426950408889634f * log1pf(expf(-plam[l * 1024 + i])); }
    const GAS float* fng = C.inp<26>(); const GAS float* wrt = C.inp<27>();
    for (int i = C.bid * 512 + C.tid; i < NE * D; i += C.G * 512) { const int e = i >> 10, k = i & 1023;
        const float w = fng[l * D + k] * wrt[((size_t)l * D + k) * NE + e]; const unsigned hi = f2bf(w); const float lo = w - bf2f(hi);
        C.W<bf16>(WS_WRT)[i] = (bf16)hi; C.W<bf16>(WS_WRT)[NE * D + i] = (bf16)f2bf(lo); }
}

__device__ __forceinline__ void s5_tables(const Ctx& C, int l, int g) {
    LAS f32x2* AP = (LAS f32x2*)(C.lds);
    LAS f32x2* BB = (LAS f32x2*)(C.lds + 33792);
    LAS f32x2* CC = (LAS f32x2*)(C.lds + 50176);
    const int tid = C.tid, dp = tid & 127, dir = dp >> 6, p = dp & 63, grp = tid >> 7; const size_t pi = ((size_t)(l * 2 + dir) * 16 + g) * 64 + p;
    const GAS float* plr = C.inp<3>(); const GAS float* pli = C.inp<4>(); const GAS float* pdt = C.inp<5>();
    const float lr = fminf(plr[pi], -1e-4f), li = pli[pi], dt = expf(pdt[(l * 2 + dir) * 16 + g]);
    for (int e = grp; e <= 32; e += 4) { const float mg = __expf((float)e * lr * dt); float sn, cs; __sincosf((float)e * li * dt, &sn, &cs); AP[(dir * 33 + e) * 64 + p] = (f32x2){mg * cs, mg * sn}; }
    { const float mg = __expf(lr * dt); float sn, cs; __sincosf(li * dt, &sn, &cs); const float are = mg * cs, aim = mg * sn, den = lr * lr + li * li;
      const float kre = ((are - 1.f) * lr + aim * li) / den, kim = (aim * lr - (are - 1.f) * li) / den;
      const GAS float* pbre = C.inp<6>(); const GAS float* pbim = C.inp<7>(); const GAS float* pcre = C.inp<8>(); const GAS float* pcim = C.inp<9>();
#pragma unroll
      for (int hh = 0; hh < 4; ++hh) { const int h = grp * 4 + hh; const float bre = pbre[pi * 16 + h], bim = pbim[pi * 16 + h]; BB[(dir * 64 + p) * 16 + h] = (f32x2){kre * bre - kim * bim, kre * bim + kim * bre};
          const size_t ci = (((size_t)(l * 2 + dir) * 16 + g) * 16 + h) * 64 + p; CC[(dir * 16 + h) * 64 + p] = (f32x2){pcre[ci], pcim[ci]}; } }
    __syncthreads();
}
__device__ __forceinline__ void p0_s5_kt(const Ctx& C, int l) {
    GAS float* ktg = C.W<float>(WS_PROBS);
    for (int item = C.bid; item < 256; item += C.G) {
        const int g = item >> 4, part = item & 15;
        __syncthreads(); s5_tables(C, l, g);
        const LAS f32x2* AP = (const LAS f32x2*)(C.lds); const LAS f32x2* BB = (const LAS f32x2*)(C.lds + 33792); const LAS f32x2* CC = (const LAS f32x2*)(C.lds + 50176);
#pragma unroll
        for (int q = 0; q < 2; ++q) { const int en = part * 1024 + q * 512 + C.tid, dir = en >> 13, lag = (en >> 8) & 31, h = (en >> 4) & 15, h2 = en & 15; float s = 0.f;
#pragma unroll 8
            for (int p = 0; p < 64; ++p) { const f32x2 c = CC[(dir * 16 + h) * 64 + p], a = AP[(dir * 33 + lag) * 64 + p], b = BB[(dir * 64 + p) * 16 + h2];
                const float cre = c.x * a.x - c.y * a.y, cim = c.x * a.y + c.y * a.x; s += cre * b.x - cim * b.y; }
            ktg[(size_t)g * 16384 + en] = s; }
    }
    __syncthreads();
}
template <int WHICH>
__device__ __forceinline__ void p1_s5_assemble(const Ctx& C, int l, int bid0, int nblk) {
    const GAS float* ktg = C.W<float>(WS_PROBS); const GAS float* s5d = C.inp<10>();
    for (int item = C.bid - bid0; item < 256; item += nblk) {
        const int g = item >> 4, part = item & 15, tid = C.tid;
        __syncthreads(); s5_tables(C, l, g);
        const LAS f32x2* AP = (const LAS f32x2*)(C.lds); const LAS f32x2* BB = (const LAS f32x2*)(C.lds + 33792); const LAS f32x2* CC = (const LAS f32x2*)(C.lds + 50176);
        LAS float* KT = (LAS float*)(C.lds + 66560);
        for (int i = tid; i < 4096; i += 512) *(LAS f32x4*)(KT + i * 4) = *(const GAS f32x4*)(ktg + (size_t)g * 16384 + i * 4);
        __syncthreads();
        GAS bf16* bt2 = C.W<bf16>(WS_S5BT2) + (size_t)g * 512 * UXP;
        if constexpr (WHICH == 1)
        for (int ch = tid; ch < 32 * 96; ch += 512) {
            const int row = part * 32 + ch / 96, cc = (ch % 96) * 8, t = row >> 4, h = row & 15; float vv[8];
            if (cc < 512) { const int s = cc >> 4, h0 = cc & 15;
#pragma unroll
                for (int j = 0; j < 8; ++j) { const int h2 = h0 + j; float x;
                    if (t > s) x = KT[((0 * 32 + (t - s)) * 16 + h) * 16 + h2]; else if (t < s) x = KT[((1 * 32 + (s - t)) * 16 + h) * 16 + h2];
                    else x = KT[(0 * 16 + h) * 16 + h2] + KT[((32) * 16 + h) * 16 + h2] + (h == h2 ? s5d[l * 256 + g * 16 + h] : 0.f);
                    vv[j] = x; } }
            else { const int sc = cc - 512, dir = sc >> 7, p0 = (sc & 127) >> 1; const int e = dir ? (32 - t) : (t + 1);
#pragma unroll
                for (int j = 0; j < 4; ++j) { const f32x2 c = CC[(dir * 16 + h) * 64 + p0 + j], a = AP[(dir * 33 + e) * 64 + p0 + j];
                    vv[2 * j] = c.x * a.x - c.y * a.y; vv[2 * j + 1] = -(c.x * a.y + c.y * a.x); } }
            *(GAS u32x4*)(bt2 + (size_t)row * UXP + cc) = pack8(vv);
        }
        GAS bf16* mn = C.W<bf16>(WS_S5MIN) + (size_t)g * 256 * 512;
        if constexpr (WHICH == 0)
        for (int ch = tid; ch < 16 * 64; ch += 512) {
            const int row = part * 16 + (ch >> 6), cc = (ch & 63) * 8, dir = row >> 7, p = (row & 127) >> 1, ri = row & 1, s = cc >> 4, h0 = cc & 15, e = dir ? s : (31 - s);
            const f32x2 a = AP[(dir * 33 + e) * 64 + p]; float vv[8];
#pragma unroll
            for (int j = 0; j < 8; ++j) { const f32x2 b = BB[(dir * 64 + p) * 16 + h0 + j]; vv[j] = ri ? (a.x * b.y + a.y * b.x) : (a.x * b.x - a.y * b.y); }
            *(GAS u32x4*)(mn + (size_t)row * 512 + cc) = pack8(vv);
        }
    }
    __syncthreads();
}

__device__ __forceinline__ void p0_x_to_hb(const Ctx& C) {
    const int gw = C.bid * 8 + C.wave, NGW = C.G * 8; const GAS float* xin = C.inp<0>();
    for (int t0 = gw; t0 < T; t0 += 2 * NGW) {
        f32x4 v[2][4]; bool ok[2];
#pragma unroll
        for (int q = 0; q < 2; ++q) { const int t = t0 + q * NGW; ok[q] = t < T; const GAS f32x4* xr = (const GAS f32x4*)(xin + (size_t)(ok[q] ? t : 0) * D) + C.lane * 2;
            v[q][0] = xr[0]; v[q][1] = xr[1]; v[q][2] = xr[128]; v[q][3] = xr[129]; }
#pragma unroll
        for (int q = 0; q < 2; ++q) if (ok[q]) { const int t = t0 + q * NGW; GAS bf16* o = C.W<bf16>(WS_HB) + (size_t)t * D + C.lane * 8; float ss = 0.f; float rr[2][8];
#pragma unroll
            for (int j = 0; j < 2; ++j) { const f32x4 a = v[q][2 * j], b = v[q][2 * j + 1]; float vv[8] = {a.x, a.y, a.z, a.w, b.x, b.y, b.z, b.w}; const u32x4 w = pack8(vv); unpack8(w, rr[j]);
#pragma unroll
                for (int i = 0; i < 8; ++i) ss += rr[j][i] * rr[j][i];
                *(GAS u32x4*)(o + j * 512) = w; }
#pragma unroll
            for (int off = 1; off < 64; off <<= 1) ss += shxf_(ss, off, C.lane);
            const float sa = __builtin_amdgcn_rsqf(ss * (1.f / D) + EPS) * SA8;
#pragma unroll
            for (int j = 0; j < 2; ++j) { u32x2 o8; o8.x = pack4_fp8(rr[j][0] * sa, rr[j][1] * sa, rr[j][2] * sa, rr[j][3] * sa); o8.y = pack4_fp8(rr[j][4] * sa, rr[j][5] * sa, rr[j][6] * sa, rr[j][7] * sa);
                *(GAS u32x2*)(C.W<unsigned char>(WS_HB8) + (size_t)t * D + C.lane * 8 + j * 512) = o8; }
            if (C.lane == 0) C.W<float>(WS_SS1)[t] = ss; }
    }
}

constexpr int LRU_CH = 128, LRU_NCH = SEQ / LRU_CH;
struct LruK { float ba[2][4], bx[2][4], c8[2][4]; float w0, w1, w2, w3, cb; };
__device__ __forceinline__ void lru_setup(const Ctx& C, int l, int nb, LruK& K) {
    const int lane = C.lane, fr = lane & 15, ch0 = nb * 64, tid = C.tid;
    const GAS float* pba = C.inp<15>(); const GAS float* pbx = C.inp<17>(); const GAS float* lc8 = C.W<float>(WS_LRUC8);
#pragma unroll
    for (int dir = 0; dir < 2; ++dir)
#pragma unroll
        for (int cb4 = 0; cb4 < 4; ++cb4) { const int chn = ch0 + cb4 * 16 + fr; K.ba[dir][cb4] = pba[(l * 2 + dir) * 512 + chn]; K.bx[dir][cb4] = pbx[(l * 2 + dir) * 512 + chn];
            K.c8[dir][cb4] = lc8[dir * 512 + chn]; }
    const GAS float* cw = C.inp<12>(); const int ch = ch0 + lane;
    K.w0 = cw[(l * 4 + 0) * 512 + ch]; K.w1 = cw[(l * 4 + 1) * 512 + ch]; K.w2 = cw[(l * 4 + 2) * 512 + ch]; K.w3 = cw[(l * 4 + 3) * 512 + ch]; K.cb = C.inp<13>()[l * 512 + ch];
    const GAS bf16* wt = C.W<bf16>(WS_LRUW);
    __syncthreads();
#pragma unroll
    for (int i = 0; i < 4; ++i) { const int e = (i * 512 + tid) * 8, mtx = e >> 12, d = (e >> 6) & 63, c = e & 63;
        *(LAS u32x4*)(C.lds + (mtx * 64 + d) * 144 + c * 2) = *(const GAS u32x4*)(wt + ((size_t)(mtx * 8 + nb) * 64 + d) * 64 + c); }
    __syncthreads();
}
__device__ __forceinline__ void lru_load_x(const Ctx& C, int unit, u32x4 (&xr)[3]) {
    const int bc = unit >> 3, nb = unit & 7, b = bc / LRU_NCH, s0 = (bc % LRU_NCH) * LRU_CH, r8 = C.lane >> 3, ck = (C.lane & 7) * 8; const GAS bf16* xb = C.W<bf16>(WS_XB);
#pragma unroll
    for (int i = 0; i < 3; ++i) { const int s = s0 + C.wave * 16 + i * 8 + r8 - 2; xr[i] = (s >= 0 && s < SEQ && i * 8 + r8 < 19) ? *(const GAS u32x4*)(xb + ((size_t)b * SEQ + s) * 512 + nb * 64 + ck) : (u32x4){0u, 0u, 0u, 0u}; }
}
__device__ __forceinline__ void lru_pass1_unit(const Ctx& C, int unit, int par, const LruK& K, const u32x4 (&xr)[3]) {
    const int lane = C.lane, w = C.wave, fr = lane & 15, fq = lane >> 4;
    const int bc = unit >> 3, nb = unit & 7, t0 = bc * LRU_CH + w * 16, ch0 = nb * 64;
    LAS unsigned char* WT = C.lds; LAS unsigned char* WV = C.lds + 36864 + w * 11008;
    LAS bf16* XCb = (LAS bf16*)WV; LAS float* LA = (LAS float*)(WV + 2304); LAS float* LB = (LAS float*)(WV + 2304 + 4352);
    LAS float* SEG = (LAS float*)(C.lds + 124928) + par * 2048;
    {
        LAS bf16* XS = (LAS bf16*)(WV + 2304);
#pragma unroll
        for (int i = 0; i < 3; ++i) *(LAS u32x4*)(XS + (i * 8 + (lane >> 3)) * 64 + (lane & 7) * 8) = xr[i];
        float xv[19];
#pragma unroll
        for (int i = 0; i < 19; ++i) xv[i] = bf2f(XS[i * 64 + lane]);
#pragma unroll
        for (int j = 0; j < 16; ++j) { const float xc = K.cb + K.w0 * xv[j] + K.w1 * xv[j + 1] + K.w2 * xv[j + 2] + K.w3 * xv[j + 3]; XCb[j * 72 + lane] = (bf16)f2bf(xc); }
    }
    bf16x8 af[2];
#pragma unroll
    for (int kk = 0; kk < 2; ++kk) af[kk] = *(const LAS bf16x8*)((LAS unsigned char*)XCb + fr * 144 + (kk * 32 + fq * 8) * 2);
    float hs[2][16], ps[2][16];
    float xcv[4][4];
#pragma unroll
    for (int cb4 = 0; cb4 < 4; ++cb4)
#pragma unroll
        for (int r = 0; r < 4; ++r) xcv[cb4][r] = bf2f(XCb[(4 * fq + r) * 72 + cb4 * 16 + fr]);
#pragma unroll
    for (int dir = 0; dir < 2; ++dir) {
        bf16x8 bR[4][2], bI[4][2];
#pragma unroll
        for (int cb4 = 0; cb4 < 4; ++cb4)
#pragma unroll
            for (int kk = 0; kk < 2; ++kk) { bR[cb4][kk] = *(const LAS bf16x8*)(WT + ((dir * 2 + 0) * 64 + cb4 * 16 + fr) * 144 + (kk * 32 + fq * 8) * 2); bI[cb4][kk] = *(const LAS bf16x8*)(WT + ((dir * 2 + 1) * 64 + cb4 * 16 + fr) * 144 + (kk * 32 + fq * 8) * 2); }
        f32x4 aR[4], aI[4];
#pragma unroll
        for (int cb4 = 0; cb4 < 4; ++cb4) { aR[cb4] = (f32x4){0.f, 0.f, 0.f, 0.f}; aI[cb4] = (f32x4){0.f, 0.f, 0.f, 0.f};
#pragma unroll
            for (int kk = 0; kk < 2; ++kk) { aR[cb4] = MFMA16(af[kk], bR[cb4][kk], aR[cb4]); aI[cb4] = MFMA16(af[kk], bI[cb4][kk], aI[cb4]); } }
        float va[4][4], vb[4][4];
#pragma unroll
        for (int cb4 = 0; cb4 < 4; ++cb4) { const float ba = K.ba[dir][cb4], bx = K.bx[dir][cb4], c8 = K.c8[dir][cb4];
#pragma unroll
            for (int r = 0; r < 4; ++r) { const float rg = sigmoid_(aR[cb4][r] + ba), ig = sigmoid_(aI[cb4][r] + bx), a = __builtin_amdgcn_exp2f(-c8 * rg), mlt = __builtin_amdgcn_sqrtf(fmaxf(1.f - a * a, 0.f));
                va[cb4][r] = a; vb[cb4][r] = mlt * ig * xcv[cb4][r]; } }
#pragma unroll
        for (int cb4 = 0; cb4 < 4; ++cb4)
#pragma unroll
            for (int r = 0; r < 4; ++r) { const int tok = 4 * fq + r, d = cb4 * 16 + fr; LA[tok * 68 + d] = va[cb4][r]; LB[tok * 68 + d] = vb[cb4][r]; }
        float h = 0.f, P = 1.f;
#pragma unroll
        for (int i = 0; i < 16; ++i) { const int tok = dir ? 15 - i : i; const float a = LA[tok * 68 + lane], bb = LB[tok * 68 + lane]; h = a * h + bb; P *= a; hs[dir][tok] = h; ps[dir][tok] = P; }
        SEG[((dir * 2 + 0) * 8 + w) * 64 + lane] = P; SEG[((dir * 2 + 1) * 8 + w) * 64 + lane] = h;
    }
    __syncthreads();
    float cin = 0.f, Pin = 1.f, cib = 0.f, Pib = 1.f;
    for (int s = 0; s < w; ++s) { const float A = SEG[(0 * 8 + s) * 64 + lane], H = SEG[(8 + s) * 64 + lane]; cin = A * cin + H; Pin *= A; }
    for (int s = 7; s > w; --s) { const float A = SEG[(16 + s) * 64 + lane], H = SEG[(24 + s) * 64 + lane]; cib = A * cib + H; Pib *= A; }
    GAS bf16* yl = C.W<bf16>(WS_YLOC); GAS bf16* gpf = C.W<bf16>(WS_PF); GAS bf16* gpb = C.W<bf16>(WS_PB);
    float yfl = 0.f, pfl = 0.f, ybf = 0.f, pbf = 0.f;
    LAS bf16* ST = (LAS bf16*)(WV + 2304);
#pragma unroll
    for (int j = 0; j < 16; ++j) {
        const float yf = hs[0][j] + ps[0][j] * cin, pcf = ps[0][j] * Pin, yb = hs[1][j] + ps[1][j] * cib, pcb = ps[1][j] * Pib;
        const unsigned p0 = cvt_pk_bf16(yf + yb, pcf), p1 = cvt_pk_bf16(pcb, 0.f);
        ST[(0 * 16 + j) * 64 + lane] = (bf16)(p0 & 0xffffu); ST[(1 * 16 + j) * 64 + lane] = (bf16)(p0 >> 16); ST[(2 * 16 + j) * 64 + lane] = (bf16)(p1 & 0xffffu);
        if (j == 15) { yfl = yf; pfl = pcf; } if (j == 0) { ybf = yb; pbf = pcb; } }
    { const int tok = lane >> 2, ck = (lane & 3) * 16; const size_t o = (size_t)(t0 + tok) * 512 + ch0 + ck;
#pragma unroll
      for (int arr = 0; arr < 3; ++arr) { GAS bf16* gp = arr == 0 ? yl : (arr == 1 ? gpf : gpb);
          const u32x4 v0 = *(const LAS u32x4*)(ST + (arr * 16 + tok) * 64 + ck), v1 = *(const LAS u32x4*)(ST + (arr * 16 + tok) * 64 + ck + 8);
          *(GAS u32x4*)(gp + o) = v0; *(GAS u32x4*)(gp + o + 8) = v1; } }
    GAS float* sm = C.W<float>(WS_LSUM) + ((size_t)bc * 512 + ch0 + lane) * 4;
    if (w == 7) { sm[0] = pfl; sm[1] = yfl; }
    if (w == 0) { sm[2] = pbf; sm[3] = ybf; }
}
__device__ __forceinline__ void lru_pass1_all(const Ctx& C, int l) {
    constexpr int NU = (T / LRU_CH) * 8;
    LruK K; int cur_nb = -1, par = 0; u32x4 xr[3], xn[3];
    int u = C.bid; if (u >= NU) return;
    lru_load_x(C, u, xr);
    for (; u < NU; u += C.G) {
        const int nb = u & 7; if (nb != cur_nb) { lru_setup(C, l, nb, K); cur_nb = nb; }
        const int un = u + C.G; if (un < NU) lru_load_x(C, un, xn);
        lru_pass1_unit(C, u, par, K, xr); par ^= 1;
#pragma unroll
        for (int i = 0; i < 3; ++i) xr[i] = xn[i];
    }
    __syncthreads();
}
__device__ __forceinline__ void lru_carry(const Ctx& C) {
    const int gid = C.bid * 512 + C.tid; if (gid >= 8192) return;
    const int dir = gid >> 12, b = (gid >> 9) & 7, ch = gid & 511; const GAS float* sm = C.W<float>(WS_LSUM); GAS float* car = C.W<float>(WS_LCAR); float c = 0.f;
    for (int i0 = 0; i0 < LRU_NCH; i0 += 8) {
        f32x2 ah[8];
#pragma unroll
        for (int j = 0; j < 8; ++j) { const int cc = dir ? LRU_NCH - 1 - (i0 + j) : (i0 + j); ah[j] = *(const GAS f32x2*)(sm + ((size_t)(b * LRU_NCH + cc) * 512 + ch) * 4 + dir * 2); }
#pragma unroll
        for (int j = 0; j < 8; ++j) { const int cc = dir ? LRU_NCH - 1 - (i0 + j) : (i0 + j); car[((size_t)(b * LRU_NCH + cc) * 512 + ch) * 2 + dir] = c; c = ah[j].x * c + ah[j].y; }
    }
}
__device__ __forceinline__ void lru_pass2(const Ctx& C) {
    const GAS bf16* yl = C.W<bf16>(WS_YLOC); const GAS bf16* gpf = C.W<bf16>(WS_PF); const GAS bf16* gpb = C.W<bf16>(WS_PB); const GAS float* car = C.W<float>(WS_LCAR); GAS bf16* ycat = C.W<bf16>(WS_YCAT);
    int start, cnt;
    if (C.G == 256) { if (C.bid < 128) { start = C.bid * 4608; cnt = 9; } else { start = 128 * 4608 + (C.bid - 128) * 11776; cnt = 23; } }
    else { const int per = (T * 64 / 512 + C.G - 1) / C.G; start = C.bid * per * 512; cnt = per; }
    for (int j = 0; j < cnt; j += 4) {
        u32x4 ly[4], lf[4], lb[4]; f32x4 cv[4][4]; int tt[4], cc[4]; bool ok[4];
#pragma unroll
        for (int q = 0; q < 4; ++q) { const int i = start + (j + q) * 512 + C.tid; ok[q] = (j + q < cnt) && i < T * 64; const int ii = ok[q] ? i : 0; tt[q] = ii >> 6; cc[q] = (ii & 63) * 8;
            ly[q] = *(const GAS u32x4*)(yl + (size_t)tt[q] * 512 + cc[q]); lf[q] = *(const GAS u32x4*)(gpf + (size_t)tt[q] * 512 + cc[q]); lb[q] = *(const GAS u32x4*)(gpb + (size_t)tt[q] * 512 + cc[q]);
            const GAS f32x4* cp = (const GAS f32x4*)(car + ((size_t)(tt[q] / LRU_CH) * 512 + cc[q]) * 2);
#pragma unroll
            for (int k = 0; k < 4; ++k) cv[q][k] = cp[k]; }
#pragma unroll
        for (int q = 0; q < 4; ++q) { float y[8], pf[8], pb[8], o[8]; unpack8(ly[q], y); unpack8(lf[q], pf); unpack8(lb[q], pb);
#pragma unroll
            for (int k = 0; k < 4; ++k) { o[2 * k] = y[2 * k] + pf[2 * k] * cv[q][k].x + pb[2 * k] * cv[q][k].y; o[2 * k + 1] = y[2 * k + 1] + pf[2 * k + 1] * cv[q][k].z + pb[2 * k + 1] * cv[q][k].w; }
            if (ok[q]) *(GAS u32x4*)(ycat + (size_t)tt[q] * 1024 + 256 + cc[q]) = pack8(o); }
    }
}

struct GlaConsts { bf16x8 bh[4], bl[4]; float baf, bab; };
__device__ __forceinline__ void gla_load_consts(const Ctx& C, int l, int h, GlaConsts& K) {
    const int d = C.lane, col0 = h * 64, dir = C.wave >> 2, n = C.lane & 15, kq = C.lane >> 4; const GAS float* pwa = C.inp<19>(); const GAS float* pbal = C.inp<20>();
#pragma unroll
    for (int dt = 0; dt < 4; ++dt) { float hv[8], lv[8];
#pragma unroll
        for (int i = 0; i < 8; ++i) { const float wv = pwa[((size_t)(l * 2 + dir) * 16 + (kq & 1) * 8 + i) * 256 + col0 + dt * 16 + n]; hv[i] = bf2f(f2bf(wv)); lv[i] = wv - hv[i]; }
        K.bh[dt] = __builtin_bit_cast(bf16x8, pack8(hv)); K.bl[dt] = __builtin_bit_cast(bf16x8, pack8(lv)); }
    K.baf = pbal[(l * 2 + 0) * 256 + col0 + d]; K.bab = pbal[(l * 2 + 1) * 256 + col0 + d];
}
struct GlaIn { u32x4 q, k, v; f32x4 alr; };
__device__ __forceinline__ void gla_load_in(const Ctx& C, int u, GlaIn& I) {
    const int b = u >> 8, h = (u >> 6) & 3, n = u & 63, t0 = b * SEQ + n * 64, col0 = h * 64, w = C.wave, tid = C.tid, lane = C.lane;
    const size_t o = (size_t)(t0 + w * 8 + (lane >> 3)) * 256 + col0 + (lane & 7) * 8;
    I.q = *(const GAS u32x4*)(C.W<bf16>(WS_Q) + o); I.k = *(const GAS u32x4*)(C.W<bf16>(WS_K) + o); I.v = *(const GAS u32x4*)(C.W<bf16>(WS_V) + o);
    I.alr = *(const GAS f32x4*)(C.W<float>(WS_ALR) + (size_t)(t0 + (tid >> 3)) * 32 + (tid & 7) * 4);
}
__device__ __forceinline__ void gla_pass1_unit(const Ctx& C, int u, const GlaConsts& K, const GlaIn& I) {
    const int lane = C.lane, w = C.wave, tid = C.tid, fr = lane & 15, fq = lane >> 4;
    const int b = u >> 8, h = (u >> 6) & 3, n = u & 63, t0 = b * SEQ + n * 64, col0 = h * 64;
    LAS unsigned char* L = C.lds;
    LAS float* ALR = (LAS float*)L;
    LAS float* SEGF = (LAS float*)(L + 8192);
    LAS float* SEGB = (LAS float*)(L + 10240);
    LAS unsigned char* QDF = L + 12288, *KDF = L + 21504, *QDB = L + 30720, *KDB = L + 39936, *KRFT = L + 49152, *KRBT = L + 58368, *VT = L + 67584, *SS = L + 76800;
    *(LAS f32x4*)(ALR + (tid >> 3) * 32 + (tid & 7) * 4) = I.alr;
    LAS bf16* QKV = (LAS bf16*)(L + 86016);
    { const int row = w * 8 + (lane >> 3), ck = (lane & 7) * 8; *(LAS u32x4*)(QKV + (0 * 64 + row) * 64 + ck) = I.q; *(LAS u32x4*)(QKV + (1 * 64 + row) * 64 + ck) = I.k; *(LAS u32x4*)(QKV + (2 * 64 + row) * 64 + ck) = I.v; }
    __syncthreads();
    LAS float* XT = (LAS float*)(L + 110592);
    {
        const int dir = w >> 2, tt = w & 3; const LAS float* ap = ALR + (tt * 16 + fr) * 32 + dir * 16 + (fq & 1) * 8;
        const f32x4 x0 = *(const LAS f32x4*)ap, x1 = *(const LAS f32x4*)(ap + 4); float xs[8] = {x0.x, x0.y, x0.z, x0.w, x1.x, x1.y, x1.z, x1.w};
#pragma unroll
        for (int i = 0; i < 8; ++i) { const float hi = bf2f(f2bf(xs[i])); xs[i] = (fq >= 2) ? xs[i] - hi : hi; }
        const bf16x8 af = __builtin_bit_cast(bf16x8, pack8(xs));
#pragma unroll
        for (int dt = 0; dt < 4; ++dt) { f32x4 c = {0.f, 0.f, 0.f, 0.f}; c = MFMA16(af, K.bh[dt], c); c = MFMA16(af, K.bl[dt], c);
            *(LAS f32x4*)(XT + (dir * 64 + dt * 16 + fr) * 68 + tt * 16 + 4 * fq) = c; }
    }
    __syncthreads();
    float bfw[8], bbw[8], allF, allB;
    {
        const int d = lane;
        float gf[8], gb[8];
        { const f32x4 f0 = *(const LAS f32x4*)(XT + d * 68 + 8 * w), f1 = *(const LAS f32x4*)(XT + d * 68 + 8 * w + 4), b0 = *(const LAS f32x4*)(XT + (64 + d) * 68 + 8 * w), b1 = *(const LAS f32x4*)(XT + (64 + d) * 68 + 8 * w + 4);
          const float xfv[8] = {f0.x, f0.y, f0.z, f0.w, f1.x, f1.y, f1.z, f1.w}, xbv[8] = {b0.x, b0.y, b0.z, b0.w, b1.x, b1.y, b1.z, b1.w};
#pragma unroll
          for (int j = 0; j < 8; ++j) { gf[j] = logsig_(xfv[j] + K.baf) * (1.f / 16.f); gb[j] = logsig_(xbv[j] + K.bab) * (1.f / 16.f); } }
        float s = 0.f;
#pragma unroll
        for (int j = 0; j < 8; ++j) { s += gf[j]; bfw[j] = s; }
        SEGF[w * 64 + d] = s; s = 0.f;
#pragma unroll
        for (int j = 7; j >= 0; --j) { s += gb[j]; bbw[j] = s; }
        SEGB[w * 64 + d] = s;
    }
    __syncthreads();
    {
        const int d = lane; float offF = 0.f, offB = 0.f; allF = 0.f; allB = 0.f;
#pragma unroll
        for (int s = 0; s < 8; ++s) { const float a = SEGF[s * 64 + d], c = SEGB[s * 64 + d]; allF += a; allB += c; if (s < w) offF += a; if (s > w) offB += c; }
        GAS bf16* gqdf = C.W<bf16>(WS_QDF); GAS bf16* gqdb = C.W<bf16>(WS_QDB);
        float krf[8], krb[8], vt[8];
#pragma unroll
        for (int j = 0; j < 8; ++j) { const int tok = w * 8 + j; const size_t o = (size_t)(t0 + tok) * 256 + col0 + d;
            const float qv = bf2f(QKV[(0 * 64 + tok) * 64 + d]), kv = bf2f(QKV[(1 * 64 + tok) * 64 + d]), vv = bf2f(QKV[(2 * 64 + tok) * 64 + d]); const float cf = offF + bfw[j], cb = offB + bbw[j];
            const float qdf = qv * __expf(cf), kdf = kv * __expf(-cf), qdb = qv * __expf(cb), kdb = kv * __expf(-cb);
            krf[j] = kv * __expf(allF - cf); krb[j] = kv * __expf(allB - cb); vt[j] = vv;
            const unsigned hq = f2bf(qdf), hb = f2bf(qdb);
            *(LAS bf16*)(QDF + tok * 144 + d * 2) = (bf16)hq; *(LAS bf16*)(KDF + tok * 144 + d * 2) = (bf16)f2bf(kdf); *(LAS bf16*)(QDB + tok * 144 + d * 2) = (bf16)hb; *(LAS bf16*)(KDB + tok * 144 + d * 2) = (bf16)f2bf(kdb);
            (void)o; }
        *(LAS u32x4*)(KRFT + d * 144 + w * 16) = pack8(krf); *(LAS u32x4*)(KRBT + d * 144 + w * 16) = pack8(krb); *(LAS u32x4*)(VT + d * 144 + w * 16) = pack8(vt);
        { const int row = w * 8 + (lane >> 3), ck = (lane & 7) * 8; const size_t go = (size_t)(t0 + row) * 256 + col0 + ck;
          *(GAS u32x4*)(gqdf + go) = *(const LAS u32x4*)(QDF + row * 144 + ck * 2); *(GAS u32x4*)(gqdb + go) = *(const LAS u32x4*)(QDB + row * 144 + ck * 2); }
        if (w == 0) { GAS float* gd = C.W<float>(WS_GDEC) + (size_t)u * 128; gd[d] = __expf(allF); gd[64 + d] = __expf(allB); }
    }
    __syncthreads();
    {
        const int dir = w >> 2, ib = w & 3; const LAS unsigned char* QD = dir ? QDB : QDF; const LAS unsigned char* KD = dir ? KDB : KDF;
        bf16x8 af[2];
#pragma unroll
        for (int kk = 0; kk < 2; ++kk) af[kk] = *(const LAS bf16x8*)(QD + (ib * 16 + fr) * 144 + (kk * 32 + fq * 8) * 2);
        for (int jb = 0; jb < 4; ++jb) {
            if (dir == 0 ? (jb > ib) : (jb < ib)) continue;
            f32x4 a = {0.f, 0.f, 0.f, 0.f};
#pragma unroll
            for (int kk = 0; kk < 2; ++kk) { const bf16x8 bfrag = *(const LAS bf16x8*)(KD + (jb * 16 + fr) * 144 + (kk * 32 + fq * 8) * 2); a = MFMA16(af[kk], bfrag, a); }
#pragma unroll
            for (int r = 0; r < 4; ++r) { const int i = ib * 16 + 4 * fq + r, j = jb * 16 + fr; const bool keep = dir == 0 ? (j <= i) : (j > i); if (keep) *(LAS bf16*)(SS + i * 144 + j * 2) = (bf16)f2bf(a[r]); }
        }
    }
    __syncthreads();
    {
        GAS bf16* goin = C.W<bf16>(WS_OIN);
#pragma unroll
        for (int tt = 0; tt < 2; ++tt) { const int tile = w * 2 + tt, dvb = tile >> 2, ib = tile & 3; f32x4 a = {0.f, 0.f, 0.f, 0.f};
#pragma unroll
            for (int kk = 0; kk < 2; ++kk) { const bf16x8 x = *(const LAS bf16x8*)(VT + (dvb * 16 + fr) * 144 + (kk * 32 + fq * 8) * 2), y = *(const LAS bf16x8*)(SS + (ib * 16 + fr) * 144 + (kk * 32 + fq * 8) * 2); a = MFMA16(x, y, a); }
            u32x2 o; o.x = cvt_pk_bf16(a[0], a[1]); o.y = cvt_pk_bf16(a[2], a[3]);
            *(GAS u32x2*)(goin + (size_t)(t0 + ib * 16 + fr) * 256 + col0 + dvb * 16 + 4 * fq) = o; }
        const int dir = w >> 2, dkb = w & 3; const LAS unsigned char* KR = dir ? KRBT : KRFT; GAS bf16* gkv = C.W<bf16>(WS_KV) + ((size_t)u * 2 + dir) * 4096;
        bf16x8 af[2];
#pragma unroll
        for (int kk = 0; kk < 2; ++kk) af[kk] = *(const LAS bf16x8*)(KR + (dkb * 16 + fr) * 144 + (kk * 32 + fq * 8) * 2);
#pragma unroll
        for (int dvb = 0; dvb < 4; ++dvb) { f32x4 a = {0.f, 0.f, 0.f, 0.f};
#pragma unroll
            for (int kk = 0; kk < 2; ++kk) { const bf16x8 y = *(const LAS bf16x8*)(VT + (dvb * 16 + fr) * 144 + (kk * 32 + fq * 8) * 2); a = MFMA16(af[kk], y, a); }
            u32x2 o; o.x = cvt_pk_bf16(a[0], a[1]); o.y = cvt_pk_bf16(a[2], a[3]);
            *(GAS u32x2*)(gkv + (size_t)(dvb * 16 + fr) * 64 + dkb * 16 + 4 * fq) = o; }
    }
    __syncthreads();
}
__device__ __forceinline__ void gla_pass1_all(const Ctx& C, int l) {
    GlaConsts K; int cur_h = -1; GlaIn I, In;
    int u = C.bid; if (u >= 2048) return;
    gla_load_in(C, u, I);
    for (; u < 2048; u += C.G) {
        const int h = (u >> 6) & 3; if (h != cur_h) { gla_load_consts(C, l, h, K); cur_h = h; }
        const int un = u + C.G; if (un < 2048) gla_load_in(C, un, In);
        gla_pass1_unit(C, u, K, I);
        I = In;
    }
}
__device__ __forceinline__ void gla_scan(const Ctx& C) {
    GAS bf16* kv = C.W<bf16>(WS_KV); const GAS float* gd = C.W<float>(WS_GDEC);
    const int NT = C.G * 512;
    for (int e0 = C.bid * 512 + C.tid; e0 < 64 * 4096; e0 += 2 * NT) {
        const int e1 = e0 + NT; const bool two = e1 < 64 * 4096;
        const int sq0 = e0 >> 12, el0 = e0 & 4095, dk0 = el0 & 63, dir0 = sq0 & 1, bh0 = sq0 >> 1;
        const int e1c = two ? e1 : e0; const int sq1 = e1c >> 12, el1 = e1c & 4095, dk1 = el1 & 63, dir1 = sq1 & 1, bh1 = sq1 >> 1;
        float S0 = 0.f, S1 = 0.f;
        for (int i0 = 0; i0 < 64; i0 += 8) {
            float k0[8], d0[8], k1[8], d1[8];
#pragma unroll
            for (int j = 0; j < 8; ++j) { const int n0 = dir0 ? 63 - (i0 + j) : (i0 + j), u0 = bh0 * 64 + n0, n1 = dir1 ? 63 - (i0 + j) : (i0 + j), u1 = bh1 * 64 + n1;
                k0[j] = bf2f(kv[((size_t)u0 * 2 + dir0) * 4096 + el0]); d0[j] = gd[(size_t)u0 * 128 + dir0 * 64 + dk0];
                k1[j] = bf2f(kv[((size_t)u1 * 2 + dir1) * 4096 + el1]); d1[j] = gd[(size_t)u1 * 128 + dir1 * 64 + dk1]; }
#pragma unroll
            for (int j = 0; j < 8; ++j) { const int n0 = dir0 ? 63 - (i0 + j) : (i0 + j), u0 = bh0 * 64 + n0, n1 = dir1 ? 63 - (i0 + j) : (i0 + j), u1 = bh1 * 64 + n1;
                kv[((size_t)u0 * 2 + dir0) * 4096 + el0] = (bf16)f2bf(S0); S0 = d0[j] * S0 + k0[j];
                if (two) { kv[((size_t)u1 * 2 + dir1) * 4096 + el1] = (bf16)f2bf(S1); S1 = d1[j] * S1 + k1[j]; } }
        }
    }
}
__device__ __forceinline__ void gla_pass2_unit(const Ctx& C, int l, int unit) {
    const int lane = C.lane, w = C.wave, fr = lane & 15, fq = lane >> 4; const int b = unit >> 6, n = unit & 63, t0 = b * SEQ + n * 64;
    const GAS bf16* gqdf = C.W<bf16>(WS_QDF); const GAS bf16* gqdb = C.W<bf16>(WS_QDB); const GAS bf16* kv = C.W<bf16>(WS_KV); const GAS bf16* goin = C.W<bf16>(WS_OIN); const GAS bf16* sog = C.W<bf16>(WS_SOG); GAS bf16* ycat = C.W<bf16>(WS_YCAT); const GAS float* gng = C.inp<21>();
#pragma unroll
    for (int pp = 0; pp < 2; ++pp) {
        const int p = w * 2 + pp, h = p >> 2, ib = p & 3, u = b * 256 + h * 64 + n, tok = t0 + ib * 16 + fr;
        bf16x8 qf[2], qb[2];
#pragma unroll
        for (int kk = 0; kk < 2; ++kk) { qf[kk] = *(const GAS bf16x8*)(gqdf + (size_t)tok * 256 + h * 64 + kk * 32 + fq * 8); qb[kk] = *(const GAS bf16x8*)(gqdb + (size_t)tok * 256 + h * 64 + kk * 32 + fq * 8); }
        f32x4 o[4]; float ssq = 0.f;
#pragma unroll
        for (int dvb = 0; dvb < 4; ++dvb) { f32x4 a = {0.f, 0.f, 0.f, 0.f};
#pragma unroll
            for (int kk = 0; kk < 2; ++kk) { const bf16x8 pf = *(const GAS bf16x8*)(kv + ((size_t)u * 2 + 0) * 4096 + (dvb * 16 + fr) * 64 + kk * 32 + fq * 8), pb = *(const GAS bf16x8*)(kv + ((size_t)u * 2 + 1) * 4096 + (dvb * 16 + fr) * 64 + kk * 32 + fq * 8);
                a = MFMA16(pf, qf[kk], a); a = MFMA16(pb, qb[kk], a); }
            const u32x2 oi = *(const GAS u32x2*)(goin + (size_t)tok * 256 + h * 64 + dvb * 16 + 4 * fq);
            a[0] += bflo(oi.x); a[1] += bfhi(oi.x); a[2] += bflo(oi.y); a[3] += bfhi(oi.y); o[dvb] = a; ssq += a[0] * a[0] + a[1] * a[1] + a[2] * a[2] + a[3] * a[3]; }
        ssq += __shfl_xor(ssq, 16); ssq += __shfl_xor(ssq, 32);
        const float rs = __builtin_amdgcn_rsqf(ssq * (1.f / 64.f) + EPS);
#pragma unroll
        for (int dvb = 0; dvb < 4; ++dvb) { const int dv = dvb * 16 + 4 * fq; const f32x4 g = *(const GAS f32x4*)(gng + l * 64 + dv); const u32x2 sg = *(const GAS u32x2*)(sog + (size_t)tok * 256 + h * 64 + dv);
            u32x2 r; r.x = cvt_pk_bf16(o[dvb][0] * rs * g.x * bflo(sg.x), o[dvb][1] * rs * g.y * bfhi(sg.x)); r.y = cvt_pk_bf16(o[dvb][2] * rs * g.z * bflo(sg.y), o[dvb][3] * rs * g.w * bfhi(sg.y));
            *(GAS u32x2*)(ycat + (size_t)tok * 1024 + 768 + h * 64 + dv) = r; }
    }
}

__device__ __forceinline__ void s5_scan(const Ctx& C, int l) {
    const int gid = C.bid * 512 + C.tid; if (gid >= 16384) return;
    const int p = gid & 63, dir = (gid >> 6) & 1, b = (gid >> 7) & 7, g = gid >> 10; const size_t pi = ((size_t)(l * 2 + dir) * 16 + g) * 64 + p;
    const float lr = fminf(C.inp<3>()[pi], -1e-4f), li = C.inp<4>()[pi], dt = expf(C.inp<5>()[(l * 2 + dir) * 16 + g]); const float mg = expf(32.f * lr * dt); float sn, cs; sincosf(32.f * li * dt, &sn, &cs);
    const float are = mg * cs, aim = mg * sn; const GAS float* xl = C.W<float>(WS_XLOC); GAS bf16* ux = C.W<bf16>(WS_UX); float xr = 0.f, xi = 0.f;
    for (int i0 = 0; i0 < S5NCH; i0 += 16) {
        f32x2 v[16];
#pragma unroll
        for (int j = 0; j < 16; ++j) { const int c = dir ? (S5NCH - 1 - (i0 + j)) : (i0 + j); const size_t row = (size_t)g * S5ROWS + b * S5NCH + c; v[j] = *(const GAS f32x2*)(xl + row * 256 + dir * 128 + 2 * p); }
#pragma unroll
        for (int j = 0; j < 16; ++j) { const int c = dir ? (S5NCH - 1 - (i0 + j)) : (i0 + j); const size_t row = (size_t)g * S5ROWS + b * S5NCH + c;
            *(GAS unsigned*)(ux + row * UXP + 512 + dir * 128 + 2 * p) = cvt_pk_bf16(xr, xi);
            const float nr = are * xr - aim * xi + v[j].x, ni = are * xi + aim * xr + v[j].y; xr = nr; xi = ni; }
    }
}

__device__ __forceinline__ void router_phase(const Ctx& C) {
    const int lane = C.lane, fr = lane & 15, fq = lane >> 4; const int gw = C.bid * 8 + C.wave, NGW = C.G * 8;
    const GAS bf16* hb2 = C.W<bf16>(WS_HB2); const GAS bf16* wr = C.W<bf16>(WS_WRT); GAS float* probs = C.W<float>(WS_PROBS); GAS float* ss2 = C.W<float>(WS_SS2);
    for (int tg = gw; tg < T / 16; tg += NGW) {
        const int tok0 = tg * 16; f32x4 acc = {0.f, 0.f, 0.f, 0.f}; float ss = 0.f;
#pragma unroll
        for (int half = 0; half < 2; ++half) {
            u32x4 aw[16];
#pragma unroll
            for (int k2 = 0; k2 < 16; ++k2) aw[k2] = *(const GAS u32x4*)(hb2 + (size_t)(tok0 + fr) * D + (half * 16 + k2) * 32 + fq * 8);
#pragma unroll
            for (int k2 = 0; k2 < 16; ++k2) { const int kk = half * 16 + k2; float av[8]; unpack8(aw[k2], av);
#pragma unroll
                for (int i = 0; i < 8; ++i) ss += av[i] * av[i];
                const bf16x8 a = __builtin_bit_cast(bf16x8, aw[k2]);
                const bf16x8 bh = *(const GAS bf16x8*)(wr + (size_t)fr * D + kk * 32 + fq * 8), bl = *(const GAS bf16x8*)(wr + (size_t)(NE + fr) * D + kk * 32 + fq * 8);
                acc = MFMA16(a, bh, acc); acc = MFMA16(a, bl, acc); }
        }
        ss += __shfl_xor(ss, 16); ss += __shfl_xor(ss, 32);
        if (fq == 0) ss2[tok0 + fr] = ss;
        float pr[4];
#pragma unroll
        for (int r = 0; r < 4; ++r) { const float rs = __builtin_amdgcn_rsqf(__shfl(ss, 4 * fq + r) * (1.f / D) + EPS); const float lg = acc[r] * rs; float mx = lg;
#pragma unroll
            for (int off = 1; off < 16; off <<= 1) mx = fmaxf(mx, __shfl_xor(mx, off));
            const float e = __expf(lg - mx); float sm = e;
#pragma unroll
            for (int off = 1; off < 16; off <<= 1) sm += __shfl_xor(sm, off);
            pr[r] = e / sm; }
        const int b = tok0 >> 12, s = (tok0 & 4095) + 4 * fq;
        *(GAS f32x4*)(probs + ((size_t)(b * NE + fr)) * SEQ + s) = (f32x4){pr[0], pr[1], pr[2], pr[3]};
    }
}
__device__ __forceinline__ void xn8_rows(const Ctx& C, int b0, int nb) {
    const int lane = C.lane; const GAS bf16* hb2 = C.W<bf16>(WS_HB2); const GAS float* ss2 = C.W<float>(WS_SS2); GAS unsigned char* xn8 = C.W<unsigned char>(WS_XN8);
    const int w0 = (C.bid - b0) * 8 + C.wave, nw = nb * 8;
    for (int t0 = w0; t0 < T; t0 += 4 * nw) {
        u32x4 a[4], c[4]; float sq[4]; bool ok[4];
#pragma unroll
        for (int q = 0; q < 4; ++q) { const int t = t0 + q * nw; ok[q] = t < T; const int tt = ok[q] ? t : 0; sq[q] = ss2[tt]; a[q] = *(const GAS u32x4*)(hb2 + (size_t)tt * D + lane * 16); c[q] = *(const GAS u32x4*)(hb2 + (size_t)tt * D + lane * 16 + 8); }
#pragma unroll
        for (int q = 0; q < 4; ++q) if (ok[q]) { const int t = t0 + q * nw; const float rs16 = __builtin_amdgcn_rsqf(sq[q] * (1.f / D) + EPS) * SA8; float av[8], cv[8]; unpack8(a[q], av); unpack8(c[q], cv);
            u32x4 o; o.x = pack4_fp8(av[0] * rs16, av[1] * rs16, av[2] * rs16, av[3] * rs16); o.y = pack4_fp8(av[4] * rs16, av[5] * rs16, av[6] * rs16, av[7] * rs16);
            o.z = pack4_fp8(cv[0] * rs16, cv[1] * rs16, cv[2] * rs16, cv[3] * rs16); o.w = pack4_fp8(cv[4] * rs16, cv[5] * rs16, cv[6] * rs16, cv[7] * rs16);
            *(GAS u32x4*)(xn8 + (size_t)t * D + lane * 16) = o; }
    }
}
__device__ __forceinline__ void topk_phase(const Ctx& C) {
    if (C.bid >= NBATCH * NE) { if (C.G > NBATCH * NE) xn8_rows(C, NBATCH * NE, C.G - NBATCH * NE); return; }
    if (C.G <= NBATCH * NE) xn8_rows(C, 0, C.G);
    const int tid = C.tid, lane = C.lane, w = C.wave; const int be = C.bid, b = be >> 4, e = be & 15;
    LAS unsigned* hist = (LAS unsigned*)C.lds;
    LAS unsigned* wsum = (LAS unsigned*)(C.lds + 1024);
    LAS unsigned* sh = (LAS unsigned*)(C.lds + 1152);
    const GAS float* pp = C.W<float>(WS_PROBS) + (size_t)be * SEQ + tid * 8;
    unsigned v[8]; { const u32x4 a = *(const u32x4*)pp, c = *(const GAS u32x4*)(pp + 4); v[0] = a.x; v[1] = a.y; v[2] = a.z; v[3] = a.w; v[4] = c.x; v[5] = c.y; v[6] = c.z; v[7] = c.w; }
    unsigned prefix = 0u, mask = 0u, need = CAP;
    for (int pass = 0; pass < 4; ++pass) {
        const int shift = 24 - 8 * pass;
        if (tid < 256) hist[tid] = 0u;
        __syncthreads();
#pragma unroll
        for (int i = 0; i < 8; ++i) if ((v[i] & mask) == prefix) __hip_atomic_fetch_add(&hist[(v[i] >> shift) & 255u], 1u, __ATOMIC_RELAXED, __HIP_MEMORY_SCOPE_WORKGROUP);
        __syncthreads();
        unsigned cnt = 0u, suf = 0u;
        if (tid < 256) { cnt = hist[tid]; suf = cnt;
#pragma unroll
            for (int off = 1; off < 64; off <<= 1) { const unsigned o = shdn_(suf, off, lane); if (lane + off < 64) suf += o; }
            if (lane == 0) wsum[w] = suf; }
        __syncthreads();
        if (tid < 256) { for (int ww = w + 1; ww < 4; ++ww) suf += wsum[ww];
            const unsigned above = suf - cnt; if (suf >= need && above < need) { sh[0] = (unsigned)tid; sh[1] = need - above; } }
        __syncthreads();
        prefix |= sh[0] << shift; mask |= 255u << shift; need = sh[1];
        __syncthreads();
    }
    const unsigned thr = prefix;
    unsigned cg = 0u, ce = 0u;
#pragma unroll
    for (int i = 0; i < 8; ++i) { cg += v[i] > thr; ce += v[i] == thr; }
    unsigned pk = cg | (ce << 16), inc = pk;
#pragma unroll
    for (int off = 1; off < 64; off <<= 1) { const unsigned o = shup_(inc, off, lane); if (lane >= off) inc += o; }
    if (lane == 63) wsum[w] = inc;
    __syncthreads();
    unsigned base = 0u, tot = 0u; for (int ww = 0; ww < 8; ++ww) { const unsigned x = wsum[ww]; if (ww < w) base += x; tot += x; }
    const unsigned ex = base + inc - pk; unsigned sg = ex & 0xffffu, se = ex >> 16; const unsigned totg = tot & 0xffffu;
    GAS int* idx = C.W<int>(WS_IDX) + be * CAP; GAS float* gp = C.W<float>(WS_GATEP) + be * CAP; GAS short* sel = C.W<short>(WS_SEL);
#pragma unroll
    for (int i = 0; i < 8; ++i) { const int s = tid * 8 + i; int slot = -1;
        if (v[i] > thr) slot = (int)sg++; else if (v[i] == thr) { if (se < need) slot = (int)(totg + se); ++se; }
        if (slot >= 0) { idx[slot] = s; gp[slot] = __builtin_bit_cast(float, v[i]); }
        sel[((size_t)b * SEQ + s) * NE + e] = (short)slot; }
    __syncthreads();
}
__device__ __forceinline__ void gather_phase(const Ctx& C) {
    const int gw = C.bid * 8 + C.wave, NGW = C.G * 8, lane = C.lane; const GAS bf16* hb2 = C.W<bf16>(WS_HB2); GAS bf16* xe = C.W<bf16>(WS_XE); const GAS int* idx = C.W<int>(WS_IDX); const GAS float* ss2 = C.W<float>(WS_SS2);
    for (int r = gw; r < NBATCH * NE * CAP; r += NGW) { const int b = r >> 13, tok = b * SEQ + idx[r]; const float rs = __builtin_amdgcn_rsqf(ss2[tok] * (1.f / D) + EPS);
#pragma unroll
        for (int j = 0; j < 2; ++j) { float vv[8]; unpack8(*(const GAS u32x4*)(hb2 + (size_t)tok * D + j * 512 + lane * 8), vv);
#pragma unroll
            for (int i = 0; i < 8; ++i) vv[i] *= rs;
            *(GAS u32x4*)(xe + (size_t)r * D + j * 512 + lane * 8) = pack8(vv); } }
}
__device__ __forceinline__ void combine_phase(const Ctx& C, int l) {
    const int gw = C.bid * 8 + C.wave, NGW = C.G * 8, lane = C.lane; const GAS bf16* hb2 = C.W<bf16>(WS_HB2); const GAS unsigned char* ye = C.W<unsigned char>(WS_XE); const GAS short* sel = C.W<short>(WS_SEL); GAS bf16* hb = C.W<bf16>(WS_HB); const GAS float* fg = C.inp<31>();
    u32x4 r1lo = {0u, 0u, 0u, 0u}, r1hi = r1lo, r2lo = r1lo, r2hi = r1lo; int s1 = -1, s2 = -1;
    u32x2 yA[4], yC[4], zA[4], zC[4]; bool yon[4] = {false, false, false, false}, zon[4] = {false, false, false, false}; unsigned yrest = 0u, zrest = 0u;
    u32x4 r0lo = r1lo, r0hi = r1lo; int s0 = -1;
#define CB_ROW(tt, rlo, rhi, sv_) do { if ((tt) < T) { rlo = *(const GAS u32x4*)(hb2 + (size_t)(tt) * D + lane * 8); rhi = *(const GAS u32x4*)(hb2 + (size_t)(tt) * D + 512 + lane * 8); sv_ = (lane < 16) ? (int)sel[(size_t)(tt) * NE + lane] : -1; } else sv_ = -1; } while (0)
#define CB_YE(tt, sv_, A_, C_, on_, rest_) do { unsigned _m = (unsigned)(__ballot((sv_) >= 0) & 0xffffull); const int _b = (tt) >> 12; \
        _Pragma("unroll") for (int q = 0; q < 4; ++q) { on_[q] = _m != 0u; if (on_[q]) { const int e = __builtin_ctz(_m); _m &= _m - 1u; const int slot = __builtin_amdgcn_readlane((sv_), e); \
            const GAS unsigned char* yr = ye + ((size_t)(_b * NE + e) * CAP + slot) * D; A_[q] = *(const GAS u32x2*)(yr + lane * 8); C_[q] = *(const GAS u32x2*)(yr + 512 + lane * 8); } } rest_ = _m; } while (0)
    CB_ROW(gw, r0lo, r0hi, s0); CB_ROW(gw + NGW, r1lo, r1hi, s1);
    if (gw < T) CB_YE(gw, s0, yA, yC, yon, yrest);
    for (int t = gw; t < T; t += NGW) { const int b = t >> 12; float lo[8], hi[8];
        if (t + NGW < T) CB_YE(t + NGW, s1, zA, zC, zon, zrest); else { zrest = 0u; _Pragma("unroll") for (int q = 0; q < 4; ++q) zon[q] = false; }
        CB_ROW(t + 2 * NGW, r2lo, r2hi, s2);
        unpack8(r0lo, lo); unpack8(r0hi, hi);
#pragma unroll
        for (int q = 0; q < 4; ++q) if (yon[q]) { float a[8], c[8]; unpack8_fp8(yA[q], a); unpack8_fp8(yC[q], c);
#pragma unroll
            for (int i = 0; i < 8; ++i) { lo[i] += a[i] * (1.f / SY8); hi[i] += c[i] * (1.f / SY8); } }
        for (unsigned m = yrest; m; ) {
            const int e = __builtin_ctz(m); m &= m - 1u; const int slot = __builtin_amdgcn_readlane(s0, e); const GAS unsigned char* yr = ye + ((size_t)(b * NE + e) * CAP + slot) * D;
            float a[8], c[8]; unpack8_fp8(*(const GAS u32x2*)(yr + lane * 8), a); unpack8_fp8(*(const GAS u32x2*)(yr + 512 + lane * 8), c);
#pragma unroll
            for (int i = 0; i < 8; ++i) { lo[i] += a[i] * (1.f / SY8); hi[i] += c[i] * (1.f / SY8); } }
        r0lo = r1lo; r0hi = r1hi; s0 = s1; r1lo = r2lo; r1hi = r2hi; s1 = s2; yrest = zrest;
#pragma unroll
        for (int q = 0; q < 4; ++q) { yA[q] = zA[q]; yC[q] = zC[q]; yon[q] = zon[q]; }
        if (l + 1 < DEPTH) {
            const u32x4 w0 = pack8(lo), w1 = pack8(hi); float r0[8], r1[8]; unpack8(w0, r0); unpack8(w1, r1); float ss = 0.f;
#pragma unroll
            for (int i = 0; i < 8; ++i) ss += r0[i] * r0[i] + r1[i] * r1[i];
#pragma unroll
            for (int off = 1; off < 64; off <<= 1) ss += shxf_(ss, off, lane);
            *(GAS u32x4*)(hb + (size_t)t * D + lane * 8) = w0; *(GAS u32x4*)(hb + (size_t)t * D + 512 + lane * 8) = w1; if (lane == 0) C.W<float>(WS_SS1)[t] = ss;
            { const float sa = __builtin_amdgcn_rsqf(ss * (1.f / D) + EPS) * SA8;
              u32x2 o8; o8.x = pack4_fp8(r0[0] * sa, r0[1] * sa, r0[2] * sa, r0[3] * sa); o8.y = pack4_fp8(r0[4] * sa, r0[5] * sa, r0[6] * sa, r0[7] * sa); *(GAS u32x2*)(C.W<unsigned char>(WS_HB8) + (size_t)t * D + lane * 8) = o8;
              o8.x = pack4_fp8(r1[0] * sa, r1[1] * sa, r1[2] * sa, r1[3] * sa); o8.y = pack4_fp8(r1[4] * sa, r1[5] * sa, r1[6] * sa, r1[7] * sa); *(GAS u32x2*)(C.W<unsigned char>(WS_HB8) + (size_t)t * D + 512 + lane * 8) = o8; }
        } else { float ss = 0.f;
#pragma unroll
            for (int i = 0; i < 8; ++i) ss += lo[i] * lo[i] + hi[i] * hi[i];
#pragma unroll
            for (int off = 1; off < 64; off <<= 1) ss += shxf_(ss, off, lane);
            const float rs = __builtin_amdgcn_rsqf(ss * (1.f / D) + EPS); const GAS float* g = fg;
            { const f32x4 g0 = *(const GAS f32x4*)(g + lane * 8), g1 = *(const GAS f32x4*)(g + lane * 8 + 4); float* o = C.out + (size_t)t * D + lane * 8;
                *(GAS f32x4*)o = (f32x4){lo[0] * rs * g0.x, lo[1] * rs * g0.y, lo[2] * rs * g0.z, lo[3] * rs * g0.w};
                *(GAS f32x4*)(o + 4) = (f32x4){lo[4] * rs * g1.x, lo[5] * rs * g1.y, lo[6] * rs * g1.z, lo[7] * rs * g1.w}; }
            { const f32x4 g0 = *(const GAS f32x4*)(g + 512 + lane * 8), g1 = *(const GAS f32x4*)(g + 512 + lane * 8 + 4); float* o = C.out + (size_t)t * D + 512 + lane * 8;
                *(GAS f32x4*)o = (f32x4){hi[0] * rs * g0.x, hi[1] * rs * g0.y, hi[2] * rs * g0.z, hi[3] * rs * g0.w};
                *(GAS f32x4*)(o + 4) = (f32x4){hi[4] * rs * g1.x, hi[5] * rs * g1.y, hi[6] * rs * g1.z, hi[7] * rs * g1.w}; }
        }
    }
}

#ifndef MK_REPEAT
#define MK_REPEAT 0
#endif
#if MK_REPEAT
__device__ __forceinline__ int rep_count(int n) { asm volatile("" : "+s"(n)); return n; }
#define REPLOOP(k) for (int rep_ = 0, nrep_ = (((MK_REPEAT >> (k)) & 1) ? rep_count(2) : 1); rep_ < nrep_; ++rep_)
#define REP0 (rep_ == 0)
#else
#define REPLOOP(k)
#define REP0 true
#endif
__global__ void __launch_bounds__(512, 2) mega_fwd(Args args) {
    extern __shared__ __attribute__((aligned(16))) unsigned char lds_raw[];
    asm volatile("s_setreg_imm32_b32 hwreg(HW_REG_MODE, 23, 1), 1" ::: "memory");
    Ctx C0; C0.karg = (unsigned long long)__builtin_amdgcn_kernarg_segment_ptr(); C0.out = args.out; C0.ws = args.ws; C0.lds = (LAS unsigned char*)lds_raw;
    C0.tid = threadIdx.x; C0.lane = C0.tid & 63; C0.wave = __builtin_amdgcn_readfirstlane(C0.tid >> 6); C0.G = gridDim.x; C0.bid = blockIdx.x;
    volatile LAS unsigned* MISC = (volatile LAS unsigned*)(C0.lds + LDSCTL_OFF);
    if (C0.tid < 64) MISC[C0.tid] = 0u;
    __syncthreads();
    const int lo = args.ph_lo, hi = args.ph_hi;
    XcdBarrier bar; bar.bar = (unsigned*)(C0.ws + WS_CTL) + 4096 + args.li * XCD_BAR_WORDS; bar.x = 0; bar.st = nullptr;
    if (hi - lo > 1) bar = xcd_barrier_post((unsigned*)(C0.ws + WS_CTL) + 4096 + args.li * XCD_BAR_WORDS, MISC + 8);
    const bool skip_inplace = (args.flags & 1) != 0; const int pflags = args.flags;
#ifndef SUB_MASK
#define SUB_MASK 0xffff
#endif
#define SUB(k) ((SUB_MASK >> (k)) & 1)
#ifndef PHASE_MASK
#define PHASE_MASK 0x3fff
#endif
#define IN(p) (((PHASE_MASK >> ((p) - P)) & 1) && lo <= (p) && (p) < hi)
  \
#define SEAM(p) do { const int k_ = (p) - P; const bool nl_ = (k_ == 13) && (l + 1 < DEPTH); if ((k_ >= 0 && k_ <= 8) || nl_) { asm volatile("s_waitcnt vmcnt(0)" ::: "memory"); __syncthreads(); \
        if (threadIdx.x == 0) { if ((p) + 1 < hi) xcd_barrier_core(bar); } else { const Ctx Cs = fresh(C0); cvt_w12_seam(Cs, nl_ ? l + 1 : l, nl_ ? 0 : k_); } __syncthreads(); } \
        else if ((p) + 1 < hi) xcd_barrier(bar); } while (0)
    LAS unsigned char* lds = C0.lds;
    for (int l = 0; l < DEPTH; ++l) {
        const int P = l * NPH;
        if (l == 0 && IN(P + 0)) { const Ctx C = fresh(C0); REPLOOP(0) {
            if (SUB(0)) p0_convert(C, l, pflags, false);
            if (SUB(1)) if (l == 0) p0_x_to_hb(C);
            if (SUB(2)) p0_s5_kt(C, l);
            __syncthreads(); }
            SEAM(P + 0);
        }
        if (IN(P + 1)) { const Ctx C = fresh(C0); REPLOOP(1) {
            p1_s5_assemble<0>(C, l, 0, C.G);
            const int slot = C.bid % 3;
            if (slot == 0) cvt_w12(C, l, 0);
            __syncthreads();
            {
                int tid2 = C.tid; asm volatile("" : "+v"(tid2));
                SchedGrid S{(const char*)C.W<bf16>(WS_HB), (const char*)C.W<bf16>(WS_WIN), T / 256, 8, D * 2, D * 2, C.G, C.bid, D / 64};
                EpiInProj E{C.W<float>(WS_SS1), C.W<bf16>(WS_UX), C.W<bf16>(WS_XB), C.W<bf16>(WS_Q), C.W<float>(WS_ALR), C.W<bf16>(WS_GATES), 1.f};
                pg8::gemm_phase(lds, tid2, D * 2, D * 2, S, E); }
            __syncthreads();
            if (slot == 1) cvt_w12(C, l, 0);
            __syncthreads();
            {
                int tid2 = C.tid; asm volatile("" : "+v"(tid2));
                SchedGrid S{(const char*)C.W<unsigned char>(WS_HB8), (const char*)C.W<unsigned char>(WS_WIN8), T / 256, 12, D, D, C.G, C.bid, D / 128, 0, 1 << 30, 8};
                EpiGates E{C.W<unsigned char>(WS_GATES)};
                pg8::gemm_phase<EpiGates, SchedGrid, true, false>(lds, tid2, D, D, S, E); }
            __syncthreads();
            if (slot == 2) cvt_w12(C, l, 0);
            __syncthreads(); }
            SEAM(P + 1);
        }
        if (IN(P + 2)) { const Ctx C = fresh(C0); REPLOOP(2) {
            if (SUB(0) && !(pflags & 8)) { SchedS5 S{(const char*)C.W<bf16>(WS_UX), (const char*)C.W<bf16>(WS_S5MIN), 4, 2, 128, 256 * 512 * 2, 512 * 2, 8, C.G, C.bid, 128}; EpiXlocH E{C.W<float>(WS_XLOC)};
              pg8::gemm_phase<EpiXlocH, SchedS5, false, false, true>(lds, C.tid, UXP * 2, 512 * 2, S, E); }
            __syncthreads();
            if (SUB(1) && !(pflags & 2)) lru_pass1_all(C, l);
            if (SUB(2) && !(pflags & 4)) gla_pass1_all(C, l);
            __syncthreads(); }
            SEAM(P + 2);
        }
        if (IN(P + 3)) { const Ctx C = fresh(C0); REPLOOP(3) {
            s5_scan(C, l);
            if (C.bid >= 32) { Ctx C2 = C; C2.bid = C.bid - 32; lru_carry(C2); }
            if (!skip_inplace) gla_scan(C);
            if (C.G > 96) { if (C.bid >= 48) p1_s5_assemble<1>(C, l, 48, C.G - 48); } else p1_s5_assemble<1>(C, l, 0, C.G);
            __syncthreads(); cvt_w12(C, l, 1);
            __syncthreads(); }
            SEAM(P + 3);
        }
        if (IN(P + 4)) { const Ctx C = fresh(C0); REPLOOP(4) {
            if (SUB(0)) { SchedS5 S{(const char*)C.W<bf16>(WS_UX), (const char*)C.W<bf16>(WS_S5BT2), 4, 2, 128, 512 * UXP * 2, UXP * 2, 12, C.G, C.bid}; EpiS5Out E{C.W<bf16>(WS_Z)};
              pg8::gemm_phase(lds, C.tid, UXP * 2, UXP * 2, S, E); }
            if (SUB(1)) lru_pass2(C);
            if (SUB(2)) for (int u = C.bid; u < 512; u += C.G) gla_pass2_unit(C, l, u);
            __syncthreads(); }
            SEAM(P + 4);
        }
        if (IN(P + 5)) { const Ctx C = fresh(C0); REPLOOP(5) {
            SchedGrid S{(const char*)C.W<bf16>(WS_Z), (const char*)C.W<bf16>(WS_WGLU), T / 256, 1, 512, 512, C.G, C.bid, 4}; EpiGlu E{C.W<bf16>(WS_Z), C.W<bf16>(WS_YCAT)};
            pg8::gemm_phase(lds, C.tid, 512, 512, S, E);
            __syncthreads(); cvt_w12(C, l, 2);
            __syncthreads(); }
            SEAM(P + 5);
        }
        if (IN(P + 6)) { const Ctx C = fresh(C0); REPLOOP(6) {
            SchedUp S{(const char*)C.W<bf16>(WS_YCAT), (const char*)C.W<bf16>(WS_WUP), C.G, C.bid}; EpiUp E{C.W<unsigned char>(WS_GATES), C.W<bf16>(WS_MERGED)};
            pg8::gemm_phase<EpiUp, SchedUp, false, false, true>(lds, C.tid, D * 2, D * 2, S, E);
            __syncthreads(); }
            SEAM(P + 6);
        }
        if (IN(P + 7)) { const Ctx C = fresh(C0); REPLOOP(7) {
            SchedGrid S{(const char*)C.W<bf16>(WS_MERGED), (const char*)C.W<bf16>(WS_WMIX), T / 256, 4, D * 2, D * 2, C.G, C.bid, 16}; EpiMix E{C.W<bf16>(WS_HB), C.W<bf16>(WS_HB2)};
            pg8::gemm_phase(lds, C.tid, D * 2, D * 2, S, E);
            __syncthreads(); }
            SEAM(P + 7);
        }
        if (IN(P + 8)) { const Ctx C = fresh(C0); REPLOOP(8) { router_phase(C); __syncthreads(); } SEAM(P + 8); }
        if (IN(P + 9)) { const Ctx C = fresh(C0); REPLOOP(9) { topk_phase(C); __syncthreads(); cvt_w12(C, l, 3); __syncthreads(); } SEAM(P + 9); }
        if (IN(P + 11)) { const Ctx C = fresh(C0); REPLOOP(11) {
            SchedFfn S{(const char*)C.W<unsigned char>(WS_XN8), (const char*)C.W<unsigned char>(WS_W1), 16, D, D, 8, C.G, C.bid, (size_t)4096 * D}; EpiFfn1 E{C.W<unsigned char>(WS_HID)};
            pg8::gemm_phase<EpiFfn1, SchedFfn, true, true>(lds, C.tid, D, D, S, E, C.W<int>(WS_IDX), (const char*)C.W<unsigned char>(WS_XN8));
            __syncthreads(); }
            SEAM(P + 11);
        }
        if (IN(P + 12)) { const Ctx C = fresh(C0); REPLOOP(12) {
            SchedFfn S{(const char*)C.W<unsigned char>(WS_HID), (const char*)C.W<unsigned char>(WS_W2), 4, FF, FF, 16, C.G, C.bid, (size_t)D * FF}; EpiFfn2 E{C.W<float>(WS_GATEP), C.W<unsigned char>(WS_XE)};
            pg8::gemm_phase<EpiFfn2, SchedFfn, true, false>(lds, C.tid, FF, FF, S, E);
            __syncthreads(); }
            SEAM(P + 12);
        }
        if (IN(P + 13)) { const Ctx C = fresh(C0); REPLOOP(13) { combine_phase(C, l); if (l + 1 < DEPTH) { p0_convert(C, l + 1, pflags, false); p0_s5_kt(C, l + 1); } __syncthreads(); } SEAM(P + 13); }
    }
#undef IN
#undef SEAM
}


#ifndef MK_DEBUG
#define MK_DEBUG 0
#endif
#if MK_DEBUG
constexpr size_t WS_DIAG = 512 * 1024;
__global__ void dbg_scan(const void* p, size_t n, int is_f32, unsigned code, unsigned* diag, float thr = 3e38f) {
    bool bad = false;
    for (size_t i = (size_t)blockIdx.x * blockDim.x + threadIdx.x; i < n; i += (size_t)gridDim.x * blockDim.x) {
        float v; if (is_f32) v = ((const float*)p)[i]; else v = __builtin_bit_cast(float, (unsigned)((const unsigned short*)p)[i] << 16);
        bad |= !(fabsf(v) <= thr); }
    if (bad) atomicMin(diag + 2, code);
}
__global__ void dbg_oin(const unsigned short* p, unsigned* diag) {
    unsigned fl = 0;
    for (size_t i = (size_t)blockIdx.x * blockDim.x + threadIdx.x; i < (size_t)T * 256; i += (size_t)gridDim.x * blockDim.x) {
        const float v = __builtin_bit_cast(float, (unsigned)p[i] << 16); if (!(fabsf(v) <= 1e30f)) { const int col = (int)(i & 255), row = (int)(i >> 8); fl |= 1u << ((col & 63) >> 4); fl |= 16u << ((row & 63) >> 5); atomicAdd(diag + 1, 1u); } }
    if (fl) atomicOr(diag, fl);
}
__global__ void dbg_report(float* out, size_t n, const unsigned* diag) {
    unsigned k = diag[2]; if (k > 60u) return;
    const float c = sqrtf((float)k * 0.1f);
    for (size_t i = (size_t)blockIdx.x * blockDim.x + threadIdx.x; i < n; i += (size_t)gridDim.x * blockDim.x) out[i] = c;
}
#endif

extern "C" void kernel_launch(void* const* d_in, const int* in_sizes, int n_in, void* d_out, int out_size, void* d_ws, size_t ws_size, hipStream_t stream) {
    static int grid = 0;
    if (grid == 0) {
        if (n_in != 32 || ws_size < WS_END) { fprintf(stderr, "kernel_launch: unexpected n_in %d or ws_size %zu (need %zu)\n", n_in, ws_size, (size_t)WS_END); grid = -1; return; }
        int dev = 0, cus = 0, per_cu = 0;
        if (hipGetDevice(&dev) != hipSuccess || hipDeviceGetAttribute(&cus, hipDeviceAttributeMultiprocessorCount, dev) != hipSuccess) { grid = -1; return; }
        if (hipFuncSetAttribute((const void*)mega_fwd, hipFuncAttributeMaxDynamicSharedMemorySize, LDS_BYTES) != hipSuccess) { fprintf(stderr, "kernel_launch: hipFuncSetAttribute failed\n"); grid = -1; return; }
        if (hipOccupancyMaxActiveBlocksPerMultiprocessor(&per_cu, (const void*)mega_fwd, 512, LDS_BYTES) != hipSuccess || per_cu < 1) fprintf(stderr, "kernel_launch: occupancy query says %d\n", per_cu);
        (void)hipGetLastError();
        grid = cus;
    }
    if (grid < 0) return;
    (void)hipMemsetAsync((char*)d_ws + WS_CTL, 0, CTL_BYTES, stream);
#if MK_DEBUG
    (void)hipMemsetAsync((char*)d_ws + WS_DIAG, 0x7f, 64, stream);
#endif
    Args a{};
    for (int i = 0; i < 32; ++i) a.in[i] = (const float*)d_in[i];
    a.out = (float*)d_out; a.ws = (unsigned char*)d_ws;
#if MK_PER_PHASE
    for (int p = 0; p < DEPTH * NPH; ++p) { a.ph_lo = p; a.ph_hi = p + 1; a.li = 0; a.flags = 0; hipLaunchKernelGGL(mega_fwd, dim3(grid), dim3(512), LDS_BYTES, stream, a);
#if MK_DEBUG
        { unsigned char* w = (unsigned char*)d_ws; unsigned* diag = (unsigned*)(w + WS_DIAG); const unsigned code = (unsigned)p + 1u; const int ph = p % NPH, l = p / NPH;
#define SCAN(off, n, f) hipLaunchKernelGGL(dbg_scan, dim3(1024), dim3(256), 0, stream, (const void*)(w + (off)), (size_t)(n), (f), code, diag, 1e30f)
          if (ph == 0) { SCAN(WS_WIN, (size_t)NIN * D, 0); SCAN(WS_W1, (size_t)NE * 4096 * D, 0); SCAN(WS_W2, (size_t)NE * D * FF, 0); SCAN(WS_WUP, (size_t)D * D, 0); SCAN(WS_WMIX, (size_t)D * D, 0); SCAN(WS_WGLU, 65536, 0);
                         SCAN(WS_S5MIN, (size_t)16 * 256 * 512, 0); SCAN(WS_S5BT2, (size_t)16 * 512 * 768, 0); SCAN(WS_LRUW, 131072, 0); SCAN(WS_WRT, 32768, 0); if (l == 0) { SCAN(WS_HB, (size_t)T * D, 0); SCAN(WS_SS1, T, 1); } }
          if (ph == 1) { SCAN(WS_XB, (size_t)T * 512, 0); SCAN(WS_Q, (size_t)T * 1024, 0); SCAN(WS_ALR, (size_t)T * 32, 1); SCAN(WS_GATES, (size_t)T * 3072, 0); }
          if (false) hipLaunchKernelGGL(dbg_oin, dim3(1024), dim3(256), 0, stream, (const unsigned short*)(w + WS_OIN), diag);
          if (false) {
#define SCANT(off, n, f, cd, th) hipLaunchKernelGGL(dbg_scan, dim3(1024), dim3(256), 0, stream, (const void*)(w + (off)), (size_t)(n), (f), (unsigned)(cd), diag, (float)(th))
              SCANT(WS_HB, (size_t)T * D, 0, 1, 10.f); SCANT(WS_SS1, T, 1, 2, 3000.f); SCANT(WS_XB, (size_t)T * 512, 0, 4, 30.f); SCANT(WS_Q, (size_t)T * 1024, 0, 8, 30.f); SCANT(WS_GATES, (size_t)T * 3072, 0, 16, 1.01f); SCANT(WS_WIN, (size_t)NIN * D, 0, 32, 1.f); }
          if (ph == 2) { SCAN(WS_XLOC, (size_t)16 * 1024 * 256, 1); SCAN(WS_YLOC, (size_t)T * 512 * 3, 0); SCAN(WS_LSUM, (size_t)512 * 512 * 4, 1); SCAN(WS_OIN, (size_t)T * 256 * 3, 0); SCAN(WS_KV, (size_t)2048 * 2 * 4096, 0); SCAN(WS_GDEC, (size_t)2048 * 128, 1); }
          if (ph == 3) { SCAN(WS_UX, (size_t)16 * 1024 * 768, 0); SCAN(WS_LCAR, (size_t)512 * 512 * 2, 1); SCAN(WS_KV, (size_t)2048 * 2 * 4096, 0); }
          if (ph == 4) { SCAN(WS_Z, (size_t)T * 256, 0); }
          if (ph == 5) { SCAN(WS_YCAT, (size_t)T * 1024, 0); }
          if (ph == 6) { SCAN(WS_MERGED, (size_t)T * 1024, 0); }
          if (ph == 7) { SCAN(WS_HB2, (size_t)T * 1024, 0); }
          if (ph == 8) { SCAN(WS_PROBS, (size_t)128 * 4096, 1); SCAN(WS_SS2, T, 1); }
          if (ph == 9) { SCAN(WS_GATEP, 65536, 1); }
          if (ph == 10) { SCAN(WS_XE, (size_t)65536 * 1024, 0); }
          if (ph == 11) { SCAN(WS_HID, (size_t)65536 * 2048, 0); }
          if (ph == 12) { SCAN(WS_XE, (size_t)65536 * 1024, 0); }
          if (ph == 13) { if (l == 0) { SCAN(WS_HB, (size_t)T * D, 0); SCAN(WS_SS1, T, 1); } else hipLaunchKernelGGL(dbg_scan, dim3(1024), dim3(256), 0, stream, (const void*)d_out, (size_t)T * D, 1, code, diag, 1e30f); }
#undef SCAN
        }
#endif
    }
#if MK_DEBUG
    hipLaunchKernelGGL(dbg_report, dim3(1024), dim3(256), 0, stream, (float*)d_out, (size_t)T * D, (const unsigned*)((unsigned char*)d_ws + WS_DIAG));
#endif
#elif MK_PROBE >= 0
    { const int k = MK_PROBE; const int seg[6][3] = {{0, k + 1, 0}, {k, k + 1, MK_PROBE_FLAGS_SET}, {k + 1, NPH + k + 1, 0}, {NPH + k, NPH + k + 1, MK_PROBE_FLAGS_SET}, {NPH + k + 1, 2 * NPH, 0}, {0, 0, 0}};
      for (int i = 0; i < 5; ++i) { if (seg[i][1] <= seg[i][0]) continue; a.ph_lo = seg[i][0]; a.ph_hi = seg[i][1]; a.li = i; a.flags = seg[i][2]; hipLaunchKernelGGL(mega_fwd, dim3(grid), dim3(512), LDS_BYTES, stream, a); } }
#else
    a.ph_lo = 0; a.ph_hi = DEPTH * NPH; a.li = 0; a.flags = 0;
    hipLaunchKernelGGL(mega_fwd, dim3(grid), dim3(512), LDS_BYTES, stream, a);
#endif
    (void)out_size; (void)in_sizes;
}
```

```cpp
#include <hip/hip_runtime.h>
#include <cstdio>
#include <cstdint>

#define MK_PROBE_SET -1
#define MK_PROBE_FLAGS_SET 1
#define MK_PROBE MK_PROBE_SET
#define MK_REPEAT 0
#ifndef MK_PER_PHASE
#define MK_PER_PHASE 0
#endif

#define GAS __attribute__((address_space(1)))
#define LAS __attribute__((address_space(3)))
typedef unsigned short bf16;
typedef short bf16x8 __attribute__((ext_vector_type(8)));
typedef float f32x4 __attribute__((ext_vector_type(4)));
typedef float f32x2 __attribute__((ext_vector_type(2)));
typedef unsigned u32x4 __attribute__((ext_vector_type(4)));
typedef unsigned u32x2 __attribute__((ext_vector_type(2)));

constexpr int NBATCH = 8, SEQ = 4096, T = NBATCH * SEQ, D = 1024, DEPTH = 2;
constexpr int NIN = 5120;
constexpr int IN_W = 4896;
constexpr int NE = 16, FF = 2048, CAP = 512;
constexpr int S5L = 32, S5NCH = SEQ / S5L;
constexpr int S5ROWS = NBATCH * S5NCH;
constexpr int UXP = 768;
constexpr float EPS = 1e-6f;
constexpr float SA8 = 16.f, SW8 = 256.f, SH8 = 8.f, SY8 = 64.f;
constexpr int NPH = 14;

constexpr size_t MiB = 1u << 20;
constexpr size_t WS_CTL = 0, CTL_BYTES = 1 * MiB;
constexpr size_t WS_SS1 = 1 * MiB;
constexpr size_t WS_SS2 = WS_SS1 + 128 * 1024;
constexpr size_t WS_IDX = WS_SS2 + 128 * 1024;
constexpr size_t WS_GATEP = WS_IDX + 256 * 1024;
constexpr size_t WS_LRUW = WS_GATEP + 256 * 1024;
constexpr size_t WS_WRT = 2 * MiB;
constexpr size_t WS_LRUC8 = 2 * MiB + 128 * 1024;
constexpr size_t WS_SEL = 3 * MiB;
constexpr size_t WS_GDEC = 4 * MiB;
constexpr size_t WS_PROBS = 5 * MiB;
constexpr size_t WS_LSUM = 7 * MiB;
constexpr size_t WS_LCAR = 11 * MiB;
constexpr size_t WS_XLOC = 13 * MiB;
constexpr size_t WS_WGLU = 29 * MiB;
constexpr size_t WS_WUP = 30 * MiB;
constexpr size_t WS_WMIX = 32 * MiB;
constexpr size_t WS_S5MIN = 34 * MiB;
constexpr size_t WS_S5BT2 = 38 * MiB;
constexpr size_t WS_WIN = 50 * MiB;
constexpr size_t WS_WIN8 = 54 * MiB;
constexpr size_t WS_W1 = 60 * MiB;
constexpr size_t WS_W2 = 188 * MiB;
constexpr size_t WS_HB = 252 * MiB;
constexpr size_t WS_HB2 = 316 * MiB;
constexpr size_t WS_STAGE = 380 * MiB;
constexpr size_t WS_UX = WS_STAGE;
constexpr size_t WS_XB = WS_UX + 24 * MiB;
constexpr size_t WS_Q = WS_XB + 32 * MiB;
constexpr size_t WS_K = WS_Q + 16 * MiB;
constexpr size_t WS_V = WS_K + 16 * MiB;
constexpr size_t WS_SOG = WS_V + 16 * MiB;
constexpr size_t WS_ALR = WS_SOG + 16 * MiB;
constexpr size_t WS_GATES = WS_ALR + 4 * MiB;
constexpr size_t WS_YLOC = WS_GATES + 192 * MiB;
constexpr size_t WS_PF = WS_YLOC + 32 * MiB;
constexpr size_t WS_PB = WS_PF + 32 * MiB;
constexpr size_t WS_OIN = WS_PB + 32 * MiB;
constexpr size_t WS_QDF = WS_OIN + 16 * MiB;
constexpr size_t WS_QDB = WS_QDF + 16 * MiB;
constexpr size_t WS_KV = WS_QDB + 16 * MiB;
constexpr size_t WS_Z = WS_KV + 32 * MiB;
constexpr size_t WS_YCAT = WS_Z + 16 * MiB;
constexpr size_t WS_MIXEND = WS_YCAT + 64 * MiB;
constexpr size_t WS_MERGED = WS_XB;
constexpr size_t WS_XE = WS_STAGE;
constexpr size_t WS_HB8 = WS_STAGE + 400 * MiB;
constexpr size_t WS_XN8 = WS_STAGE + 400 * MiB;
constexpr size_t WS_HID = WS_STAGE + 128 * MiB;
constexpr size_t WS_END = (WS_MIXEND > WS_HID + 256 * MiB) ? WS_MIXEND : (WS_HID + 256 * MiB);
static_assert(WS_END <= 1000 * MiB && WS_XN8 >= WS_HID + 256 * MiB && WS_XN8 + 32 * MiB <= WS_END, "workspace map");

constexpr int LDS_BYTES = 160 * 1024;
constexpr int LDSCTL_OFF = LDS_BYTES - 1024;

__device__ __forceinline__ unsigned f2bf(float f) { unsigned u = __builtin_bit_cast(unsigned, f); return (u + 0x7fffu + ((u >> 16) & 1u)) >> 16; }
__device__ __forceinline__ float bf2f(unsigned h) { return __builtin_bit_cast(float, h << 16); }
typedef __bf16 bf16x2_t __attribute__((ext_vector_type(2)));
__device__ __forceinline__ unsigned cvt_pk_bf16(float lo, float hi) { const f32x2 v = {lo, hi}; return __builtin_bit_cast(unsigned, __builtin_convertvector(v, bf16x2_t)); }
__device__ __forceinline__ float bflo(unsigned w) { return __builtin_bit_cast(float, w << 16); }
__device__ __forceinline__ float bfhi(unsigned w) { return __builtin_bit_cast(float, w & 0xffff0000u); }
__device__ __forceinline__ float rcpf_(float x) { return __builtin_amdgcn_rcpf(x); }
__device__ __forceinline__ int   shx_(int v, int off, int lane)   { return __builtin_amdgcn_ds_bpermute((lane ^ off) << 2, v); }
__device__ __forceinline__ float shxf_(float v, int off, int lane) { return __builtin_bit_cast(float, __builtin_amdgcn_ds_bpermute((lane ^ off) << 2, __builtin_bit_cast(int, v))); }
__device__ __forceinline__ unsigned shdn_(unsigned v, int off, int lane) { return (unsigned)__builtin_amdgcn_ds_bpermute(((lane + off) & 63) << 2, (int)v); }
__device__ __forceinline__ unsigned shup_(unsigned v, int off, int lane) { return (unsigned)__builtin_amdgcn_ds_bpermute(((lane - off) & 63) << 2, (int)v); }
__device__ __forceinline__ float sigmoid_(float x) { return rcpf_(1.f + __expf(-x)); }
__device__ __forceinline__ float silu_(float x) { return x * sigmoid_(x); }
__device__ __forceinline__ float gelu_tanh_(float x) { const float u = 0.7978845608028654f * (x + 0.044715f * x * x * x); return x * sigmoid_(2.f * u); }
__device__ __forceinline__ float logsig_(float x) { return fminf(x, 0.f) - __logf(1.f + __expf(-fabsf(x))); }
__device__ __forceinline__ void unpack8(const u32x4 w, float (&o)[8]) { o[0] = bflo(w.x); o[1] = bfhi(w.x); o[2] = bflo(w.y); o[3] = bfhi(w.y); o[4] = bflo(w.z); o[5] = bfhi(w.z); o[6] = bflo(w.w); o[7] = bfhi(w.w); }
__device__ __forceinline__ u32x4 pack8(const float (&v)[8]) { u32x4 w; w.x = cvt_pk_bf16(v[0], v[1]); w.y = cvt_pk_bf16(v[2], v[3]); w.z = cvt_pk_bf16(v[4], v[5]); w.w = cvt_pk_bf16(v[6], v[7]); return w; }
__device__ __forceinline__ float clamp8_(float x) { return __builtin_amdgcn_fmed3f(x, -448.f, 448.f); }
__device__ __forceinline__ void unpack8_fp8(const u32x2 w, float (&o)[8]) { const f32x2 a = __builtin_amdgcn_cvt_pk_f32_fp8((int)w.x, false), b = __builtin_amdgcn_cvt_pk_f32_fp8((int)w.x, true), c = __builtin_amdgcn_cvt_pk_f32_fp8((int)w.y, false), d = __builtin_amdgcn_cvt_pk_f32_fp8((int)w.y, true);
    o[0] = a.x; o[1] = a.y; o[2] = b.x; o[3] = b.y; o[4] = c.x; o[5] = c.y; o[6] = d.x; o[7] = d.y; }
__device__ __forceinline__ unsigned pack4_fp8(float a, float b, float c, float d) { int r = 0; r = __builtin_amdgcn_cvt_pk_fp8_f32(a, b, r, false); r = __builtin_amdgcn_cvt_pk_fp8_f32(c, d, r, true); return (unsigned)r; }
typedef int i32x8 __attribute__((ext_vector_type(8)));
typedef int i32x4 __attribute__((ext_vector_type(4)));
#define LDS_WAIT() asm volatile("s_waitcnt lgkmcnt(0)" ::: "memory")
#define VM_WAIT() asm volatile("s_waitcnt vmcnt(0)" ::: "memory")
#define MFMA16(a, b, c) __builtin_amdgcn_mfma_f32_16x16x32_bf16((a), (b), (c), 0, 0, 0)

#define XB_TMO      128
#define XB_XCNT(j)  (256  + 64 * (j))
#define XB_XSUB(j)  (1280 + 64 * (j))
#define XB_XGEN(j)  (2304 + 64 * (j))
#define XB_TOP      3328
#define XB_TOPGEN   3392
#define XCD_BAR_WORDS 3456
#define XB_SPIN_CAP (1u << 18)
__device__ __forceinline__ unsigned xb_ld(unsigned* p)              { return __hip_atomic_load(p, __ATOMIC_RELAXED, __HIP_MEMORY_SCOPE_AGENT); }
__device__ __forceinline__ unsigned xb_add(unsigned* p, unsigned v) { return __hip_atomic_fetch_add(p, v, __ATOMIC_RELAXED, __HIP_MEMORY_SCOPE_AGENT); }
__device__ __forceinline__ unsigned xb_xcc_id() { return (unsigned)__builtin_amdgcn_s_getreg((3 << 11) | 20) & 0xFu; }
#define XB_SPIN(cond, bar) do { unsigned _sp = 0; while (cond) { __builtin_amdgcn_s_sleep(1); \
    if ((++_sp & 255u) == 0u) { if (xb_ld(&(bar)[XB_TMO])) break; if (_sp > XB_SPIN_CAP) { atomicAdd(&(bar)[XB_TMO], 1u); break; } } } } while (0)
struct XcdBarrier { unsigned* bar; unsigned x; volatile LAS unsigned* st; };
__device__ __forceinline__ XcdBarrier xcd_barrier_post(unsigned* bar, volatile LAS unsigned* st) {
    XcdBarrier b; b.bar = bar; b.x = xb_xcc_id(); b.st = st;
    if (threadIdx.x == 0) (void)xb_add(&bar[XB_XCNT(b.x)], 1u);
    return b;
}
__device__ __forceinline__ void xcd_barrier_complete(unsigned* bar, unsigned x, unsigned& nloc, unsigned& nx) {
    const unsigned G = gridDim.x * gridDim.y * gridDim.z;
    unsigned sum, cnt, mine, sp = 0u;
    for (;;) {
        sum = 0u; cnt = 0u; mine = 0u;
#pragma unroll
        for (unsigned j = 0; j < 16; ++j) { const unsigned c = xb_ld(&bar[XB_XCNT(j)]); sum += c; cnt += (c > 0u) ? 1u : 0u; mine = (j == x) ? c : mine; }
        if (sum == G) break;
        __builtin_amdgcn_s_sleep(1);
        if ((++sp & 255u) == 0u) { if (xb_ld(&bar[XB_TMO])) break; if (sp > XB_SPIN_CAP) { atomicAdd(&bar[XB_TMO], 1u); break; } }
    }
    nloc = mine > 0u ? mine : 1u; nx = cnt > 0u ? cnt : 1u;
}
__device__ __forceinline__ void xcd_barrier_core(const XcdBarrier& b) {
    {
        unsigned* bar = b.bar;
        __builtin_amdgcn_s_waitcnt(0);
        unsigned nloc = b.st[0], nx = b.st[1];
        if (nloc == 0u) { xcd_barrier_complete(bar, b.x, nloc, nx); b.st[0] = nloc; b.st[1] = nx; }
        const unsigned old = xb_add(&bar[XB_XSUB(b.x)], 1u);
        const unsigned gen = old / nloc;
        if (old + 1u == (gen + 1u) * nloc) {
            __builtin_amdgcn_fence(__ATOMIC_RELEASE, "agent");
            asm volatile("s_waitcnt vmcnt(0)" ::: "memory");
            const unsigned og = xb_add(&bar[XB_TOP], 1u);
            const unsigned tg = og / nx, target = (tg + 1u) * nx;
            if (og + 1u != target) XB_SPIN(xb_ld(&bar[XB_TOP]) < target, bar);
            __builtin_amdgcn_fence(__ATOMIC_ACQUIRE, "agent");
            asm volatile("s_waitcnt vmcnt(0)" ::: "memory");
        } else {
            const unsigned target = (gen + 1u) * nx;
            XB_SPIN(xb_ld(&bar[XB_TOP]) < target, bar);
            __builtin_amdgcn_fence(__ATOMIC_ACQUIRE, "agent");
            asm volatile("s_waitcnt vmcnt(0)" ::: "memory");
        }
    }
}
__device__ __forceinline__ void xcd_barrier(const XcdBarrier& b) {
    asm volatile("s_waitcnt vmcnt(0)" ::: "memory");
    __syncthreads();
    if (threadIdx.x == 0) xcd_barrier_core(b);
    __syncthreads();
}

namespace pg8 {
template <class E, class = void> struct acc0_of { static constexpr float v = 0.f; };
template <class E> struct acc0_of<E, decltype((void)E::ACC0)> { static constexpr float v = E::ACC0; };
constexpr int BM = 256, BK = 64, HALF = 128, HTB = HALF * BK * 2, STAGE_BYTES = 8 * HTB, NXCD = 8, WGM = 8;
__host__ __device__ __forceinline__ int lds_byte(int r, int c) { const int st = (r >> 4) * 2 + (c >> 5), rr = r & 15, cc = c & 31, ob = rr * 64 + cc * 2; return st * 1024 + (ob ^ (((ob >> 9) & 1) << 5)); }
__host__ __device__ __forceinline__ void stage_rc(int b, int& R, int& C) { const int st = b / 1024, sb = b % 1024, swz = sb ^ (((sb >> 9) & 1) << 5); R = (st >> 1) * 16 + swz / 64; C = (st & 1) * 32 + (swz % 64) / 2; }
__host__ __device__ __forceinline__ int perm32(int rho) { const int n = rho >> 4, i = rho & 15; return 8 * (i >> 2) + 4 * n + (i & 3); }

struct Unit { const char* a; const char* b; int row0, pn, aux, nt; };

__device__ __forceinline__ void tile_of(int L, int nM, int nN, int& pm, int& pn) {
    const int nwg = nM * nN; int wgid = L;
    { const int q = nwg / NXCD, r = nwg % NXCD, xcd = wgid % NXCD, off = wgid / NXCD; wgid = (xcd < r ? xcd * (q + 1) : r * (q + 1) + (xcd - r) * q) + off; }
    const int nig = WGM * nN, gid = wgid / nig, fm = gid * WGM, gsz = (nM - fm) < WGM ? (nM - fm) : WGM;
    pm = fm + ((wgid % nig) % gsz); pn = (wgid % nig) / gsz;
}

template <class Epi, class Sched, bool FP8 = false, bool GATHER = false, bool HALFN = false>
__device__ __forceinline__ void gemm_phase(LAS unsigned char* lds, const int tid, const int lda, const int ldb, const Sched& S, const Epi& E, const GAS int* gidx = nullptr, const char* gbaseA = nullptr) {
    const int wid = __builtin_amdgcn_readfirstlane(tid >> 6), lane = tid & 63, wr = wid >> 2, wc = wid & 3, fr = lane & 15, fq = lane >> 4;
    unsigned voffA[2], voffB[2]; unsigned gC = 0; int gR0 = 0;
#pragma unroll
    for (int i = 0; i < 2; ++i) { int R, C; stage_rc(tid * 16 + i * 8192, R, C); const int Rb = Epi::PERM ? ((R & ~31) + perm32(R & 31)) : R;
        voffA[i] = (unsigned)(R * lda + C * 2); voffB[i] = (unsigned)(Rb * ldb + C * 2); if (i == 0) { gR0 = R; gC = (unsigned)(C * 2); } }
    LAS unsigned* gtab = (LAS unsigned*)(lds + STAGE_BYTES);
    const size_t kstep = (size_t)(BK * 2);
    const size_t hstepA = (size_t)HALF * lda, hstepB = (size_t)HALF * ldb;
    const unsigned ldsw = (unsigned)wid * 1024u;
    const int aoff = lds_byte(wr * 64 + fr, fq * 8), boff = lds_byte(wc * 32 + fr, fq * 8);
    unsigned voffG[2] = {0u, 0u}; const char* gatesb = nullptr;
    if constexpr (HALFN && Epi::NSEG > 1) { gatesb = (const char*)E.gates;
#pragma unroll
        for (int i = 0; i < 2; ++i) { const int q = (i * 512 + tid) * 16; voffG[i] = (unsigned)((q >> 7) * 3072 + (q & 127)); } }
#define PG8_GPF(c, h) (gatesb + (size_t)(cur.row0 + 128 * (h)) * 3072 + (((c) >= 4) + ((c) >= 12)) * 1024 + cur.pn * 128)
#define PG8_STAGE_B1(bufoff, gaddr, c, h) do { if constexpr (HALFN && Epi::NSEG > 1) { PG8_STAGE(bufoff, PG8_GPF(c, h), voffG); } else { PG8_STAGE(bufoff, gaddr, voffB); } } while (0)
#define PG8_SA(b, h) (((b) * 2 + (h)) * HTB)
#define PG8_SB(b, h) ((4 + (b) * 2 + (h)) * HTB)
#define PG8_STAGE(bufoff, gbase, voff) do { _Pragma("unroll") for (int _i = 0; _i < 2; ++_i) \
        __builtin_amdgcn_global_load_lds((const unsigned*)((const char*)(gbase) + (voff)[_i]), (LAS unsigned*)(lds + (bufoff) + ldsw + _i * 8192), 16, 0, 0); } while (0)
#define PG8_LD8(p, koff) __builtin_shufflevector(*(const LAS i32x4*)(p), *(const LAS i32x4*)((p) + (koff)), 0, 1, 2, 3, 4, 5, 6, 7)
#define PG8_LDA(dst, b, h) do { _Pragma("unroll") for (int m = 0; m < 4; ++m) dst[m] = PG8_LD8(lds + PG8_SA(b, h) + aoff + m * 2048, 1024); } while (0)
#define PG8_LDB(dst, b, h) do { _Pragma("unroll") for (int n = 0; n < 2; ++n) dst[n] = PG8_LD8(lds + PG8_SB(b, h) + boff + n * 2048, 1024); } while (0)
#define PG8_LO(x) __builtin_bit_cast(bf16x8, __builtin_shufflevector((x), (x), 0, 1, 2, 3))
#define PG8_HI(x) __builtin_bit_cast(bf16x8, __builtin_shufflevector((x), (x), 4, 5, 6, 7))
#define PG8_MMA(ai, bj, At, Bt) do { if constexpr (FP8) { asm volatile("s_setprio 1"); _Pragma("unroll") for (int m = 0; m < 4; ++m) _Pragma("unroll") for (int n = 0; n < 2; ++n) \
        asm volatile("v_mfma_scale_f32_16x16x128_f8f6f4 %0, %1, %2, %0, %3, %4 op_sel_hi:[0,0,0]" : "+v"(acc[ai][bj][m][n]) : "v"(Bt[n]), "v"(At[m]), "v"(mscale), "v"(mscale2)); asm volatile("s_setprio 0"); } else { \
        asm volatile("s_setprio 1");   \
        _Pragma("unroll") for (int m = 0; m < 4; ++m) _Pragma("unroll") for (int n = 0; n < 2; ++n) asm volatile("v_mfma_f32_16x16x32_bf16 %0, %1, %2, %0" : "+v"(acc[ai][bj][m][n]) : "v"(PG8_LO(Bt[n])), "v"(PG8_LO(At[m]))); \
        _Pragma("unroll") for (int m = 0; m < 4; ++m) _Pragma("unroll") for (int n = 0; n < 2; ++n) asm volatile("v_mfma_f32_16x16x32_bf16 %0, %1, %2, %0" : "+v"(acc[ai][bj][m][n]) : "v"(PG8_HI(Bt[n])), "v"(PG8_HI(At[m]))); \
        asm volatile("s_setprio 0"); } } while (0)
#define PG8_MMAZ(ai, bj, At, Bt) do { if constexpr (FP8) { asm volatile("s_setprio 1"); _Pragma("unroll") for (int m = 0; m < 4; ++m) _Pragma("unroll") for (int n = 0; n < 2; ++n) \
        asm volatile("v_mfma_scale_f32_16x16x128_f8f6f4 %0, %1, %2, 0, %3, %4 op_sel_hi:[0,0,0]" : "=&v"(acc[ai][bj][m][n]) : "v"(Bt[n]), "v"(At[m]), "v"(mscale), "v"(mscale2)); asm volatile("s_setprio 0"); } else { \
        asm volatile("s_setprio 1"); \
        _Pragma("unroll") for (int m = 0; m < 4; ++m) _Pragma("unroll") for (int n = 0; n < 2; ++n) asm volatile("v_mfma_f32_16x16x32_bf16 %0, %1, %2, 0" : "=&v"(acc[ai][bj][m][n]) : "v"(PG8_LO(Bt[n])), "v"(PG8_LO(At[m]))); \
        _Pragma("unroll") for (int m = 0; m < 4; ++m) _Pragma("unroll") for (int n = 0; n < 2; ++n) asm volatile("v_mfma_f32_16x16x32_bf16 %0, %1, %2, %0" : "+v"(acc[ai][bj][m][n]) : "v"(PG8_HI(Bt[n])), "v"(PG8_HI(At[m]))); \
        asm volatile("s_setprio 0"); } } while (0)
#define PG8_WAIT_V(n) asm volatile("s_waitcnt vmcnt(" #n ")" ::: "memory")
#define PG8_WAIT_L(n) asm volatile("s_waitcnt lgkmcnt(" #n ")" ::: "memory")
#define PG8_BAR __builtin_amdgcn_s_barrier()
#define PG8_SCHED __builtin_amdgcn_sched_barrier(0)
    Unit cur, nxt; int ui = 0;
    constexpr bool ZINIT = (Epi::NSEG == 1) && (acc0_of<Epi>::v == 0.f);
    if (!S.next(0, cur)) return;
    f32x4 acc[2][2][4][2];
    if constexpr (!ZINIT) {
#pragma unroll
    for (int a = 0; a < 2; ++a)
#pragma unroll
        for (int b = 0; b < 2; ++b)
#pragma unroll
            for (int m = 0; m < 4; ++m)
#pragma unroll
                for (int n = 0; n < 2; ++n) acc[a][b][m][n] = (f32x4){acc0_of<Epi>::v, acc0_of<Epi>::v, acc0_of<Epi>::v, acc0_of<Epi>::v}; }
    i32x8 At[4], B0[2], B1[2];
    int mscale = 0x7f7f7f7f, mscale2 = 0x7f7f7f7f;
    if constexpr (FP8) mscale2 = Epi::MSCALE;
    asm volatile("" : "+v"(mscale), "+v"(mscale2)); (void)mscale; (void)mscale2;
    f32x4 tot[2][4][2];
    if constexpr (Epi::NSEG > 1) {
#pragma unroll
        for (int a = 0; a < 2; ++a)
#pragma unroll
            for (int m = 0; m < 4; ++m)
#pragma unroll
                for (int n = 0; n < 2; ++n) tot[a][m][n] = (f32x4){0.f, 0.f, 0.f, 0.f}; }
    const char* cA = GATHER ? gbaseA : cur.a; const char* cB = cur.b;
    int gpar = 0;
    if constexpr (GATHER) { gtab[tid & 255] = (unsigned)gidx[cur.row0 + (tid & 255)]; __syncthreads(); }
#define PG8_STAGE_A(bufoff, h, ko, nx) do { if constexpr (GATHER) { const LAS unsigned* _t = gtab + (((nx) ? (gpar ^ 1) : gpar) * 256) + (h) * HALF + gR0; const unsigned _b = (unsigned)((((nx) ? nxt.row0 : cur.row0) >> 13) * SEQ); \
        unsigned _vo[2]; _vo[0] = (_t[0] + _b) * (unsigned)lda + gC; _vo[1] = (_t[64] + _b) * (unsigned)lda + gC; PG8_STAGE(bufoff, gbaseA + (ko), _vo); } \
        else { PG8_STAGE(bufoff, ((nx) ? nA : cA) + (h) * hstepA + (ko), voffA); } } while (0)
    const char* nA = cA;
    PG8_STAGE(PG8_SB(0, 0), cB, voffB); PG8_STAGE_B1(PG8_SB(0, 1), cB + hstepB, 0, 0); PG8_STAGE_A(PG8_SA(0, 0), 0, (size_t)0, false); PG8_STAGE_A(PG8_SA(0, 1), 1, (size_t)0, false);
    if (wr == 1) PG8_BAR;
    PG8_WAIT_V(2); PG8_BAR;
    PG8_STAGE(PG8_SB(1, 0), cB + kstep, voffB); PG8_STAGE_A(PG8_SA(1, 0), 0, kstep, false); PG8_STAGE_B1(PG8_SB(1, 1), cB + hstepB + kstep, 0, 1);
    PG8_WAIT_V(6); PG8_BAR;
#define PG8_ITER(MM) do { const bool last = (t == nt - 2); \
            const size_t k1 = (size_t)(t + 1) * kstep, k2 = last ? (size_t)0 : (size_t)(t + 2) * kstep, k3 = k2 + kstep; \
            const char* b2 = last ? nB : cB + (size_t)(t + 2) * kstep; const char* b3 = b2 + kstep; \
            PG8_LDB(B0, 0, 0); if constexpr (!HALFN) PG8_LDB(B1, 0, 1); PG8_SCHED; PG8_LDA(At, 0, 0); PG8_STAGE_A(PG8_SA(1, 1), 1, k1, false); \
            PG8_WAIT_V(8); PG8_WAIT_L(0); PG8_BAR; MM(0, 0, At, B0); if constexpr (!HALFN) MM(0, 1, At, B1); PG8_BAR; PG8_SCHED; \
            PG8_LDA(At, 0, 1); PG8_STAGE(PG8_SB(0, 0), b2, voffB); PG8_STAGE_B1(PG8_SB(0, 1), b2 + hstepB, t, 0); PG8_STAGE_A(PG8_SA(0, 0), 0, k2, last); \
            PG8_WAIT_V(8); PG8_WAIT_L(0); PG8_BAR; MM(1, 0, At, B0); if constexpr (!HALFN) MM(1, 1, At, B1); PG8_BAR; PG8_SCHED; \
            PG8_LDB(B0, 1, 0); if constexpr (!HALFN) PG8_LDB(B1, 1, 1); PG8_SCHED; PG8_LDA(At, 1, 0); PG8_STAGE_A(PG8_SA(0, 1), 1, k2, last); \
            PG8_WAIT_V(8); PG8_WAIT_L(0); PG8_BAR; PG8_MMA(0, 0, At, B0); if constexpr (!HALFN) PG8_MMA(0, 1, At, B1); PG8_BAR; PG8_SCHED; \
            PG8_LDA(At, 1, 1); PG8_STAGE(PG8_SB(1, 0), b3, voffB); PG8_STAGE_B1(PG8_SB(1, 1), b3 + hstepB, t, 1); PG8_STAGE_A(PG8_SA(1, 0), 0, k3, last); \
            PG8_WAIT_V(8); PG8_WAIT_L(0); PG8_BAR; PG8_MMA(1, 0, At, B0); if constexpr (!HALFN) PG8_MMA(1, 1, At, B1); PG8_BAR; PG8_SCHED; } while (0)
    for (;;) {
        const bool has_next = S.next(ui + 1, nxt);
        nA = GATHER ? cA : (has_next ? nxt.a : cA); const char* nB = has_next ? nxt.b : cB;
        if constexpr (GATHER) { if (!has_next) nxt = cur;
            if (wid < 4) __builtin_amdgcn_global_load_lds((const unsigned*)(gidx + nxt.row0 + wid * 64 + lane), (LAS unsigned*)(gtab + (gpar ^ 1) * 256 + wid * 64), 4, 0, 0); }
        const int nt = cur.nt;
        int t = 0;
#pragma unroll 1
        for (int sg = 0; sg < Epi::NSEG; ++sg) {
        int tend = nt; if constexpr (Epi::NSEG > 1) tend = Epi::seg_end(sg);
        if constexpr (ZINIT) { PG8_ITER(PG8_MMAZ); t = 2; }
#pragma unroll 1
        for (; t < tend; t += 2) {
            PG8_ITER(PG8_MMA);
        }
        if constexpr (Epi::NSEG > 1) { asm volatile("s_nop 15\n\ts_nop 15" ::: "memory"); if (sg + 1 < Epi::NSEG) E.mid(acc, tot, lds + PG8_SB(0, 1), lds + PG8_SB(1, 1), cur, sg, wr, wc, fr, fq); }
        }
        asm volatile("s_nop 15\n\ts_nop 15" ::: "memory");
        if (wr == 0) PG8_BAR;
        if constexpr (Epi::NSEG > 1) E.fin(acc, tot, lds + PG8_SB(0, 1), lds + PG8_SB(1, 1), cur, wr, wc, fr, fq); else E(acc, cur, wr, wc, fr, fq);
        if (!has_next) break;
        if constexpr (!ZINIT) {
#pragma unroll
        for (int a = 0; a < 2; ++a)
#pragma unroll
            for (int b = 0; b < 2; ++b)
#pragma unroll
                for (int m = 0; m < 4; ++m)
#pragma unroll
                    for (int n = 0; n < 2; ++n) acc[a][b][m][n] = (f32x4){acc0_of<Epi>::v, acc0_of<Epi>::v, acc0_of<Epi>::v, acc0_of<Epi>::v}; }
        cur = nxt; cA = nA; cB = nB; ++ui;
        if constexpr (GATHER) gpar ^= 1;
        if (wr == 1) PG8_BAR;
    }
    PG8_WAIT_V(0);
    PG8_BAR;
#undef PG8_SA
#undef PG8_GPF
#undef PG8_STAGE_B1
#undef PG8_SB
#undef PG8_STAGE
#undef PG8_STAGE_A
#undef PG8_LD8
#undef PG8_LO
#undef PG8_HI
#undef PG8_LDA
#undef PG8_LDB
#undef PG8_MMA
#undef PG8_MMAZ
#undef PG8_ITER
#undef PG8_WAIT_V
#undef PG8_WAIT_L
#undef PG8_BAR
#undef PG8_SCHED
}
}
using pg8::Unit;

struct Args { const float* in[32]; float* out; unsigned char* ws; int ph_lo, ph_hi, li, flags; };
struct Ctx {
    unsigned long long karg; float* out; unsigned char* ws; LAS unsigned char* lds; int tid, lane, wave, G, bid;
    template <class Tp> __device__ __forceinline__ GAS Tp* W(size_t off) const { return (GAS Tp*)(ws + off); }
    template <int I> __device__ __forceinline__ const GAS float* inp() const { const float* p; asm volatile("s_load_dwordx2 %0, %1, %2\n\ts_waitcnt lgkmcnt(0)" : "=s"(p) : "s"(karg), "n"(I * 8) : "memory"); return (const GAS float*)p; }
};

__device__ __forceinline__ Ctx fresh(const Ctx& C0) {
    Ctx R = C0; asm volatile("" : "+s"(R.ws), "+s"(R.karg), "+s"(R.out));
    int ln; asm volatile("v_mbcnt_lo_u32_b32 %0, -1, 0\n\tv_mbcnt_hi_u32_b32 %0, -1, %0" : "=v"(ln));
    int t = (C0.wave << 6) | ln, b = C0.bid, g = C0.G; asm volatile("" : "+v"(t), "+s"(b), "+s"(g));
    R.out = (float*)(GAS float*)R.out; R.tid = t; R.lane = t & 63; R.wave = __builtin_amdgcn_readfirstlane(t >> 6); R.bid = b; R.G = g; return R;
}

struct SchedGrid {
    const char* A; const char* B; int nM, nN, lda, ldb, G, c, nt; int i0 = 0, i1 = 1 << 30; int pn0 = 0;
    __device__ __forceinline__ bool next(int i, Unit& u) const {
        i += i0; if (i >= i1) return false;
        const long L = (long)i * G + c; if (L >= (long)nM * nN) return false;
        int pm, pn; pg8::tile_of((int)L, nM, nN, pm, pn);
        u.a = A + (size_t)pm * 256 * lda; u.b = B + (size_t)pn * 256 * ldb; u.row0 = pm * 256; u.pn = pn + pn0; u.aux = 0; u.nt = nt; return true;
    }
};
struct SchedUp {
    const char* A; const char* B; int G, c;
    __device__ __forceinline__ bool next(int i, Unit& u) const {
        const long L = (long)i * G + c; if (L >= (long)(T / 256) * 8) return false;
        int pm, pn; pg8::tile_of((int)L, T / 256, 8, pm, pn);
        u.a = A + (size_t)pm * 256 * (D * 2); u.b = B + (size_t)pn * 128 * (D * 2); u.row0 = pm * 256; u.pn = pn; u.aux = 0; u.nt = 16; return true;
    }
};
struct SchedS5 {
    const char* A; const char* B; int nrt, nct, nunits, bstride_g  , ldb, nt, G, c; int ctrows = 256;
    __device__ __forceinline__ bool next(int i, Unit& u) const {
        const int L = i * G + c; if (L >= nunits) return false;
        const int per = nrt * nct, g = L / per, r = L % per, rt = r / nct, ct = r % nct;
        u.a = A + ((size_t)g * S5ROWS + rt * 256) * (UXP * 2); u.b = B + (size_t)g * bstride_g + (size_t)ct * ctrows * ldb; u.row0 = rt * 256; u.pn = ct; u.aux = g; u.nt = nt; return true;
    }
};
struct SchedFfn {
    const char* A; const char* B; int nN, lda, ldb, nt, G, c; size_t bstride_e;
    __device__ __forceinline__ bool next(int i, Unit& u) const {
        const long L = (long)i * G + c; if (L >= (long)256 * nN) return false;
        int vm, pn; pg8::tile_of((int)L, 256, nN, vm, pn);
        const int e = vm >> 4, rt = vm & 15, b = rt >> 1, half = rt & 1, row0 = (b * 16 + e) * 512 + half * 256;
        u.a = A + (size_t)row0 * lda; u.b = B + (size_t)e * bstride_e + (size_t)pn * 256 * ldb; u.row0 = row0; u.pn = pn; u.aux = e; u.nt = nt; return true;
    }
};

#define EPI_ROW(ai, m) (u.row0 + (ai) * 128 + wr * 64 + (m) * 16 + fr)
#define EPI_FENCE() asm volatile("" ::: "memory")
__device__ __forceinline__ u32x4 widen8(u32x2 xa, u32x2 xb) {
    const auto p = __builtin_amdgcn_permlane16_swap(xa.x, xb.x, false, false), q = __builtin_amdgcn_permlane16_swap(xa.y, xb.y, false, false);
    return (u32x4){p[0], q[0], p[1], q[1]}; }
struct EpiInProj {
    static constexpr bool PERM = true; static constexpr int NSEG = 1;
    const GAS float* ss1; GAS bf16* ux; GAS bf16* xb; GAS bf16* qkvs; GAS float* alr; GAS bf16* gates; float accscale;
    __device__ __forceinline__ void operator()(const f32x4 (&acc)[2][2][4][2], const Unit& u, int wr, int wc, int fr, int fq) const {
        const int pn = u.pn;
        float rsv[2][4];
#pragma unroll
        for (int ai = 0; ai < 2; ++ai)
#pragma unroll
            for (int m = 0; m < 4; ++m) rsv[ai][m] = ss1[EPI_ROW(ai, m)];
#pragma unroll
        for (int ai = 0; ai < 2; ++ai)
#pragma unroll
            for (int m = 0; m < 4; ++m) rsv[ai][m] = __builtin_amdgcn_rsqf(rsv[ai][m] * (1.f / D) + EPS) * accscale;
        if (pn == 7) {
            if (wc == 0) {
#pragma unroll
                for (int ai = 0; ai < 2; ++ai)
#pragma unroll
                    for (int m = 0; m < 4; ++m) { const int row = EPI_ROW(ai, m); const float rs = rsv[ai][m]; const f32x4 a = acc[ai][0][m][0] * rs, b = acc[ai][0][m][1] * rs;
                        *(GAS f32x4*)(alr + (size_t)row * 32 + 8 * fq) = a; *(GAS f32x4*)(alr + (size_t)row * 32 + 8 * fq + 4) = b; }
            }
            return;
        }
        GAS bf16* base; int rstride = 0, mode = 0; const bool s5 = (pn == 0);
        if (pn == 0) base = ux; else if (pn <= 2) { base = xb + (pn - 1) * 256; rstride = 512; } else if (pn <= 6) { base = qkvs + (size_t)(pn - 3) * T * 256; rstride = 256; mode = (pn == 6) ? 1 : 0; } else { base = gates + (pn - 8) * 256; rstride = 3072; mode = 2; }
#pragma unroll
        for (int ai = 0; ai < 2; ++ai)
#pragma unroll
            for (int m = 0; m < 4; ++m) { const int row = EPI_ROW(ai, m); const float rs = rsv[ai][m];
                const size_t roff = s5 ? (size_t)(row >> 5) * UXP + (row & 31) * 16 : (size_t)row * rstride;
#pragma unroll
                for (int bj = 0; bj < 2; ++bj) {
                    const int c = bj * 128 + wc * 32 + 8 * fq; const size_t coff = s5 ? (size_t)(c >> 4) * S5ROWS * UXP + (c & 15) : (size_t)c;
                    float vv[8];
#pragma unroll
                    for (int j = 0; j < 4; ++j) { vv[j] = acc[ai][bj][m][0][j] * rs; vv[4 + j] = acc[ai][bj][m][1][j] * rs; }
                    if (mode != 0) {
#pragma unroll
                        for (int j = 0; j < 8; ++j) { const float sg = sigmoid_(vv[j]); vv[j] = (mode == 1) ? vv[j] * sg : sg; } }
                    *(GAS u32x4*)(base + roff + coff) = pack8(vv);
                }
                EPI_FENCE(); }
    }
};
struct EpiGates {
    static constexpr bool PERM = true; static constexpr int NSEG = 1; static constexpr int MSCALE = 0x73737373;
    static_assert(SA8 * SW8 == 4096.f, "MSCALE = 2^-12");
    GAS unsigned char* gates;
    __device__ __forceinline__ void operator()(const f32x4 (&acc)[2][2][4][2], const Unit& u, int wr, int wc, int fr, int fq) const {
#pragma unroll
        for (int ai = 0; ai < 2; ++ai)
#pragma unroll
            for (int pr = 0; pr < 2; ++pr) { const int row = EPI_ROW(ai, 2 * pr + (fq & 1));
#pragma unroll
                for (int bj = 0; bj < 2; ++bj) { u32x2 o[2];
#pragma unroll
                    for (int h = 0; h < 2; ++h) { const int m = 2 * pr + h; unsigned lo = 0u, hi = 0u;
#pragma unroll
                        for (int j = 0; j < 4; ++j) {
                            lo = __builtin_amdgcn_cvt_pk_u8_f32(rcpf_(__builtin_fmaf(__builtin_amdgcn_exp2f(-acc[ai][bj][m][0][j]), 1.f / 255.f, 1.f / 255.f)), j, lo);
                            hi = __builtin_amdgcn_cvt_pk_u8_f32(rcpf_(__builtin_fmaf(__builtin_amdgcn_exp2f(-acc[ai][bj][m][1][j]), 1.f / 255.f, 1.f / 255.f)), j, hi); }
                        o[h] = (u32x2){lo, hi}; }
                    *(GAS u32x4*)(gates + (size_t)row * 3072 + (u.pn - 8) * 256 + bj * 128 + wc * 32 + 8 * (fq & ~1)) = widen8(o[0], o[1]); }
                EPI_FENCE(); }
    }
};
struct EpiXloc {
    static constexpr bool PERM = false; static constexpr int NSEG = 1;
    GAS float* xloc;
    __device__ __forceinline__ void operator()(const f32x4 (&acc)[2][2][4][2], const Unit& u, int wr, int wc, int fr, int fq) const {
#pragma unroll
        for (int ai = 0; ai < 2; ++ai)
#pragma unroll
            for (int m = 0; m < 4; ++m) { const int row = EPI_ROW(ai, m);
                GAS float* rowp = xloc + ((size_t)u.aux * S5ROWS + row) * 256 + wc * 32 + 4 * fq;
#pragma unroll
                for (int bj = 0; bj < 2; ++bj)
#pragma unroll
                    for (int n = 0; n < 2; ++n) *(GAS f32x4*)(rowp + bj * 128 + n * 16) = acc[ai][bj][m][n];
                EPI_FENCE(); }
    }
};
struct EpiXlocH {
    static constexpr bool PERM = false; static constexpr int NSEG = 1;
    GAS float* xloc;
    __device__ __forceinline__ void operator()(const f32x4 (&acc)[2][2][4][2], const Unit& u, int wr, int wc, int fr, int fq) const {
#pragma unroll
        for (int ai = 0; ai < 2; ++ai)
#pragma unroll
            for (int m = 0; m < 4; ++m) { const int row = EPI_ROW(ai, m);
                GAS float* rowp = xloc + ((size_t)u.aux * S5ROWS + row) * 256 + u.pn * 128 + wc * 32 + 4 * fq;
#pragma unroll
                for (int n = 0; n < 2; ++n) *(GAS f32x4*)(rowp + n * 16) = acc[ai][0][m][n];
                EPI_FENCE(); }
    }
};
struct EpiS5Out {
    static constexpr bool PERM = true; static constexpr int NSEG = 1;
    GAS bf16* z;
    __device__ __forceinline__ void operator()(const f32x4 (&acc)[2][2][4][2], const Unit& u, int wr, int wc, int fr, int fq) const {
#pragma unroll
        for (int ai = 0; ai < 2; ++ai)
#pragma unroll
            for (int m = 0; m < 4; ++m) { const int row = EPI_ROW(ai, m);
#pragma unroll
                for (int bj = 0; bj < 2; ++bj) {
                    const int c = u.pn * 256 + bj * 128 + wc * 32 + 8 * fq, jj = c >> 4, h0 = c & 15;
                    float vv[8];
#pragma unroll
                    for (int j = 0; j < 4; ++j) { vv[j] = gelu_tanh_(acc[ai][bj][m][0][j]); vv[4 + j] = gelu_tanh_(acc[ai][bj][m][1][j]); }
                    *(GAS u32x4*)(z + ((size_t)row * S5L + jj) * 256 + u.aux * 16 + h0) = pack8(vv);
                }
                EPI_FENCE(); }
    }
};
struct EpiGlu {
    static constexpr bool PERM = true; static constexpr int NSEG = 1;
    const GAS bf16* z; GAS bf16* ycat;
    __device__ __forceinline__ void operator()(const f32x4 (&acc)[2][2][4][2], const Unit& u, int wr, int wc, int fr, int fq) const {
#pragma unroll
        for (int ai = 0; ai < 2; ++ai) {
            u32x4 ld[4][2];
#pragma unroll
            for (int m = 0; m < 4; ++m)
#pragma unroll
                for (int bj = 0; bj < 2; ++bj) ld[m][bj] = *(const GAS u32x4*)(z + (size_t)EPI_ROW(ai, m) * 256 + bj * 128 + wc * 32 + 8 * fq);
#pragma unroll
            for (int m = 0; m < 4; ++m)
#pragma unroll
                for (int bj = 0; bj < 2; ++bj) { const int c = bj * 128 + wc * 32 + 8 * fq; float zz[8], vv[8]; unpack8(ld[m][bj], zz);
#pragma unroll
                    for (int j = 0; j < 4; ++j) { vv[j] = zz[j] * sigmoid_(acc[ai][bj][m][0][j]); vv[4 + j] = zz[4 + j] * sigmoid_(acc[ai][bj][m][1][j]); }
                    *(GAS u32x4*)(ycat + (size_t)EPI_ROW(ai, m) * 1024 + c) = pack8(vv); }
            EPI_FENCE(); }
    }
};
struct EpiUp {
    static constexpr bool PERM = true; static constexpr int NSEG = 3;
    static __device__ __forceinline__ int seg_end(int sg) { return sg == 0 ? 4 : (sg == 1 ? 12 : 16); }
    const GAS unsigned char* gates; GAS bf16* merged;
    __device__ __forceinline__ void add(f32x4 (&acc)[2][2][4][2], f32x4 (&tot)[2][4][2], const LAS unsigned char* g0, const LAS unsigned char* g1, int wr, int wc, int fr, int fq) const {
        u32x2 lg[2][4];
#pragma unroll
        for (int ai = 0; ai < 2; ++ai)
#pragma unroll
            for (int m = 0; m < 4; ++m) lg[ai][m] = *(const LAS u32x2*)((ai ? g1 : g0) + (wr * 64 + m * 16 + fr) * 128 + wc * 32 + 8 * fq);
#pragma unroll
        for (int ai = 0; ai < 2; ++ai)
#pragma unroll
            for (int m = 0; m < 4; ++m) { float gg[8];
#pragma unroll
                for (int j = 0; j < 4; ++j) { gg[j] = (float)((lg[ai][m].x >> (8 * j)) & 255u); gg[4 + j] = (float)((lg[ai][m].y >> (8 * j)) & 255u); }
#pragma unroll
                for (int j = 0; j < 4; ++j) { tot[ai][m][0][j] += gg[j] * acc[ai][0][m][0][j]; tot[ai][m][1][j] += gg[4 + j] * acc[ai][0][m][1][j]; }
                acc[ai][0][m][0] = (f32x4){0.f, 0.f, 0.f, 0.f}; acc[ai][0][m][1] = (f32x4){0.f, 0.f, 0.f, 0.f}; }
    }
    __device__ __forceinline__ void mid(f32x4 (&acc)[2][2][4][2], f32x4 (&tot)[2][4][2], const LAS unsigned char* g0, const LAS unsigned char* g1, const Unit& u, int sg, int wr, int wc, int fr, int fq) const { add(acc, tot, g0, g1, wr, wc, fr, fq); }
    __device__ __forceinline__ void fin(f32x4 (&acc)[2][2][4][2], f32x4 (&tot)[2][4][2], const LAS unsigned char* g0, const LAS unsigned char* g1, const Unit& u, int wr, int wc, int fr, int fq) const {
        add(acc, tot, g0, g1, wr, wc, fr, fq);
#pragma unroll
        for (int ai = 0; ai < 2; ++ai)
#pragma unroll
            for (int m = 0; m < 4; ++m) { float vv[8];
#pragma unroll
                for (int j = 0; j < 4; ++j) { vv[j] = tot[ai][m][0][j] * (1.f / 255.f); vv[4 + j] = tot[ai][m][1][j] * (1.f / 255.f); }
                *(GAS u32x4*)(merged + (size_t)EPI_ROW(ai, m) * 1024 + u.pn * 128 + wc * 32 + 8 * fq) = pack8(vv);
                tot[ai][m][0] = (f32x4){0.f, 0.f, 0.f, 0.f}; tot[ai][m][1] = (f32x4){0.f, 0.f, 0.f, 0.f}; }
    }
    __device__ __forceinline__ void operator()(const f32x4 (&)[2][2][4][2], const Unit&, int, int, int, int) const {}
};
struct EpiMix {
    static constexpr bool PERM = true; static constexpr int NSEG = 1;
    const GAS bf16* hb; GAS bf16* hb2;
    __device__ __forceinline__ void operator()(const f32x4 (&acc)[2][2][4][2], const Unit& u, int wr, int wc, int fr, int fq) const {
        u32x4 ldq[2][4][2];
#pragma unroll
        for (int ai = 0; ai < 2; ++ai)
#pragma unroll
            for (int m = 0; m < 4; ++m)
#pragma unroll
                for (int bj = 0; bj < 2; ++bj) ldq[ai][m][bj] = *(const GAS u32x4*)(hb + (size_t)EPI_ROW(ai, m) * 1024 + u.pn * 256 + bj * 128 + wc * 32 + 8 * fq);
#pragma unroll
        for (int ai = 0; ai < 2; ++ai) {
#pragma unroll
            for (int m = 0; m < 4; ++m)
#pragma unroll
                for (int bj = 0; bj < 2; ++bj) { const int c = u.pn * 256 + bj * 128 + wc * 32 + 8 * fq; float hh[8], vv[8]; unpack8(ldq[ai][m][bj], hh);
#pragma unroll
                    for (int j = 0; j < 4; ++j) { vv[j] = hh[j] + acc[ai][bj][m][0][j]; vv[4 + j] = hh[4 + j] + acc[ai][bj][m][1][j]; }
                    *(GAS u32x4*)(hb2 + (size_t)EPI_ROW(ai, m) * 1024 + c) = pack8(vv); }
            EPI_FENCE(); }
    }
};
struct EpiFfn1 {
    static constexpr bool PERM = true; static constexpr int NSEG = 1; static constexpr int MSCALE = 0x73737373;
    static_assert(SA8 * SW8 == 4096.f, "MSCALE = 2^-12");
    GAS unsigned char* hid;
    __device__ __forceinline__ void operator()(const f32x4 (&acc)[2][2][4][2], const Unit& u, int wr, int wc, int fr, int fq) const {
#pragma unroll
        for (int ai = 0; ai < 2; ++ai)
#pragma unroll
            for (int pr = 0; pr < 2; ++pr) { u32x2 o[2];
#pragma unroll
                for (int h = 0; h < 2; ++h) { const int m = 2 * pr + h; float vv[8];
#pragma unroll
                    for (int j = 0; j < 4; ++j) { const float a0 = acc[ai][0][m][0][j], a1 = acc[ai][0][m][1][j];
                        vv[j] = (a0 * acc[ai][1][m][0][j]) * rcpf_(1.f + __builtin_amdgcn_exp2f(-a0)); vv[4 + j] = (a1 * acc[ai][1][m][1][j]) * rcpf_(1.f + __builtin_amdgcn_exp2f(-a1)); }
                    o[h].x = pack4_fp8(vv[0], vv[1], vv[2], vv[3]); o[h].y = pack4_fp8(vv[4], vv[5], vv[6], vv[7]); }
                const int row = EPI_ROW(ai, 2 * pr + (fq & 1));
                *(GAS u32x4*)(hid + (size_t)row * FF + u.pn * 128 + wc * 32 + 8 * (fq & ~1)) = widen8(o[0], o[1]);
                EPI_FENCE(); }
    }
};
struct EpiFfn2 {
    static constexpr bool PERM = true; static constexpr int NSEG = 1; static constexpr int MSCALE = 0x7f7f7f7f;
    const GAS float* gatep; GAS unsigned char* ye;
    __device__ __forceinline__ void operator()(const f32x4 (&acc)[2][2][4][2], const Unit& u, int wr, int wc, int fr, int fq) const {
        float gpv[2][4];
#pragma unroll
        for (int ai = 0; ai < 2; ++ai)
#pragma unroll
            for (int m = 0; m < 4; ++m) gpv[ai][m] = gatep[EPI_ROW(ai, m)];
#pragma unroll
        for (int ai = 0; ai < 2; ++ai)
#pragma unroll
            for (int pr = 0; pr < 2; ++pr) { const int row = EPI_ROW(ai, 2 * pr + (fq & 1));
#pragma unroll
                for (int bj = 0; bj < 2; ++bj) { u32x2 o[2];
#pragma unroll
                    for (int h = 0; h < 2; ++h) { const int m = 2 * pr + h; const float gp = gpv[ai][m] * (SY8 / (SH8 * SW8)); float vv[8];
#pragma unroll
                        for (int j = 0; j < 4; ++j) { vv[j] = gp * acc[ai][bj][m][0][j]; vv[4 + j] = gp * acc[ai][bj][m][1][j]; }
                        o[h].x = pack4_fp8(vv[0], vv[1], vv[2], vv[3]); o[h].y = pack4_fp8(vv[4], vv[5], vv[6], vv[7]); }
                    *(GAS u32x4*)(ye + (size_t)row * 1024 + u.pn * 256 + bj * 128 + wc * 32 + 8 * (fq & ~1)) = widen8(o[0], o[1]);
                }
                EPI_FENCE(); }
    }
};

__device__ __forceinline__ void cvt_tile(const bool F8, const GAS float* src, int sp, const GAS float* kscale, float mul, int valid, GAS void* dstv, int dp, LAS float* scr, int lane) {
    const int nn = (lane & 15) * 4, kq = lane >> 4;
    f32x4 v[16]; float ks[16];
    if (kscale) {
#pragma unroll
        for (int i = 0; i < 16; ++i) ks[i] = kscale[i * 4 + kq];
    } else {
#pragma unroll
        for (int i = 0; i < 16; ++i) ks[i] = 1.f;
    }
    if (nn < valid) {
#pragma unroll
        for (int i = 0; i < 16; ++i) v[i] = *(const GAS f32x4*)(src + (size_t)(i * 4 + kq) * sp + nn);
    } else {
#pragma unroll
        for (int i = 0; i < 16; ++i) v[i] = (f32x4){0.f, 0.f, 0.f, 0.f};
    }
#pragma unroll
    for (int i = 0; i < 16; ++i) { const int kk = i * 4 + kq; const float s = ks[i] * mul; LAS float* p = scr + kk * 65 + nn; p[0] = v[i].x * s; p[1] = v[i].y * s; p[2] = v[i].z * s; p[3] = v[i].w * s; }
    LDS_WAIT(); asm volatile("" ::: "memory");
    const int c = lane & 7;
#pragma unroll
    for (int j = 0; j < 8; ++j) { const int n = (lane >> 3) + 8 * j; const LAS float* s = scr + (8 * c) * 65 + n;
        if (F8) { u32x2 o; o.x = pack4_fp8(s[0 * 65], s[1 * 65], s[2 * 65], s[3 * 65]); o.y = pack4_fp8(s[4 * 65], s[5 * 65], s[6 * 65], s[7 * 65]); *(GAS u32x2*)((GAS unsigned char*)dstv + (size_t)n * dp + 8 * c) = o; }
        else { u32x4 o; o.x = cvt_pk_bf16(s[0 * 65], s[1 * 65]); o.y = cvt_pk_bf16(s[2 * 65], s[3 * 65]); o.z = cvt_pk_bf16(s[4 * 65], s[5 * 65]); o.w = cvt_pk_bf16(s[6 * 65], s[7 * 65]);
            *(GAS u32x4*)((GAS bf16*)dstv + (size_t)n * dp + 8 * c) = o; } }
    LDS_WAIT(); asm volatile("" ::: "memory");
}

constexpr int SEAM_CVT_TILES = 7 * 8;
struct W12Item { const GAS float* src; const GAS float* ksc; GAS unsigned char* dst; int sp, dp; float mul; };
__device__ __forceinline__ W12Item w12_item(int r, int l, const GAS float* wg, const GAS float* wu, const GAS float* wd, const GAS float* fng, GAS unsigned char* w1, GAS unsigned char* w2) {
    W12Item I;
    if (r < 16 * 16 * 64) { const int e = r >> 10, kt = (r >> 6) & 15, ntile = r & 63, n0 = ntile * 64, pn = n0 >> 8, rr = n0 & 255;
        I.src = (rr < 128 ? wg : wu) + ((size_t)(l * NE + e) * D + kt * 64) * FF + pn * 128 + (rr & 127); I.sp = FF; I.ksc = fng + l * D + kt * 64; I.dst = w1 + ((size_t)e * 4096 + n0) * D + kt * 64; I.dp = D;
        I.mul = rr < 128 ? 1.4426950408889634f : SH8 / 1.4426950408889634f; }
    else { r -= 16 * 16 * 64; const int e = r >> 9, kt = (r >> 4) & 31, ntile = r & 15;
        I.src = wd + ((size_t)(l * NE + e) * FF + kt * 64) * D + ntile * 64; I.sp = D; I.ksc = nullptr; I.dst = w2 + ((size_t)e * D + ntile * 64) * FF + kt * 64; I.dp = FF; I.mul = 1.f; }
    return I;
}
__device__ __forceinline__ void w12_load(const W12Item& I, int lane, f32x4 (&v)[16]) {
    const int nn = (lane & 15) * 4, kq = lane >> 4;
#pragma unroll
    for (int i = 0; i < 16; ++i) v[i] = *(const GAS f32x4*)(I.src + (size_t)(i * 4 + kq) * I.sp + nn);
}
__device__ __forceinline__ void w12_to_lds(const W12Item& I, int lane, const f32x4 (&v)[16], const float (&ks)[16], LAS float* scr) {
    const int nn = (lane & 15) * 4, kq = lane >> 4; const bool sc = I.ksc != nullptr;
#pragma unroll
    for (int i = 0; i < 16; ++i) { const int kk = i * 4 + kq; const float s = sc ? ks[i] * I.mul : SW8; LAS float* p = scr + kk * 65 + nn; p[0] = v[i].x * s; p[1] = v[i].y * s; p[2] = v[i].z * s; p[3] = v[i].w * s; }
}
__device__ __forceinline__ void w12_store(const W12Item& I, int lane, LAS float* scr, bool nostore) {
    LDS_WAIT(); asm volatile("" ::: "memory");
    const int c = lane & 7;
#pragma unroll
    for (int j = 0; j < 8; ++j) { const int n = (lane >> 3) + 8 * j; const LAS float* s = scr + (8 * c) * 65 + n;
        u32x2 o; o.x = pack4_fp8(s[0 * 65], s[1 * 65], s[2 * 65], s[3 * 65]); o.y = pack4_fp8(s[4 * 65], s[5 * 65], s[6 * 65], s[7 * 65]);
        *(GAS u32x2*)(I.dst + (size_t)n * I.dp + 8 * c) = o; }
    LDS_WAIT(); asm volatile("" ::: "memory");
}
__device__ __forceinline__ void w12_share(int bid, int G, int slot, int& first, int& step, int& cnt) {
    if (G != 256) { first = bid * 8; step = G * 8; cnt = (slot == 0) ? (1 << 30) : 0; return; }
    int start, lo, hi;
    if (bid < 48) { start = bid * 60; lo = 0; hi = (slot == 0) ? 60 : 0; }
    else if (bid < 128) { start = 2880 + (bid - 48) * 92; lo = (slot == 0) ? 0 : 63; hi = (slot == 0) ? 63 : (slot == 1 ? 92 : 63); }
    else { start = 10240 + (bid - 128) * 112; lo = (slot == 0) ? 0 : (slot == 1 ? 61 : (slot == 2 ? 87 : 102)); hi = (slot == 0) ? 61 : (slot == 1 ? 87 : (slot == 2 ? 102 : 112)); }
    first = start + lo; step = 8; cnt = hi - lo;
}
__device__ __forceinline__ void cvt_w12(const Ctx& C, int l, int slot) {
    LAS float* scr = (LAS float*)(C.lds + C.wave * 16640);
    const int lane = C.lane; constexpr int END = 16 * 16 * 64 + 16 * 32 * 16;
    int first, step, cnt; w12_share(C.bid, C.G, slot, first, step, cnt);
    if (C.G == 256 && slot == 0) return;
    const int last = (C.G == 256) ? first + cnt : END;
    int it = first + C.wave; if (cnt <= 0 || it >= last) return;
    const GAS float* wg = C.inp<28>(); const GAS float* wu = C.inp<29>(); const GAS float* wd = C.inp<30>(); const GAS float* fng = C.inp<26>(); GAS unsigned char* w1 = C.W<unsigned char>(WS_W1); GAS unsigned char* w2 = C.W<unsigned char>(WS_W2);
    f32x4 v[16]; float ks[16]; int ks_kt = -1;
    W12Item A = w12_item(it, l, wg, wu, wd, fng, w1, w2); w12_load(A, lane, v);
    for (;;) {
        if (A.ksc) { const int kt = (it >> 6) & 15; if (kt != ks_kt) {
#pragma unroll
            for (int i = 0; i < 16; ++i) ks[i] = A.ksc[i * 4 + (lane >> 4)] * SW8;
            ks_kt = kt; } }
        w12_to_lds(A, lane, v, ks, scr);
        const W12Item Cur = A; const int nx = it + step; const bool more = nx < last;
        if (more) { int ln = lane; asm volatile("" : "+v"(ln)); A = w12_item(nx, l, wg, wu, wd, fng, w1, w2); w12_load(A, ln, v); }
        w12_store(Cur, lane, scr, false);
        if (!more) break;
        it = nx;
    }
}

__device__ __forceinline__ void cvt_w12_seam(const Ctx& C, int l, int k) {
    if (C.G != 256 || C.wave == 0) return;
    int first, step, cnt; w12_share(C.bid, C.G, 0, first, step, cnt);
    const int rem = cnt - SEAM_CVT_TILES;
    if (k == 0 && C.wave - 1 >= rem) return;
    const int it = (k == 0) ? first + (C.wave - 1) : first + rem + 7 * (k - 1) + (C.wave - 1);
    LAS float* scr = (LAS float*)(C.lds + C.wave * 16640); const int lane = C.lane;
    const GAS float* wg = C.inp<28>(); const GAS float* wu = C.inp<29>(); const GAS float* wd = C.inp<30>(); const GAS float* fng = C.inp<26>(); GAS unsigned char* w1 = C.W<unsigned char>(WS_W1); GAS unsigned char* w2 = C.W<unsigned char>(WS_W2);
    f32x4 v[16]; float ks[16];
    const W12Item A = w12_item(it, l, wg, wu, wd, fng, w1, w2); w12_load(A, lane, v);
    if (A.ksc) {
#pragma unroll
        for (int i = 0; i < 16; ++i) ks[i] = A.ksc[i * 4 + (lane >> 4)] * SW8; }
    w12_to_lds(A, lane, v, ks, scr);
    w12_store(A, lane, scr, false);
}
__device__ __forceinline__ void p0_convert(const Ctx& C, int l, int pflags, const bool big) {
    LAS float* scr = (LAS float*)(C.lds + C.wave * 16640);
    const int gw = C.bid * 8 + C.wave, NGW = C.G * 8, lane = C.lane;
    constexpr int I_IN = 16 * 80, I_W1 = 16 * 16 * 64, I_W2 = 16 * 32 * 16, I_UP = 16 * 16, I_MIX = 16 * 16, I_GLU = 4 * 4, I_LRU = 32;
    constexpr int NITEMS = I_IN + I_W1 + I_W2 + I_UP + I_MIX + I_GLU + I_LRU;
    for (int it = (big ? gw : gw + I_W1 + I_W2); it < (big ? I_W1 + I_W2 : NITEMS); it += NGW) {
        int r = it; const GAS float* src; int sp; const GAS float* ksc = nullptr; float mul = 1.f; int valid = 64; GAS bf16* dst = nullptr; int dp; bool f8 = false; GAS unsigned char* dst8 = nullptr;
        if (r < I_W1) {
            const int e = r >> 10, kt = (r >> 6) & 15, ntile = r & 63, n0 = ntile * 64, pn = n0 >> 8, rr = n0 & 255;
            src = (rr < 128 ? C.inp<28>() : C.inp<29>()) + ((size_t)(l * NE + e) * D + kt * 64) * FF + pn * 128 + (rr & 127); sp = FF; ksc = C.inp<26>() + l * D + kt * 64;
            continue; }
        else if ((r -= I_W1) < I_W2) {
            const int e = r >> 9, kt = (r >> 4) & 31, ntile = r & 15;
            continue; }
        else if ((r -= I_W2) < I_IN) {
            const int kt = r / 80, ntile = r % 80, n0 = ntile * 64;
            int sc0; if (n0 < 1792) { sc0 = n0; } else if (n0 == 1792) { sc0 = 1792; valid = 32; } else if (n0 < 2048) { sc0 = 0; valid = 0; } else { sc0 = n0 - 224; }
            mul = (n0 >= 768 && n0 < 1024) ? 0.125f : 1.f;
            src = C.inp<2>() + ((size_t)l * D + kt * 64) * IN_W + sc0; sp = IN_W; ksc = C.inp<1>() + l * D + kt * 64; dst = C.W<bf16>(WS_WIN) + (size_t)n0 * D + kt * 64; dp = D;
            if (n0 >= 2048) { f8 = true; mul = SW8 * 1.4426950408889634f; dst8 = C.W<unsigned char>(WS_WIN8) + (size_t)(n0 - 2048) * D + kt * 64; } }
        else if ((r -= I_IN) < I_UP) {
            const int kt = r >> 4, ntile = r & 15, k0 = kt * 64;
            src = ((k0 < 256) ? C.inp<22>() + ((size_t)l * 256 + k0) * D : (k0 < 768) ? C.inp<23>() + ((size_t)l * 512 + (k0 - 256)) * D : C.inp<24>() + ((size_t)l * 256 + (k0 - 768)) * D) + ntile * 64;
            sp = D; dst = C.W<bf16>(WS_WUP) + (size_t)ntile * 64 * D + k0; dp = D; }
        else if ((r -= I_UP) < I_MIX) { const int kt = r >> 4, ntile = r & 15;
            src = C.inp<25>() + ((size_t)l * D + kt * 64) * D + ntile * 64; sp = D; dst = C.W<bf16>(WS_WMIX) + (size_t)ntile * 64 * D + kt * 64; dp = D; }
        else if ((r -= I_MIX) < I_GLU) { const int kt = r >> 2, ntile = r & 3;
            src = C.inp<11>() + ((size_t)l * 256 + kt * 64) * 256 + ntile * 64; sp = 256; dst = C.W<bf16>(WS_WGLU) + (size_t)ntile * 64 * 256 + kt * 64; dp = 256; }
        else { r -= I_GLU;
            const int dir = r >> 4, gate = (r >> 3) & 1, nb = r & 7;
            src = (gate ? C.inp<16>() : C.inp<14>()) + ((size_t)((l * 2 + dir) * 8 + nb)) * 4096; sp = 64; dst = C.W<bf16>(WS_LRUW) + (size_t)((dir * 2 + gate) * 8 + nb) * 4096; dp = 64; }
        cvt_tile(f8, src, sp, ksc, mul, valid, f8 ? (GAS void*)dst8 : (GAS void*)dst, dp, scr, lane);
    }
    if (big) return;
    { const GAS float* plam = C.inp<18>(); for (int i = C.bid * 512 + C.tid; i < 1024; i += C.G * 512) C.W<float>(WS_LRUC8)[i] = 8.f * 1.4426950408889634f * log1pf(expf(-plam[l * 1024 + i])); }
    const GAS float* fng = C.inp<26>(); const GAS float* wrt = C.inp<27>();
    for (int i = C.bid * 512 + C.tid; i < NE * D; i += C.G * 512) { const int e = i >> 10, k = i & 1023;
        const float w = fng[l * D + k] * wrt[((size_t)l * D + k) * NE + e]; const unsigned hi = f2bf(w); const float lo = w - bf2f(hi);
        C.W<bf16>(WS_WRT)[i] = (bf16)hi; C.W<bf16>(WS_WRT)[NE * D + i] = (bf16)f2bf(lo); }
}

__device__ __forceinline__ void s5_tables(const Ctx& C, int l, int g) {
    LAS f32x2* AP = (LAS f32x2*)(C.lds);
    LAS f32x2* BB = (LAS f32x2*)(C.lds + 33792);
    LAS f32x2* CC = (LAS f32x2*)(C.lds + 50176);
    const int tid = C.tid, dp = tid & 127, dir = dp >> 6, p = dp & 63, grp = tid >> 7; const size_t pi = ((size_t)(l * 2 + dir) * 16 + g) * 64 + p;
    const GAS float* plr = C.inp<3>(); const GAS float* pli = C.inp<4>(); const GAS float* pdt = C.inp<5>();
    const float lr = fminf(plr[pi], -1e-4f), li = pli[pi], dt = expf(pdt[(l * 2 + dir) * 16 + g]);
    for (int e = grp; e <= 32; e += 4) { const float mg = __expf((float)e * lr * dt); float sn, cs; __sincosf((float)e * li * dt, &sn, &cs); AP[(dir * 33 + e) * 64 + p] = (f32x2){mg * cs, mg * sn}; }
    { const float mg = __expf(lr * dt); float sn, cs; __sincosf(li * dt, &sn, &cs); const float are = mg * cs, aim = mg * sn, den = lr * lr + li * li;
      const float kre = ((are - 1.f) * lr + aim * li) / den, kim = (aim * lr - (are - 1.f) * li) / den;
      const GAS float* pbre = C.inp<6>(); const GAS float* pbim = C.inp<7>(); const GAS float* pcre = C.inp<8>(); const GAS float* pcim = C.inp<9>();
#pragma unroll
      for (int hh = 0; hh < 4; ++hh) { const int h = grp * 4 + hh; const float bre = pbre[pi * 16 + h], bim = pbim[pi * 16 + h]; BB[(dir * 64 + p) * 16 + h] = (f32x2){kre * bre - kim * bim, kre * bim + kim * bre};
          const size_t ci = (((size_t)(l * 2 + dir) * 16 + g) * 16 + h) * 64 + p; CC[(dir * 16 + h) * 64 + p] = (f32x2){pcre[ci], pcim[ci]}; } }
    __syncthreads();
}
__device__ __forceinline__ void p0_s5_kt(const Ctx& C, int l) {
    GAS float* ktg = C.W<float>(WS_PROBS);
    for (int item = C.bid; item < 256; item += C.G) {
        const int g = item >> 4, part = item & 15;
        __syncthreads(); s5_tables(C, l, g);
        const LAS f32x2* AP = (const LAS f32x2*)(C.lds); const LAS f32x2* BB = (const LAS f32x2*)(C.lds + 33792); const LAS f32x2* CC = (const LAS f32x2*)(C.lds + 50176);
#pragma unroll
        for (int q = 0; q < 2; ++q) { const int en = part * 1024 + q * 512 + C.tid, dir = en >> 13, lag = (en >> 8) & 31, h = (en >> 4) & 15, h2 = en & 15; float s = 0.f;
#pragma unroll 8
            for (int p = 0; p < 64; ++p) { const f32x2 c = CC[(dir * 16 + h) * 64 + p], a = AP[(dir * 33 + lag) * 64 + p], b = BB[(dir * 64 + p) * 16 + h2];
                const float cre = c.x * a.x - c.y * a.y, cim = c.x * a.y + c.y * a.x; s += cre * b.x - cim * b.y; }
            ktg[(size_t)g * 16384 + en] = s; }
    }
    __syncthreads();
}
template <int WHICH>
__device__ __forceinline__ void p1_s5_assemble(const Ctx& C, int l, int bid0, int nblk) {
    const GAS float* ktg = C.W<float>(WS_PROBS); const GAS float* s5d = C.inp<10>();
    for (int item = C.bid - bid0; item < 256; item += nblk) {
        const int g = item >> 4, part = item & 15, tid = C.tid;
        __syncthreads();
        f32x4 ktr[8];
#pragma unroll
        for (int q = 0; q < 8; ++q) ktr[q] = *(const GAS f32x4*)(ktg + (size_t)g * 16384 + (size_t)(tid + 512 * q) * 4);
        const float sdv = s5d[l * 256 + g * 16 + (tid & 15)];
        s5_tables(C, l, g);
        const LAS f32x2* AP = (const LAS f32x2*)(C.lds); const LAS f32x2* BB = (const LAS f32x2*)(C.lds + 33792); const LAS f32x2* CC = (const LAS f32x2*)(C.lds + 50176);
        LAS float* KT = (LAS float*)(C.lds + 66560);
        LAS float* SD = (LAS float*)(C.lds + 132096);
#pragma unroll
        for (int q = 0; q < 8; ++q) *(LAS f32x4*)(KT + (tid + 512 * q) * 4) = ktr[q];
        if (tid < 16) SD[tid] = sdv;
        __syncthreads();
        GAS bf16* bt2 = C.W<bf16>(WS_S5BT2) + (size_t)g * 512 * UXP;
        if constexpr ((WHICH & 2) != 0)
        for (int ch = tid; ch < 32 * 96; ch += 512) {
            const int row = part * 32 + ch / 96, cc = (ch % 96) * 8, t = row >> 4, h = row & 15; float vv[8];
            if (cc < 512) { const int s = cc >> 4, h0 = cc & 15;
#pragma unroll
                for (int j = 0; j < 8; ++j) { const int h2 = h0 + j; float x;
                    if (t > s) x = KT[((0 * 32 + (t - s)) * 16 + h) * 16 + h2]; else if (t < s) x = KT[((1 * 32 + (s - t)) * 16 + h) * 16 + h2];
                    else x = KT[(0 * 16 + h) * 16 + h2] + KT[((32) * 16 + h) * 16 + h2] + (h == h2 ? SD[h] : 0.f);
                    vv[j] = x; } }
            else { const int sc = cc - 512, dir = sc >> 7, p0 = (sc & 127) >> 1; const int e = dir ? (32 - t) : (t + 1);
#pragma unroll
                for (int j = 0; j < 4; ++j) { const f32x2 c = CC[(dir * 16 + h) * 64 + p0 + j], a = AP[(dir * 33 + e) * 64 + p0 + j];
                    vv[2 * j] = c.x * a.x - c.y * a.y; vv[2 * j + 1] = -(c.x * a.y + c.y * a.x); } }
            *(GAS u32x4*)(bt2 + (size_t)row * UXP + cc) = pack8(vv);
        }
        GAS bf16* mn = C.W<bf16>(WS_S5MIN) + (size_t)g * 256 * 512;
        if constexpr ((WHICH & 1) != 0)
        for (int ch = tid; ch < 16 * 64; ch += 512) {
            const int row = part * 16 + (ch >> 6), cc = (ch & 63) * 8, dir = row >> 7, p = (row & 127) >> 1, ri = row & 1, s = cc >> 4, h0 = cc & 15, e = dir ? s : (31 - s);
            const f32x2 a = AP[(dir * 33 + e) * 64 + p]; float vv[8];
#pragma unroll
            for (int j = 0; j < 8; ++j) { const f32x2 b = BB[(dir * 64 + p) * 16 + h0 + j]; vv[j] = ri ? (a.x * b.y + a.y * b.x) : (a.x * b.x - a.y * b.y); }
            *(GAS u32x4*)(mn + (size_t)row * 512 + cc) = pack8(vv);
        }
    }
    __syncthreads();
}

__device__ __forceinline__ void p0_x_to_hb(const Ctx& C) {
    const int gw = C.bid * 8 + C.wave, NGW = C.G * 8; const GAS float* xin = C.inp<0>();
    for (int t0 = gw; t0 < T; t0 += 2 * NGW) {
        f32x4 v[2][4]; bool ok[2];
#pragma unroll
        for (int q = 0; q < 2; ++q) { const int t = t0 + q * NGW; ok[q] = t < T; const GAS f32x4* xr = (const GAS f32x4*)(xin + (size_t)(ok[q] ? t : 0) * D) + C.lane * 2;
            v[q][0] = xr[0]; v[q][1] = xr[1]; v[q][2] = xr[128]; v[q][3] = xr[129]; }
#pragma unroll
        for (int q = 0; q < 2; ++q) if (ok[q]) { const int t = t0 + q * NGW; GAS bf16* o = C.W<bf16>(WS_HB) + (size_t)t * D + C.lane * 8; float ss = 0.f; float rr[2][8];
#pragma unroll
            for (int j = 0; j < 2; ++j) { const f32x4 a = v[q][2 * j], b = v[q][2 * j + 1]; float vv[8] = {a.x, a.y, a.z, a.w, b.x, b.y, b.z, b.w}; const u32x4 w = pack8(vv); unpack8(w, rr[j]);
#pragma unroll
                for (int i = 0; i < 8; ++i) ss += rr[j][i] * rr[j][i];
                *(GAS u32x4*)(o + j * 512) = w; }
#pragma unroll
            for (int off = 1; off < 64; off <<= 1) ss += shxf_(ss, off, C.lane);
            const float sa = __builtin_amdgcn_rsqf(ss * (1.f / D) + EPS) * SA8;
#pragma unroll
            for (int j = 0; j < 2; ++j) { u32x2 o8; o8.x = pack4_fp8(rr[j][0] * sa, rr[j][1] * sa, rr[j][2] * sa, rr[j][3] * sa); o8.y = pack4_fp8(rr[j][4] * sa, rr[j][5] * sa, rr[j][6] * sa, rr[j][7] * sa);
                *(GAS u32x2*)(C.W<unsigned char>(WS_HB8) + (size_t)t * D + C.lane * 8 + j * 512) = o8; }
            if (C.lane == 0) C.W<float>(WS_SS1)[t] = ss; }
    }
}

constexpr int LRU_CH = 128, LRU_NCH = SEQ / LRU_CH;
struct LruK { float ba[2][4], bx[2][4], c8[2][4]; float w0, w1, w2, w3, cb; };
__device__ __forceinline__ void lru_setup(const Ctx& C, int l, int nb, LruK& K) {
    const int lane = C.lane, fr = lane & 15, ch0 = nb * 64, tid = C.tid;
    const GAS float* pba = C.inp<15>(); const GAS float* pbx = C.inp<17>(); const GAS float* lc8 = C.W<float>(WS_LRUC8);
#pragma unroll
    for (int dir = 0; dir < 2; ++dir)
#pragma unroll
        for (int cb4 = 0; cb4 < 4; ++cb4) { const int chn = ch0 + cb4 * 16 + fr; K.ba[dir][cb4] = pba[(l * 2 + dir) * 512 + chn]; K.bx[dir][cb4] = pbx[(l * 2 + dir) * 512 + chn];
            K.c8[dir][cb4] = lc8[dir * 512 + chn]; }
    const GAS float* cw = C.inp<12>(); const int ch = ch0 + lane;
    K.w0 = cw[(l * 4 + 0) * 512 + ch]; K.w1 = cw[(l * 4 + 1) * 512 + ch]; K.w2 = cw[(l * 4 + 2) * 512 + ch]; K.w3 = cw[(l * 4 + 3) * 512 + ch]; K.cb = C.inp<13>()[l * 512 + ch];
    const GAS bf16* wt = C.W<bf16>(WS_LRUW);
    u32x4 wreg[4];
#pragma unroll
    for (int i = 0; i < 4; ++i) { const int e = (i * 512 + tid) * 8, mtx = e >> 12, d = (e >> 6) & 63, c = e & 63;
        wreg[i] = *(const GAS u32x4*)(wt + ((size_t)(mtx * 8 + nb) * 64 + d) * 64 + c); }
    __syncthreads();
#pragma unroll
    for (int i = 0; i < 4; ++i) { const int e = (i * 512 + tid) * 8, mtx = e >> 12, d = (e >> 6) & 63, c = e & 63;
        *(LAS u32x4*)(C.lds + (mtx * 64 + d) * 144 + c * 2) = wreg[i]; }
    __syncthreads();
}
__device__ __forceinline__ void lru_load_x(const Ctx& C, int unit, u32x4 (&xr)[3]) {
    const int bc = unit >> 3, nb = unit & 7, b = bc / LRU_NCH, s0 = (bc % LRU_NCH) * LRU_CH, r8 = C.lane >> 3, ck = (C.lane & 7) * 8; const GAS bf16* xb = C.W<bf16>(WS_XB);
#pragma unroll
    for (int i = 0; i < 3; ++i) { const int s = s0 + C.wave * 16 + i * 8 + r8 - 2; xr[i] = (s >= 0 && s < SEQ && i * 8 + r8 < 19) ? *(const GAS u32x4*)(xb + ((size_t)b * SEQ + s) * 512 + nb * 64 + ck) : (u32x4){0u, 0u, 0u, 0u}; }
}
__device__ __forceinline__ void lru_pass1_unit(const Ctx& C, int unit, int par, const LruK& K, const u32x4 (&xr)[3]) {
    const int lane = C.lane, w = C.wave, fr = lane & 15, fq = lane >> 4;
    const int bc = unit >> 3, nb = unit & 7, t0 = bc * LRU_CH + w * 16, ch0 = nb * 64;
    LAS unsigned char* WT = C.lds; LAS unsigned char* WV = C.lds + 36864 + w * 11008;
    LAS bf16* XCb = (LAS bf16*)WV; LAS float* LA = (LAS float*)(WV + 2304); LAS float* LB = (LAS float*)(WV + 2304 + 4352);
    LAS float* SEG = (LAS float*)(C.lds + 124928) + par * 2048;
    {
        LAS bf16* XS = (LAS bf16*)(WV + 2304);
#pragma unroll
        for (int i = 0; i < 3; ++i) *(LAS u32x4*)(XS + (i * 8 + (lane >> 3)) * 64 + (lane & 7) * 8) = xr[i];
        float xv[19];
#pragma unroll
        for (int i = 0; i < 19; ++i) xv[i] = bf2f(XS[i * 64 + lane]);
#pragma unroll
        for (int j = 0; j < 16; ++j) { const float xc = K.cb + K.w0 * xv[j] + K.w1 * xv[j + 1] + K.w2 * xv[j + 2] + K.w3 * xv[j + 3]; XCb[j * 72 + lane] = (bf16)f2bf(xc); }
    }
    bf16x8 af[2];
#pragma unroll
    for (int kk = 0; kk < 2; ++kk) af[kk] = *(const LAS bf16x8*)((LAS unsigned char*)XCb + fr * 144 + (kk * 32 + fq * 8) * 2);
    float hs[2][16], ps[2][16];
    float xcv[4][4];
#pragma unroll
    for (int cb4 = 0; cb4 < 4; ++cb4)
#pragma unroll
        for (int r = 0; r < 4; ++r) xcv[cb4][r] = bf2f(XCb[(4 * fq + r) * 72 + cb4 * 16 + fr]);
#pragma unroll
    for (int dir = 0; dir < 2; ++dir) {
        bf16x8 bR[4][2], bI[4][2];
#pragma unroll
        for (int cb4 = 0; cb4 < 4; ++cb4)
#pragma unroll
            for (int kk = 0; kk < 2; ++kk) { bR[cb4][kk] = *(const LAS bf16x8*)(WT + ((dir * 2 + 0) * 64 + cb4 * 16 + fr) * 144 + (kk * 32 + fq * 8) * 2); bI[cb4][kk] = *(const LAS bf16x8*)(WT + ((dir * 2 + 1) * 64 + cb4 * 16 + fr) * 144 + (kk * 32 + fq * 8) * 2); }
        f32x4 aR[4], aI[4];
#pragma unroll
        for (int cb4 = 0; cb4 < 4; ++cb4) { aR[cb4] = (f32x4){0.f, 0.f, 0.f, 0.f}; aI[cb4] = (f32x4){0.f, 0.f, 0.f, 0.f};
#pragma unroll
            for (int kk = 0; kk < 2; ++kk) { aR[cb4] = MFMA16(af[kk], bR[cb4][kk], aR[cb4]); aI[cb4] = MFMA16(af[kk], bI[cb4][kk], aI[cb4]); } }
        float va[4][4], vb[4][4];
#pragma unroll
        for (int cb4 = 0; cb4 < 4; ++cb4) { const float ba = K.ba[dir][cb4], bx = K.bx[dir][cb4], c8 = K.c8[dir][cb4];
#pragma unroll
            for (int r = 0; r < 4; ++r) { const float rg = sigmoid_(aR[cb4][r] + ba), ig = sigmoid_(aI[cb4][r] + bx), a = __builtin_amdgcn_exp2f(-c8 * rg), mlt = __builtin_amdgcn_sqrtf(fmaxf(1.f - a * a, 0.f));
                va[cb4][r] = a; vb[cb4][r] = mlt * ig * xcv[cb4][r]; } }
#pragma unroll
        for (int cb4 = 0; cb4 < 4; ++cb4)
#pragma unroll
            for (int r = 0; r < 4; ++r) { const int tok = 4 * fq + r, d = cb4 * 16 + fr; LA[tok * 68 + d] = va[cb4][r]; LB[tok * 68 + d] = vb[cb4][r]; }
        float h = 0.f, P = 1.f;
#pragma unroll
        for (int i = 0; i < 16; ++i) { const int tok = dir ? 15 - i : i; const float a = LA[tok * 68 + lane], bb = LB[tok * 68 + lane]; h = a * h + bb; P *= a; hs[dir][tok] = h; ps[dir][tok] = P; }
        SEG[((dir * 2 + 0) * 8 + w) * 64 + lane] = P; SEG[((dir * 2 + 1) * 8 + w) * 64 + lane] = h;
    }
    __syncthreads();
    float cin = 0.f, Pin = 1.f, cib = 0.f, Pib = 1.f;
    for (int s = 0; s < w; ++s) { const float A = SEG[(0 * 8 + s) * 64 + lane], H = SEG[(8 + s) * 64 + lane]; cin = A * cin + H; Pin *= A; }
    for (int s = 7; s > w; --s) { const float A = SEG[(16 + s) * 64 + lane], H = SEG[(24 + s) * 64 + lane]; cib = A * cib + H; Pib *= A; }
    GAS bf16* yl = C.W<bf16>(WS_YLOC); GAS bf16* gpf = C.W<bf16>(WS_PF); GAS bf16* gpb = C.W<bf16>(WS_PB);
    float yfl = 0.f, pfl = 0.f, ybf = 0.f, pbf = 0.f;
    LAS bf16* ST = (LAS bf16*)(WV + 2304);
#pragma unroll
    for (int j = 0; j < 16; ++j) {
        const float yf = hs[0][j] + ps[0][j] * cin, pcf = ps[0][j] * Pin, yb = hs[1][j] + ps[1][j] * cib, pcb = ps[1][j] * Pib;
        const unsigned p0 = cvt_pk_bf16(yf + yb, pcf), p1 = cvt_pk_bf16(pcb, 0.f);
        ST[(0 * 16 + j) * 64 + lane] = (bf16)(p0 & 0xffffu); ST[(1 * 16 + j) * 64 + lane] = (bf16)(p0 >> 16); ST[(2 * 16 + j) * 64 + lane] = (bf16)(p1 & 0xffffu);
        if (j == 15) { yfl = yf; pfl = pcf; } if (j == 0) { ybf = yb; pbf = pcb; } }
    { const int tok = lane >> 2, ck = (lane & 3) * 16; const size_t o = (size_t)(t0 + tok) * 512 + ch0 + ck;
#pragma unroll
      for (int arr = 0; arr < 3; ++arr) { GAS bf16* gp = arr == 0 ? yl : (arr == 1 ? gpf : gpb);
          const u32x4 v0 = *(const LAS u32x4*)(ST + (arr * 16 + tok) * 64 + ck), v1 = *(const LAS u32x4*)(ST + (arr * 16 + tok) * 64 + ck + 8);
          *(GAS u32x4*)(gp + o) = v0; *(GAS u32x4*)(gp + o + 8) = v1; } }
    GAS float* sm = C.W<float>(WS_LSUM) + ((size_t)bc * 512 + ch0 + lane) * 4;
    if (w == 7) { sm[0] = pfl; sm[1] = yfl; }
    if (w == 0) { sm[2] = pbf; sm[3] = ybf; }
}
__device__ __forceinline__ void lru_pass1_all(const Ctx& C, int l) {
    constexpr int NU = (T / LRU_CH) * 8;
    LruK K; int cur_nb = -1, par = 0; u32x4 xr[3], xn[3];
    int u = C.bid; if (u >= NU) return;
    lru_load_x(C, u, xr);
    for (; u < NU; u += C.G) {
        const int nb = u & 7; if (nb != cur_nb) { lru_setup(C, l, nb, K); cur_nb = nb; }
        const int un = u + C.G; if (un < NU) lru_load_x(C, un, xn);
        lru_pass1_unit(C, u, par, K, xr); par ^= 1;
#pragma unroll
        for (int i = 0; i < 3; ++i) xr[i] = xn[i];
    }
    __syncthreads();
}
__device__ __forceinline__ void lru_carry(const Ctx& C) {
    const int gid = C.bid * 512 + C.tid; if (gid >= 8192) return;
    const int dir = gid >> 12, b = (gid >> 9) & 7, ch = gid & 511; const GAS float* sm = C.W<float>(WS_LSUM); GAS float* car = C.W<float>(WS_LCAR); float c = 0.f;
    for (int i0 = 0; i0 < LRU_NCH; i0 += 8) {
        f32x2 ah[8];
#pragma unroll
        for (int j = 0; j < 8; ++j) { const int cc = dir ? LRU_NCH - 1 - (i0 + j) : (i0 + j); ah[j] = *(const GAS f32x2*)(sm + ((size_t)(b * LRU_NCH + cc) * 512 + ch) * 4 + dir * 2); }
#pragma unroll
        for (int j = 0; j < 8; ++j) { const int cc = dir ? LRU_NCH - 1 - (i0 + j) : (i0 + j); car[((size_t)(b * LRU_NCH + cc) * 512 + ch) * 2 + dir] = c; c = ah[j].x * c + ah[j].y; }
    }
}
__device__ __forceinline__ void lru_pass2(const Ctx& C) {
    const GAS bf16* yl = C.W<bf16>(WS_YLOC); const GAS bf16* gpf = C.W<bf16>(WS_PF); const GAS bf16* gpb = C.W<bf16>(WS_PB); const GAS float* car = C.W<float>(WS_LCAR); GAS bf16* ycat = C.W<bf16>(WS_YCAT);
    int start, cnt;
    if (C.G == 256) { if (C.bid < 128) { start = C.bid * 4608; cnt = 9; } else { start = 128 * 4608 + (C.bid - 128) * 11776; cnt = 23; } }
    else { const int per = (T * 64 / 512 + C.G - 1) / C.G; start = C.bid * per * 512; cnt = per; }
    for (int j = 0; j < cnt; j += 4) {
        u32x4 ly[4], lf[4], lb[4]; f32x4 cv[4][4]; int tt[4], cc[4]; bool ok[4];
#pragma unroll
        for (int q = 0; q < 4; ++q) { const int i = start + (j + q) * 512 + C.tid; ok[q] = (j + q < cnt) && i < T * 64; const int ii = ok[q] ? i : 0; tt[q] = ii >> 6; cc[q] = (ii & 63) * 8;
            ly[q] = *(const GAS u32x4*)(yl + (size_t)tt[q] * 512 + cc[q]); lf[q] = *(const GAS u32x4*)(gpf + (size_t)tt[q] * 512 + cc[q]); lb[q] = *(const GAS u32x4*)(gpb + (size_t)tt[q] * 512 + cc[q]);
            const GAS f32x4* cp = (const GAS f32x4*)(car + ((size_t)(tt[q] / LRU_CH) * 512 + cc[q]) * 2);
#pragma unroll
            for (int k = 0; k < 4; ++k) cv[q][k] = cp[k]; }
#pragma unroll
        for (int q = 0; q < 4; ++q) { float y[8], pf[8], pb[8], o[8]; unpack8(ly[q], y); unpack8(lf[q], pf); unpack8(lb[q], pb);
#pragma unroll
            for (int k = 0; k < 4; ++k) { o[2 * k] = y[2 * k] + pf[2 * k] * cv[q][k].x + pb[2 * k] * cv[q][k].y; o[2 * k + 1] = y[2 * k + 1] + pf[2 * k + 1] * cv[q][k].z + pb[2 * k + 1] * cv[q][k].w; }
            if (ok[q]) *(GAS u32x4*)(ycat + (size_t)tt[q] * 1024 + 256 + cc[q]) = pack8(o); }
    }
}

struct GlaConsts { bf16x8 bh[4], bl[4]; float baf, bab; };
__device__ __forceinline__ void gla_load_consts(const Ctx& C, int l, int h, GlaConsts& K) {
    const int d = C.lane, col0 = h * 64, dir = C.wave >> 2, n = C.lane & 15, kq = C.lane >> 4; const GAS float* pwa = C.inp<19>(); const GAS float* pbal = C.inp<20>();
#pragma unroll
    for (int dt = 0; dt < 4; ++dt) { float hv[8], lv[8];
#pragma unroll
        for (int i = 0; i < 8; ++i) { const float wv = pwa[((size_t)(l * 2 + dir) * 16 + (kq & 1) * 8 + i) * 256 + col0 + dt * 16 + n]; hv[i] = bf2f(f2bf(wv)); lv[i] = wv - hv[i]; }
        K.bh[dt] = __builtin_bit_cast(bf16x8, pack8(hv)); K.bl[dt] = __builtin_bit_cast(bf16x8, pack8(lv)); }
    K.baf = pbal[(l * 2 + 0) * 256 + col0 + d]; K.bab = pbal[(l * 2 + 1) * 256 + col0 + d];
}
struct GlaIn { u32x4 q, k, v; f32x4 alr; };
__device__ __forceinline__ void gla_load_in(const Ctx& C, int u, GlaIn& I) {
    const int b = u >> 8, h = (u >> 6) & 3, n = u & 63, t0 = b * SEQ + n * 64, col0 = h * 64, w = C.wave, tid = C.tid, lane = C.lane;
    const size_t o = (size_t)(t0 + w * 8 + (lane >> 3)) * 256 + col0 + (lane & 7) * 8;
    I.q = *(const GAS u32x4*)(C.W<bf16>(WS_Q) + o); I.k = *(const GAS u32x4*)(C.W<bf16>(WS_K) + o); I.v = *(const GAS u32x4*)(C.W<bf16>(WS_V) + o);
    I.alr = *(const GAS f32x4*)(C.W<float>(WS_ALR) + (size_t)(t0 + (tid >> 3)) * 32 + (tid & 7) * 4);
}
__device__ __forceinline__ void gla_pass1_unit(const Ctx& C, int u, const GlaConsts& K, const GlaIn& I) {
    const int lane = C.lane, w = C.wave, tid = C.tid, fr = lane & 15, fq = lane >> 4;
    const int b = u >> 8, h = (u >> 6) & 3, n = u & 63, t0 = b * SEQ + n * 64, col0 = h * 64;
    LAS unsigned char* L = C.lds;
    LAS float* ALR = (LAS float*)L;
    LAS float* SEGF = (LAS float*)(L + 8192);
    LAS float* SEGB = (LAS float*)(L + 10240);
    LAS unsigned char* QDF = L + 12288, *KDF = L + 21504, *QDB = L + 30720, *KDB = L + 39936, *KRFT = L + 49152, *KRBT = L + 58368, *VT = L + 67584, *SS = L + 76800;
    *(LAS f32x4*)(ALR + (tid >> 3) * 32 + (tid & 7) * 4) = I.alr;
    LAS bf16* QKV = (LAS bf16*)(L + 86016);
    { const int row = w * 8 + (lane >> 3), ck = (lane & 7) * 8; *(LAS u32x4*)(QKV + (0 * 64 + row) * 64 + ck) = I.q; *(LAS u32x4*)(QKV + (1 * 64 + row) * 64 + ck) = I.k; *(LAS u32x4*)(QKV + (2 * 64 + row) * 64 + ck) = I.v; }
    __syncthreads();
    LAS float* XT = (LAS float*)(L + 110592);
    {
        const int dir = w >> 2, tt = w & 3; const LAS float* ap = ALR + (tt * 16 + fr) * 32 + dir * 16 + (fq & 1) * 8;
        const f32x4 x0 = *(const LAS f32x4*)ap, x1 = *(const LAS f32x4*)(ap + 4); float xs[8] = {x0.x, x0.y, x0.z, x0.w, x1.x, x1.y, x1.z, x1.w};
#pragma unroll
        for (int i = 0; i < 8; ++i) { const float hi = bf2f(f2bf(xs[i])); xs[i] = (fq >= 2) ? xs[i] - hi : hi; }
        const bf16x8 af = __builtin_bit_cast(bf16x8, pack8(xs));
#pragma unroll
        for (int dt = 0; dt < 4; ++dt) { f32x4 c = {0.f, 0.f, 0.f, 0.f}; c = MFMA16(af, K.bh[dt], c); c = MFMA16(af, K.bl[dt], c);
            *(LAS f32x4*)(XT + (dir * 64 + dt * 16 + fr) * 68 + tt * 16 + 4 * fq) = c; }
    }
    __syncthreads();
    float bfw[8], bbw[8], allF, allB;
    {
        const int d = lane;
        float gf[8], gb[8];
        { const f32x4 f0 = *(const LAS f32x4*)(XT + d * 68 + 8 * w), f1 = *(const LAS f32x4*)(XT + d * 68 + 8 * w + 4), b0 = *(const LAS f32x4*)(XT + (64 + d) * 68 + 8 * w), b1 = *(const LAS f32x4*)(XT + (64 + d) * 68 + 8 * w + 4);
          const float xfv[8] = {f0.x, f0.y, f0.z, f0.w, f1.x, f1.y, f1.z, f1.w}, xbv[8] = {b0.x, b0.y, b0.z, b0.w, b1.x, b1.y, b1.z, b1.w};
#pragma unroll
          for (int j = 0; j < 8; ++j) { gf[j] = logsig_(xfv[j] + K.baf) * (1.f / 16.f); gb[j] = logsig_(xbv[j] + K.bab) * (1.f / 16.f); } }
        float s = 0.f;
#pragma unroll
        for (int j = 0; j < 8; ++j) { s += gf[j]; bfw[j] = s; }
        SEGF[w * 64 + d] = s; s = 0.f;
#pragma unroll
        for (int j = 7; j >= 0; --j) { s += gb[j]; bbw[j] = s; }
        SEGB[w * 64 + d] = s;
    }
    __syncthreads();
    {
        const int d = lane; float offF = 0.f, offB = 0.f; allF = 0.f; allB = 0.f;
#pragma unroll
        for (int s = 0; s < 8; ++s) { const float a = SEGF[s * 64 + d], c = SEGB[s * 64 + d]; allF += a; allB += c; if (s < w) offF += a; if (s > w) offB += c; }
        GAS bf16* gqdf = C.W<bf16>(WS_QDF); GAS bf16* gqdb = C.W<bf16>(WS_QDB);
        float krf[8], krb[8], vt[8];
#pragma unroll
        for (int j = 0; j < 8; ++j) { const int tok = w * 8 + j; const size_t o = (size_t)(t0 + tok) * 256 + col0 + d;
            const float qv = bf2f(QKV[(0 * 64 + tok) * 64 + d]), kv = bf2f(QKV[(1 * 64 + tok) * 64 + d]), vv = bf2f(QKV[(2 * 64 + tok) * 64 + d]); const float cf = offF + bfw[j], cb = offB + bbw[j];
            const float qdf = qv * __expf(cf), kdf = kv * __expf(-cf), qdb = qv * __expf(cb), kdb = kv * __expf(-cb);
            krf[j] = kv * __expf(allF - cf); krb[j] = kv * __expf(allB - cb); vt[j] = vv;
            const unsigned hq = f2bf(qdf), hb = f2bf(qdb);
            *(LAS bf16*)(QDF + tok * 144 + d * 2) = (bf16)hq; *(LAS bf16*)(KDF + tok * 144 + d * 2) = (bf16)f2bf(kdf); *(LAS bf16*)(QDB + tok * 144 + d * 2) = (bf16)hb; *(LAS bf16*)(KDB + tok * 144 + d * 2) = (bf16)f2bf(kdb);
            (void)o; }
        *(LAS u32x4*)(KRFT + d * 144 + w * 16) = pack8(krf); *(LAS u32x4*)(KRBT + d * 144 + w * 16) = pack8(krb); *(LAS u32x4*)(VT + d * 144 + w * 16) = pack8(vt);
        { const int row = w * 8 + (lane >> 3), ck = (lane & 7) * 8; const size_t go = (size_t)(t0 + row) * 256 + col0 + ck;
          *(GAS u32x4*)(gqdf + go) = *(const LAS u32x4*)(QDF + row * 144 + ck * 2); *(GAS u32x4*)(gqdb + go) = *(const LAS u32x4*)(QDB + row * 144 + ck * 2); }
        if (w == 0) { GAS float* gd = C.W<float>(WS_GDEC) + (size_t)u * 128; gd[d] = __expf(allF); gd[64 + d] = __expf(allB); }
    }
    __syncthreads();
    {
        const int dir = w >> 2, ib = w & 3; const LAS unsigned char* QD = dir ? QDB : QDF; const LAS unsigned char* KD = dir ? KDB : KDF;
        bf16x8 af[2];
#pragma unroll
        for (int kk = 0; kk < 2; ++kk) af[kk] = *(const LAS bf16x8*)(QD + (ib * 16 + fr) * 144 + (kk * 32 + fq * 8) * 2);
        for (int jb = 0; jb < 4; ++jb) {
            if (dir == 0 ? (jb > ib) : (jb < ib)) continue;
            f32x4 a = {0.f, 0.f, 0.f, 0.f};
#pragma unroll
            for (int kk = 0; kk < 2; ++kk) { const bf16x8 bfrag = *(const LAS bf16x8*)(KD + (jb * 16 + fr) * 144 + (kk * 32 + fq * 8) * 2); a = MFMA16(af[kk], bfrag, a); }
#pragma unroll
            for (int r = 0; r < 4; ++r) { const int i = ib * 16 + 4 * fq + r, j = jb * 16 + fr; const bool keep = dir == 0 ? (j <= i) : (j > i); if (keep) *(LAS bf16*)(SS + i * 144 + j * 2) = (bf16)f2bf(a[r]); }
        }
    }
    __syncthreads();
    {
        GAS bf16* goin = C.W<bf16>(WS_OIN);
#pragma unroll
        for (int tt = 0; tt < 2; ++tt) { const int tile = w * 2 + tt, dvb = tile >> 2, ib = tile & 3; f32x4 a = {0.f, 0.f, 0.f, 0.f};
#pragma unroll
            for (int kk = 0; kk < 2; ++kk) { const bf16x8 x = *(const LAS bf16x8*)(VT + (dvb * 16 + fr) * 144 + (kk * 32 + fq * 8) * 2), y = *(const LAS bf16x8*)(SS + (ib * 16 + fr) * 144 + (kk * 32 + fq * 8) * 2); a = MFMA16(x, y, a); }
            u32x2 o; o.x = cvt_pk_bf16(a[0], a[1]); o.y = cvt_pk_bf16(a[2], a[3]);
            *(GAS u32x2*)(goin + (size_t)(t0 + ib * 16 + fr) * 256 + col0 + dvb * 16 + 4 * fq) = o; }
        const int dir = w >> 2, dkb = w & 3; const LAS unsigned char* KR = dir ? KRBT : KRFT; GAS bf16* gkv = C.W<bf16>(WS_KV) + ((size_t)u * 2 + dir) * 4096;
        bf16x8 af[2];
#pragma unroll
        for (int kk = 0; kk < 2; ++kk) af[kk] = *(const LAS bf16x8*)(KR + (dkb * 16 + fr) * 144 + (kk * 32 + fq * 8) * 2);
#pragma unroll
        for (int dvb = 0; dvb < 4; ++dvb) { f32x4 a = {0.f, 0.f, 0.f, 0.f};
#pragma unroll
            for (int kk = 0; kk < 2; ++kk) { const bf16x8 y = *(const LAS bf16x8*)(VT + (dvb * 16 + fr) * 144 + (kk * 32 + fq * 8) * 2); a = MFMA16(af[kk], y, a); }
            u32x2 o; o.x = cvt_pk_bf16(a[0], a[1]); o.y = cvt_pk_bf16(a[2], a[3]);
            *(GAS u32x2*)(gkv + (size_t)(dvb * 16 + fr) * 64 + dkb * 16 + 4 * fq) = o; }
    }
    __syncthreads();
}
__device__ __forceinline__ void gla_pass1_all(const Ctx& C, int l) {
    GlaConsts K; int cur_h = -1; GlaIn I, In;
    int u = C.bid; if (u >= 2048) return;
    gla_load_in(C, u, I);
    for (; u < 2048; u += C.G) {
        const int h = (u >> 6) & 3; if (h != cur_h) { gla_load_consts(C, l, h, K); cur_h = h; }
        const int un = u + C.G; if (un < 2048) gla_load_in(C, un, In);
        gla_pass1_unit(C, u, K, I);
        I = In;
    }
}
__device__ __forceinline__ void gla_scan(const Ctx& C) {
    GAS bf16* kv = C.W<bf16>(WS_KV); const GAS float* gd = C.W<float>(WS_GDEC);
    const int NT = C.G * 512;
    for (int e0 = C.bid * 512 + C.tid; e0 < 64 * 4096; e0 += 2 * NT) {
        const int e1 = e0 + NT; const bool two = e1 < 64 * 4096;
        const int sq0 = e0 >> 12, el0 = e0 & 4095, dk0 = el0 & 63, dir0 = sq0 & 1, bh0 = sq0 >> 1;
        const int e1c = two ? e1 : e0; const int sq1 = e1c >> 12, el1 = e1c & 4095, dk1 = el1 & 63, dir1 = sq1 & 1, bh1 = sq1 >> 1;
        float S0 = 0.f, S1 = 0.f;
        for (int i0 = 0; i0 < 64; i0 += 8) {
            float k0[8], d0[8], k1[8], d1[8];
#pragma unroll
            for (int j = 0; j < 8; ++j) { const int n0 = dir0 ? 63 - (i0 + j) : (i0 + j), u0 = bh0 * 64 + n0, n1 = dir1 ? 63 - (i0 + j) : (i0 + j), u1 = bh1 * 64 + n1;
                k0[j] = bf2f(kv[((size_t)u0 * 2 + dir0) * 4096 + el0]); d0[j] = gd[(size_t)u0 * 128 + dir0 * 64 + dk0];
                k1[j] = bf2f(kv[((size_t)u1 * 2 + dir1) * 4096 + el1]); d1[j] = gd[(size_t)u1 * 128 + dir1 * 64 + dk1]; }
#pragma unroll
            for (int j = 0; j < 8; ++j) { const int n0 = dir0 ? 63 - (i0 + j) : (i0 + j), u0 = bh0 * 64 + n0, n1 = dir1 ? 63 - (i0 + j) : (i0 + j), u1 = bh1 * 64 + n1;
                kv[((size_t)u0 * 2 + dir0) * 4096 + el0] = (bf16)f2bf(S0); S0 = d0[j] * S0 + k0[j];
                if (two) { kv[((size_t)u1 * 2 + dir1) * 4096 + el1] = (bf16)f2bf(S1); S1 = d1[j] * S1 + k1[j]; } }
        }
    }
}
__device__ __forceinline__ void gla_pass2_unit(const Ctx& C, int l, int unit) {
    const int lane = C.lane, w = C.wave, fr = lane & 15, fq = lane >> 4; const int b = unit >> 6, n = unit & 63, t0 = b * SEQ + n * 64;
    const GAS bf16* gqdf = C.W<bf16>(WS_QDF); const GAS bf16* gqdb = C.W<bf16>(WS_QDB); const GAS bf16* kv = C.W<bf16>(WS_KV); const GAS bf16* goin = C.W<bf16>(WS_OIN); const GAS bf16* sog = C.W<bf16>(WS_SOG); GAS bf16* ycat = C.W<bf16>(WS_YCAT); const GAS float* gng = C.inp<21>();
#pragma unroll
    for (int pp = 0; pp < 2; ++pp) {
        const int p = w * 2 + pp, h = p >> 2, ib = p & 3, u = b * 256 + h * 64 + n, tok = t0 + ib * 16 + fr;
        bf16x8 qf[2], qb[2];
#pragma unroll
        for (int kk = 0; kk < 2; ++kk) { qf[kk] = *(const GAS bf16x8*)(gqdf + (size_t)tok * 256 + h * 64 + kk * 32 + fq * 8); qb[kk] = *(const GAS bf16x8*)(gqdb + (size_t)tok * 256 + h * 64 + kk * 32 + fq * 8); }
        f32x4 o[4]; float ssq = 0.f;
#pragma unroll
        for (int dvb = 0; dvb < 4; ++dvb) { f32x4 a = {0.f, 0.f, 0.f, 0.f};
#pragma unroll
            for (int kk = 0; kk < 2; ++kk) { const bf16x8 pf = *(const GAS bf16x8*)(kv + ((size_t)u * 2 + 0) * 4096 + (dvb * 16 + fr) * 64 + kk * 32 + fq * 8), pb = *(const GAS bf16x8*)(kv + ((size_t)u * 2 + 1) * 4096 + (dvb * 16 + fr) * 64 + kk * 32 + fq * 8);
                a = MFMA16(pf, qf[kk], a); a = MFMA16(pb, qb[kk], a); }
            const u32x2 oi = *(const GAS u32x2*)(goin + (size_t)tok * 256 + h * 64 + dvb * 16 + 4 * fq);
            a[0] += bflo(oi.x); a[1] += bfhi(oi.x); a[2] += bflo(oi.y); a[3] += bfhi(oi.y); o[dvb] = a; ssq += a[0] * a[0] + a[1] * a[1] + a[2] * a[2] + a[3] * a[3]; }
        ssq += __shfl_xor(ssq, 16); ssq += __shfl_xor(ssq, 32);
        const float rs = __builtin_amdgcn_rsqf(ssq * (1.f / 64.f) + EPS);
#pragma unroll
        for (int dvb = 0; dvb < 4; ++dvb) { const int dv = dvb * 16 + 4 * fq; const f32x4 g = *(const GAS f32x4*)(gng + l * 64 + dv); const u32x2 sg = *(const GAS u32x2*)(sog + (size_t)tok * 256 + h * 64 + dv);
            u32x2 r; r.x = cvt_pk_bf16(o[dvb][0] * rs * g.x * bflo(sg.x), o[dvb][1] * rs * g.y * bfhi(sg.x)); r.y = cvt_pk_bf16(o[dvb][2] * rs * g.z * bflo(sg.y), o[dvb][3] * rs * g.w * bfhi(sg.y));
            *(GAS u32x2*)(ycat + (size_t)tok * 1024 + 768 + h * 64 + dv) = r; }
    }
}

__device__ __forceinline__ void s5_scan(const Ctx& C, int l) {
    const int gid = C.bid * 512 + C.tid; if (gid >= 16384) return;
    const int p = gid & 63, dir = (gid >> 6) & 1, b = (gid >> 7) & 7, g = gid >> 10; const size_t pi = ((size_t)(l * 2 + dir) * 16 + g) * 64 + p;
    const float lr = fminf(C.inp<3>()[pi], -1e-4f), li = C.inp<4>()[pi], dt = expf(C.inp<5>()[(l * 2 + dir) * 16 + g]); const float mg = expf(32.f * lr * dt); float sn, cs; sincosf(32.f * li * dt, &sn, &cs);
    const float are = mg * cs, aim = mg * sn; const GAS float* xl = C.W<float>(WS_XLOC); GAS bf16* ux = C.W<bf16>(WS_UX); float xr = 0.f, xi = 0.f;
    for (int i0 = 0; i0 < S5NCH; i0 += 16) {
        f32x2 v[16];
#pragma unroll
        for (int j = 0; j < 16; ++j) { const int c = dir ? (S5NCH - 1 - (i0 + j)) : (i0 + j); const size_t row = (size_t)g * S5ROWS + b * S5NCH + c; v[j] = *(const GAS f32x2*)(xl + row * 256 + dir * 128 + 2 * p); }
#pragma unroll
        for (int j = 0; j < 16; ++j) { const int c = dir ? (S5NCH - 1 - (i0 + j)) : (i0 + j); const size_t row = (size_t)g * S5ROWS + b * S5NCH + c;
            *(GAS unsigned*)(ux + row * UXP + 512 + dir * 128 + 2 * p) = cvt_pk_bf16(xr, xi);
            const float nr = are * xr - aim * xi + v[j].x, ni = are * xi + aim * xr + v[j].y; xr = nr; xi = ni; }
    }
}

__device__ __forceinline__ void router_phase(const Ctx& C) {
    const int lane = C.lane, fr = lane & 15, fq = lane >> 4; const int gw = C.bid * 8 + C.wave, NGW = C.G * 8;
    const GAS bf16* hb2 = C.W<bf16>(WS_HB2); const GAS bf16* wr = C.W<bf16>(WS_WRT); GAS float* probs = C.W<float>(WS_PROBS); GAS float* ss2 = C.W<float>(WS_SS2);
    for (int tg = gw; tg < T / 16; tg += NGW) {
        const int tok0 = tg * 16; f32x4 acc = {0.f, 0.f, 0.f, 0.f}; float ss = 0.f;
        u32x4 aw[32];
#pragma unroll
        for (int kk = 0; kk < 32; ++kk) aw[kk] = *(const GAS u32x4*)(hb2 + (size_t)(tok0 + fr) * D + kk * 32 + fq * 8);
#pragma unroll
        for (int kk = 0; kk < 32; ++kk) { float av[8]; unpack8(aw[kk], av);
#pragma unroll
            for (int i = 0; i < 8; ++i) ss += av[i] * av[i];
            const bf16x8 a = __builtin_bit_cast(bf16x8, aw[kk]);
            const bf16x8 bh = *(const GAS bf16x8*)(wr + (size_t)fr * D + kk * 32 + fq * 8), bl = *(const GAS bf16x8*)(wr + (size_t)(NE + fr) * D + kk * 32 + fq * 8);
            acc = MFMA16(a, bh, acc); acc = MFMA16(a, bl, acc); }
        ss += __shfl_xor(ss, 16); ss += __shfl_xor(ss, 32);
        if (fq == 0) ss2[tok0 + fr] = ss;
        float pr[4];
#pragma unroll
        for (int r = 0; r < 4; ++r) { const float rs = __builtin_amdgcn_rsqf(__shfl(ss, 4 * fq + r) * (1.f / D) + EPS); const float lg = acc[r] * rs; float mx = lg;
#pragma unroll
            for (int off = 1; off < 16; off <<= 1) mx = fmaxf(mx, __shfl_xor(mx, off));
            const float e = __expf(lg - mx); float sm = e;
#pragma unroll
            for (int off = 1; off < 16; off <<= 1) sm += __shfl_xor(sm, off);
            pr[r] = e / sm; }
        const int b = tok0 >> 12, s = (tok0 & 4095) + 4 * fq;
        *(GAS f32x4*)(probs + ((size_t)(b * NE + fr)) * SEQ + s) = (f32x4){pr[0], pr[1], pr[2], pr[3]};
    }
}
__device__ __forceinline__ void xn8_rows(const Ctx& C, int b0, int nb) {
    const int lane = C.lane; const GAS bf16* hb2 = C.W<bf16>(WS_HB2); const GAS float* ss2 = C.W<float>(WS_SS2); GAS unsigned char* xn8 = C.W<unsigned char>(WS_XN8);
    const int w0 = (C.bid - b0) * 8 + C.wave, nw = nb * 8;
    for (int t0 = w0; t0 < T; t0 += 4 * nw) {
        u32x4 a[4], c[4]; float sq[4]; bool ok[4];
#pragma unroll
        for (int q = 0; q < 4; ++q) { const int t = t0 + q * nw; ok[q] = t < T; const int tt = ok[q] ? t : 0; sq[q] = ss2[tt]; a[q] = *(const GAS u32x4*)(hb2 + (size_t)tt * D + lane * 16); c[q] = *(const GAS u32x4*)(hb2 + (size_t)tt * D + lane * 16 + 8); }
#pragma unroll
        for (int q = 0; q < 4; ++q) if (ok[q]) { const int t = t0 + q * nw; const float rs16 = __builtin_amdgcn_rsqf(sq[q] * (1.f / D) + EPS) * SA8; float av[8], cv[8]; unpack8(a[q], av); unpack8(c[q], cv);
            u32x4 o; o.x = pack4_fp8(av[0] * rs16, av[1] * rs16, av[2] * rs16, av[3] * rs16); o.y = pack4_fp8(av[4] * rs16, av[5] * rs16, av[6] * rs16, av[7] * rs16);
            o.z = pack4_fp8(cv[0] * rs16, cv[1] * rs16, cv[2] * rs16, cv[3] * rs16); o.w = pack4_fp8(cv[4] * rs16, cv[5] * rs16, cv[6] * rs16, cv[7] * rs16);
            *(GAS u32x4*)(xn8 + (size_t)t * D + lane * 16) = o; }
    }
}
__device__ __forceinline__ void topk_phase(const Ctx& C) {
    if (C.bid >= NBATCH * NE) { if (C.G > NBATCH * NE) xn8_rows(C, NBATCH * NE, C.G - NBATCH * NE); return; }
    if (C.G <= NBATCH * NE) xn8_rows(C, 0, C.G);
    const int tid = C.tid, lane = C.lane, w = C.wave; const int be = C.bid, b = be >> 4, e = be & 15;
    LAS unsigned* hist = (LAS unsigned*)C.lds;
    LAS unsigned* wsum = (LAS unsigned*)(C.lds + 1024);
    LAS unsigned* sh = (LAS unsigned*)(C.lds + 1152);
    const GAS float* pp = C.W<float>(WS_PROBS) + (size_t)be * SEQ + tid * 8;
    unsigned v[8]; { const u32x4 a = *(const u32x4*)pp, c = *(const GAS u32x4*)(pp + 4); v[0] = a.x; v[1] = a.y; v[2] = a.z; v[3] = a.w; v[4] = c.x; v[5] = c.y; v[6] = c.z; v[7] = c.w; }
    unsigned prefix = 0u, mask = 0u, need = CAP;
    for (int pass = 0; pass < 4; ++pass) {
        const int shift = 24 - 8 * pass;
        if (tid < 256) hist[tid] = 0u;
        __syncthreads();
#pragma unroll
        for (int i = 0; i < 8; ++i) if ((v[i] & mask) == prefix) __hip_atomic_fetch_add(&hist[(v[i] >> shift) & 255u], 1u, __ATOMIC_RELAXED, __HIP_MEMORY_SCOPE_WORKGROUP);
        __syncthreads();
        unsigned cnt = 0u, suf = 0u;
        if (tid < 256) { cnt = hist[tid]; suf = cnt;
#pragma unroll
            for (int off = 1; off < 64; off <<= 1) { const unsigned o = shdn_(suf, off, lane); if (lane + off < 64) suf += o; }
            if (lane == 0) wsum[w] = suf; }
        __syncthreads();
        if (tid < 256) { for (int ww = w + 1; ww < 4; ++ww) suf += wsum[ww];
            const unsigned above = suf - cnt; if (suf >= need && above < need) { sh[0] = (unsigned)tid; sh[1] = need - above; } }
        __syncthreads();
        prefix |= sh[0] << shift; mask |= 255u << shift; need = sh[1];
        __syncthreads();
    }
    const unsigned thr = prefix;
    unsigned cg = 0u, ce = 0u;
#pragma unroll
    for (int i = 0; i < 8; ++i) { cg += v[i] > thr; ce += v[i] == thr; }
    unsigned pk = cg | (ce << 16), inc = pk;
#pragma unroll
    for (int off = 1; off < 64; off <<= 1) { const unsigned o = shup_(inc, off, lane); if (lane >= off) inc += o; }
    if (lane == 63) wsum[w] = inc;
    __syncthreads();
    unsigned base = 0u, tot = 0u; for (int ww = 0; ww < 8; ++ww) { const unsigned x = wsum[ww]; if (ww < w) base += x; tot += x; }
    const unsigned ex = base + inc - pk; unsigned sg = ex & 0xffffu, se = ex >> 16; const unsigned totg = tot & 0xffffu;
    GAS int* idx = C.W<int>(WS_IDX) + be * CAP; GAS float* gp = C.W<float>(WS_GATEP) + be * CAP; GAS short* sel = C.W<short>(WS_SEL);
#pragma unroll
    for (int i = 0; i < 8; ++i) { const int s = tid * 8 + i; int slot = -1;
        if (v[i] > thr) slot = (int)sg++; else if (v[i] == thr) { if (se < need) slot = (int)(totg + se); ++se; }
        if (slot >= 0) { idx[slot] = s; gp[slot] = __builtin_bit_cast(float, v[i]); }
        sel[((size_t)b * SEQ + s) * NE + e] = (short)slot; }
    __syncthreads();
}
__device__ __forceinline__ void gather_phase(const Ctx& C) {
    const int gw = C.bid * 8 + C.wave, NGW = C.G * 8, lane = C.lane; const GAS bf16* hb2 = C.W<bf16>(WS_HB2); GAS bf16* xe = C.W<bf16>(WS_XE); const GAS int* idx = C.W<int>(WS_IDX); const GAS float* ss2 = C.W<float>(WS_SS2);
    for (int r = gw; r < NBATCH * NE * CAP; r += NGW) { const int b = r >> 13, tok = b * SEQ + idx[r]; const float rs = __builtin_amdgcn_rsqf(ss2[tok] * (1.f / D) + EPS);
#pragma unroll
        for (int j = 0; j < 2; ++j) { float vv[8]; unpack8(*(const GAS u32x4*)(hb2 + (size_t)tok * D + j * 512 + lane * 8), vv);
#pragma unroll
            for (int i = 0; i < 8; ++i) vv[i] *= rs;
            *(GAS u32x4*)(xe + (size_t)r * D + j * 512 + lane * 8) = pack8(vv); } }
}
__device__ __forceinline__ void combine_phase(const Ctx& C, int l) {
    const int gw = C.bid * 8 + C.wave, NGW = C.G * 8, lane = C.lane; const GAS bf16* hb2 = C.W<bf16>(WS_HB2); const GAS unsigned char* ye = C.W<unsigned char>(WS_XE); const GAS short* sel = C.W<short>(WS_SEL); GAS bf16* hb = C.W<bf16>(WS_HB); const GAS float* fg = C.inp<31>();
    u32x4 r1lo = {0u, 0u, 0u, 0u}, r1hi = r1lo, r2lo = r1lo, r2hi = r1lo; int s1 = -1, s2 = -1;
    u32x2 yA[4], yC[4], zA[4], zC[4]; bool yon[4] = {false, false, false, false}, zon[4] = {false, false, false, false}; unsigned yrest = 0u, zrest = 0u;
    u32x4 r0lo = r1lo, r0hi = r1lo; int s0 = -1;
#define CB_ROW(tt, rlo, rhi, sv_) do { if ((tt) < T) { rlo = *(const GAS u32x4*)(hb2 + (size_t)(tt) * D + lane * 8); rhi = *(const GAS u32x4*)(hb2 + (size_t)(tt) * D + 512 + lane * 8); sv_ = (lane < 16) ? (int)sel[(size_t)(tt) * NE + lane] : -1; } else sv_ = -1; } while (0)
#define CB_YE(tt, sv_, A_, C_, on_, rest_) do { unsigned _m = (unsigned)(__ballot((sv_) >= 0) & 0xffffull); const int _b = (tt) >> 12; \
        _Pragma("unroll") for (int q = 0; q < 4; ++q) { on_[q] = _m != 0u; if (on_[q]) { const int e = __builtin_ctz(_m); _m &= _m - 1u; const int slot = __builtin_amdgcn_readlane((sv_), e); \
            const GAS unsigned char* yr = ye + ((size_t)(_b * NE + e) * CAP + slot) * D; A_[q] = *(const GAS u32x2*)(yr + lane * 8); C_[q] = *(const GAS u32x2*)(yr + 512 + lane * 8); } } rest_ = _m; } while (0)
    CB_ROW(gw, r0lo, r0hi, s0); CB_ROW(gw + NGW, r1lo, r1hi, s1);
    if (gw < T) CB_YE(gw, s0, yA, yC, yon, yrest);
    for (int t = gw; t < T; t += NGW) { const int b = t >> 12; float lo[8], hi[8];
        if (t + NGW < T) CB_YE(t + NGW, s1, zA, zC, zon, zrest); else { zrest = 0u; _Pragma("unroll") for (int q = 0; q < 4; ++q) zon[q] = false; }
        CB_ROW(t + 2 * NGW, r2lo, r2hi, s2);
        unpack8(r0lo, lo); unpack8(r0hi, hi);
#pragma unroll
        for (int q = 0; q < 4; ++q) if (yon[q]) { float a[8], c[8]; unpack8_fp8(yA[q], a); unpack8_fp8(yC[q], c);
#pragma unroll
            for (int i = 0; i < 8; ++i) { lo[i] += a[i] * (1.f / SY8); hi[i] += c[i] * (1.f / SY8); } }
        for (unsigned m = yrest; m; ) {
            const int e = __builtin_ctz(m); m &= m - 1u; const int slot = __builtin_amdgcn_readlane(s0, e); const GAS unsigned char* yr = ye + ((size_t)(b * NE + e) * CAP + slot) * D;
            float a[8], c[8]; unpack8_fp8(*(const GAS u32x2*)(yr + lane * 8), a); unpack8_fp8(*(const GAS u32x2*)(yr + 512 + lane * 8), c);
#pragma unroll
            for (int i = 0; i < 8; ++i) { lo[i] += a[i] * (1.f / SY8); hi[i] += c[i] * (1.f / SY8); } }
        r0lo = r1lo; r0hi = r1hi; s0 = s1; r1lo = r2lo; r1hi = r2hi; s1 = s2; yrest = zrest;
#pragma unroll
        for (int q = 0; q < 4; ++q) { yA[q] = zA[q]; yC[q] = zC[q]; yon[q] = zon[q]; }
        if (l + 1 < DEPTH) {
            const u32x4 w0 = pack8(lo), w1 = pack8(hi); float r0[8], r1[8]; unpack8(w0, r0); unpack8(w1, r1); float ss = 0.f;
#pragma unroll
            for (int i = 0; i < 8; ++i) ss += r0[i] * r0[i] + r1[i] * r1[i];
#pragma unroll
            for (int off = 1; off < 64; off <<= 1) ss += shxf_(ss, off, lane);
            *(GAS u32x4*)(hb + (size_t)t * D + lane * 8) = w0; *(GAS u32x4*)(hb + (size_t)t * D + 512 + lane * 8) = w1; if (lane == 0) C.W<float>(WS_SS1)[t] = ss;
            { const float sa = __builtin_amdgcn_rsqf(ss * (1.f / D) + EPS) * SA8;
              u32x2 o8; o8.x = pack4_fp8(r0[0] * sa, r0[1] * sa, r0[2] * sa, r0[3] * sa); o8.y = pack4_fp8(r0[4] * sa, r0[5] * sa, r0[6] * sa, r0[7] * sa); *(GAS u32x2*)(C.W<unsigned char>(WS_HB8) + (size_t)t * D + lane * 8) = o8;
              o8.x = pack4_fp8(r1[0] * sa, r1[1] * sa, r1[2] * sa, r1[3] * sa); o8.y = pack4_fp8(r1[4] * sa, r1[5] * sa, r1[6] * sa, r1[7] * sa); *(GAS u32x2*)(C.W<unsigned char>(WS_HB8) + (size_t)t * D + 512 + lane * 8) = o8; }
        } else { float ss = 0.f;
#pragma unroll
            for (int i = 0; i < 8; ++i) ss += lo[i] * lo[i] + hi[i] * hi[i];
#pragma unroll
            for (int off = 1; off < 64; off <<= 1) ss += shxf_(ss, off, lane);
            const float rs = __builtin_amdgcn_rsqf(ss * (1.f / D) + EPS); const GAS float* g = fg;
            { const f32x4 g0 = *(const GAS f32x4*)(g + lane * 8), g1 = *(const GAS f32x4*)(g + lane * 8 + 4); float* o = C.out + (size_t)t * D + lane * 8;
                *(GAS f32x4*)o = (f32x4){lo[0] * rs * g0.x, lo[1] * rs * g0.y, lo[2] * rs * g0.z, lo[3] * rs * g0.w};
                *(GAS f32x4*)(o + 4) = (f32x4){lo[4] * rs * g1.x, lo[5] * rs * g1.y, lo[6] * rs * g1.z, lo[7] * rs * g1.w}; }
            { const f32x4 g0 = *(const GAS f32x4*)(g + 512 + lane * 8), g1 = *(const GAS f32x4*)(g + 512 + lane * 8 + 4); float* o = C.out + (size_t)t * D + 512 + lane * 8;
                *(GAS f32x4*)o = (f32x4){hi[0] * rs * g0.x, hi[1] * rs * g0.y, hi[2] * rs * g0.z, hi[3] * rs * g0.w};
                *(GAS f32x4*)(o + 4) = (f32x4){hi[4] * rs * g1.x, hi[5] * rs * g1.y, hi[6] * rs * g1.z, hi[7] * rs * g1.w}; }
        }
    }
}

#ifndef MK_REPEAT
#define MK_REPEAT 0
#endif
#if MK_REPEAT
__device__ __forceinline__ int rep_count(int n) { asm volatile("" : "+s"(n)); return n; }
#define REPLOOP(k) for (int rep_ = 0, nrep_ = (((MK_REPEAT >> (k)) & 1) ? rep_count(2) : 1); rep_ < nrep_; ++rep_)
#define REP0 (rep_ == 0)
#else
#define REPLOOP(k)
#define REP0 true
#endif
__global__ void __launch_bounds__(512, 2) mega_fwd(Args args) {
    extern __shared__ __attribute__((aligned(16))) unsigned char lds_raw[];
    asm volatile("s_setreg_imm32_b32 hwreg(HW_REG_MODE, 23, 1), 1" ::: "memory");
    Ctx C0; C0.karg = (unsigned long long)__builtin_amdgcn_kernarg_segment_ptr(); C0.out = args.out; C0.ws = args.ws; C0.lds = (LAS unsigned char*)lds_raw;
    C0.tid = threadIdx.x; C0.lane = C0.tid & 63; C0.wave = __builtin_amdgcn_readfirstlane(C0.tid >> 6); C0.G = gridDim.x; C0.bid = blockIdx.x;
    volatile LAS unsigned* MISC = (volatile LAS unsigned*)(C0.lds + LDSCTL_OFF);
    if (C0.tid < 64) MISC[C0.tid] = 0u;
    __syncthreads();
    const int lo = args.ph_lo, hi = args.ph_hi;
    XcdBarrier bar; bar.bar = (unsigned*)(C0.ws + WS_CTL) + 4096 + args.li * XCD_BAR_WORDS; bar.x = 0; bar.st = nullptr;
    if (hi - lo > 1) bar = xcd_barrier_post((unsigned*)(C0.ws + WS_CTL) + 4096 + args.li * XCD_BAR_WORDS, MISC + 8);
    const bool skip_inplace = (args.flags & 1) != 0; const int pflags = args.flags;
#ifndef SUB_MASK
#define SUB_MASK 0xffff
#endif
#define SUB(k) ((SUB_MASK >> (k)) & 1)
#ifndef PHASE_MASK
#define PHASE_MASK 0x3fff
#endif
#define IN(p) (((PHASE_MASK >> ((p) - P)) & 1) && lo <= (p) && (p) < hi)
  \
#define SEAM(p) do { const int k_ = (p) - P; const bool nl_ = (k_ == 13) && (l + 1 < DEPTH); if ((k_ >= 0 && k_ <= 8) || nl_) { asm volatile("s_waitcnt vmcnt(0)" ::: "memory"); __syncthreads(); \
        if (threadIdx.x == 0) { if ((p) + 1 < hi) xcd_barrier_core(bar); } else { const Ctx Cs = fresh(C0); cvt_w12_seam(Cs, nl_ ? l + 1 : l, nl_ ? 0 : k_); } __syncthreads(); } \
        else if ((p) + 1 < hi) xcd_barrier(bar); } while (0)
    LAS unsigned char* lds = C0.lds;
    for (int l = 0; l < DEPTH; ++l) {
        const int P = l * NPH;
        if (l == 0 && IN(P + 0)) { const Ctx C = fresh(C0); REPLOOP(0) {
            if (SUB(0)) p0_convert(C, l, pflags, false);
            if (SUB(1)) if (l == 0) p0_x_to_hb(C);
            if (SUB(2)) p0_s5_kt(C, l);
            __syncthreads(); }
            SEAM(P + 0);
        }
        if (IN(P + 1)) { const Ctx C = fresh(C0); REPLOOP(1) {
            p1_s5_assemble<3>(C, l, 0, C.G);
            const int slot = C.bid % 3;
            if (slot == 0) cvt_w12(C, l, 0);
            __syncthreads();
            {
                int tid2 = C.tid; asm volatile("" : "+v"(tid2));
                SchedGrid S{(const char*)C.W<bf16>(WS_HB), (const char*)C.W<bf16>(WS_WIN), T / 256, 8, D * 2, D * 2, C.G, C.bid, D / 64};
                EpiInProj E{C.W<float>(WS_SS1), C.W<bf16>(WS_UX), C.W<bf16>(WS_XB), C.W<bf16>(WS_Q), C.W<float>(WS_ALR), C.W<bf16>(WS_GATES), 1.f};
                pg8::gemm_phase(lds, tid2, D * 2, D * 2, S, E); }
            __syncthreads();
            if (slot == 1) cvt_w12(C, l, 0);
            __syncthreads();
            {
                int tid2 = C.tid; asm volatile("" : "+v"(tid2));
                SchedGrid S{(const char*)C.W<unsigned char>(WS_HB8), (const char*)C.W<unsigned char>(WS_WIN8), T / 256, 12, D, D, C.G, C.bid, D / 128, 0, 1 << 30, 8};
                EpiGates E{C.W<unsigned char>(WS_GATES)};
                pg8::gemm_phase<EpiGates, SchedGrid, true, false>(lds, tid2, D, D, S, E); }
            __syncthreads();
            if (slot == 2) cvt_w12(C, l, 0);
            __syncthreads(); }
            SEAM(P + 1);
        }
        if (IN(P + 2)) { const Ctx C = fresh(C0); REPLOOP(2) {
            if (SUB(0) && !(pflags & 8)) { SchedS5 S{(const char*)C.W<bf16>(WS_UX), (const char*)C.W<bf16>(WS_S5MIN), 4, 2, 128, 256 * 512 * 2, 512 * 2, 8, C.G, C.bid, 128}; EpiXlocH E{C.W<float>(WS_XLOC)};
              pg8::gemm_phase<EpiXlocH, SchedS5, false, false, true>(lds, C.tid, UXP * 2, 512 * 2, S, E); }
            __syncthreads();
            if (SUB(1) && !(pflags & 2)) lru_pass1_all(C, l);
            if (SUB(2) && !(pflags & 4)) gla_pass1_all(C, l);
            __syncthreads(); }
            SEAM(P + 2);
        }
        if (IN(P + 3)) { const Ctx C = fresh(C0); REPLOOP(3) {
            s5_scan(C, l);
            if (C.bid >= 32) { Ctx C2 = C; C2.bid = C.bid - 32; lru_carry(C2); }
            if (!skip_inplace) gla_scan(C);
            __syncthreads(); cvt_w12(C, l, 1);
            __syncthreads(); }
            SEAM(P + 3);
        }
        if (IN(P + 4)) { const Ctx C = fresh(C0); REPLOOP(4) {
            if (SUB(0)) { SchedS5 S{(const char*)C.W<bf16>(WS_UX), (const char*)C.W<bf16>(WS_S5BT2), 4, 2, 128, 512 * UXP * 2, UXP * 2, 12, C.G, C.bid}; EpiS5Out E{C.W<bf16>(WS_Z)};
              pg8::gemm_phase(lds, C.tid, UXP * 2, UXP * 2, S, E); }
            if (SUB(1)) lru_pass2(C);
            if (SUB(2)) for (int u = C.bid; u < 512; u += C.G) gla_pass2_unit(C, l, u);
            __syncthreads(); }
            SEAM(P + 4);
        }
        if (IN(P + 5)) { const Ctx C = fresh(C0); REPLOOP(5) {
            SchedGrid S{(const char*)C.W<bf16>(WS_Z), (const char*)C.W<bf16>(WS_WGLU), T / 256, 1, 512, 512, C.G, C.bid, 4}; EpiGlu E{C.W<bf16>(WS_Z), C.W<bf16>(WS_YCAT)};
            pg8::gemm_phase(lds, C.tid, 512, 512, S, E);
            __syncthreads(); cvt_w12(C, l, 2);
            __syncthreads(); }
            SEAM(P + 5);
        }
        if (IN(P + 6)) { const Ctx C = fresh(C0); REPLOOP(6) {
            SchedUp S{(const char*)C.W<bf16>(WS_YCAT), (const char*)C.W<bf16>(WS_WUP), C.G, C.bid}; EpiUp E{C.W<unsigned char>(WS_GATES), C.W<bf16>(WS_MERGED)};
            pg8::gemm_phase<EpiUp, SchedUp, false, false, true>(lds, C.tid, D * 2, D * 2, S, E);
            __syncthreads(); }
            SEAM(P + 6);
        }
        if (IN(P + 7)) { const Ctx C = fresh(C0); REPLOOP(7) {
            SchedGrid S{(const char*)C.W<bf16>(WS_MERGED), (const char*)C.W<bf16>(WS_WMIX), T / 256, 4, D * 2, D * 2, C.G, C.bid, 16}; EpiMix E{C.W<bf16>(WS_HB), C.W<bf16>(WS_HB2)};
            pg8::gemm_phase(lds, C.tid, D * 2, D * 2, S, E);
            __syncthreads(); }
            SEAM(P + 7);
        }
        if (IN(P + 8)) { const Ctx C = fresh(C0); REPLOOP(8) { router_phase(C); __syncthreads(); } SEAM(P + 8); }
        if (IN(P + 9)) { const Ctx C = fresh(C0); REPLOOP(9) { topk_phase(C); __syncthreads(); cvt_w12(C, l, 3); __syncthreads(); } SEAM(P + 9); }
        if (IN(P + 11)) { const Ctx C = fresh(C0); REPLOOP(11) {
            SchedFfn S{(const char*)C.W<unsigned char>(WS_XN8), (const char*)C.W<unsigned char>(WS_W1), 16, D, D, 8, C.G, C.bid, (size_t)4096 * D}; EpiFfn1 E{C.W<unsigned char>(WS_HID)};
            pg8::gemm_phase<EpiFfn1, SchedFfn, true, true>(lds, C.tid, D, D, S, E, C.W<int>(WS_IDX), (const char*)C.W<unsigned char>(WS_XN8));
            __syncthreads(); }
            SEAM(P + 11);
        }
        if (IN(P + 12)) { const Ctx C = fresh(C0); REPLOOP(12) {
            SchedFfn S{(const char*)C.W<unsigned char>(WS_HID), (const char*)C.W<unsigned char>(WS_W2), 4, FF, FF, 16, C.G, C.bid, (size_t)D * FF}; EpiFfn2 E{C.W<float>(WS_GATEP), C.W<unsigned char>(WS_XE)};
            pg8::gemm_phase<EpiFfn2, SchedFfn, true, false>(lds, C.tid, FF, FF, S, E);
            __syncthreads(); }
            SEAM(P + 12);
        }
        if (IN(P + 13)) { const Ctx C = fresh(C0); REPLOOP(13) { combine_phase(C, l); if (l + 1 < DEPTH) { p0_convert(C, l + 1, pflags, false); p0_s5_kt(C, l + 1); } __syncthreads(); } SEAM(P + 13); }
    }
#undef IN
#undef SEAM
}


#ifndef MK_DEBUG
#define MK_DEBUG 0
#endif
#if MK_DEBUG
constexpr size_t WS_DIAG = 512 * 1024;
__global__ void dbg_scan(const void* p, size_t n, int is_f32, unsigned code, unsigned* diag, float thr = 3e38f) {
    bool bad = false;
    for (size_t i = (size_t)blockIdx.x * blockDim.x + threadIdx.x; i < n; i += (size_t)gridDim.x * blockDim.x) {
        float v; if (is_f32) v = ((const float*)p)[i]; else v = __builtin_bit_cast(float, (unsigned)((const unsigned short*)p)[i] << 16);
        bad |= !(fabsf(v) <= thr); }
    if (bad) atomicMin(diag + 2, code);
}
__global__ void dbg_oin(const unsigned short* p, unsigned* diag) {
    unsigned fl = 0;
    for (size_t i = (size_t)blockIdx.x * blockDim.x + threadIdx.x; i < (size_t)T * 256; i += (size_t)gridDim.x * blockDim.x) {
        const float v = __builtin_bit_cast(float, (unsigned)p[i] << 16); if (!(fabsf(v) <= 1e30f)) { const int col = (int)(i & 255), row = (int)(i >> 8); fl |= 1u << ((col & 63) >> 4); fl |= 16u << ((row & 63) >> 5); atomicAdd(diag + 1, 1u); } }
    if (fl) atomicOr(diag, fl);
}
__global__ void dbg_report(float* out, size_t n, const unsigned* diag) {
    unsigned k = diag[2]; if (k > 60u) return;
    const float c = sqrtf((float)k * 0.1f);
    for (size_t i = (size_t)blockIdx.x * blockDim.x + threadIdx.x; i < n; i += (size_t)gridDim.x * blockDim.x) out[i] = c;
}
#endif

extern "C" void kernel_launch(void* const* d_in, const int* in_sizes, int n_in, void* d_out, int out_size, void* d_ws, size_t ws_size, hipStream_t stream) {
    static int grid = 0;
    if (grid == 0) {
        if (n_in != 32 || ws_size < WS_END) { fprintf(stderr, "kernel_launch: unexpected n_in %d or ws_size %zu (need %zu)\n", n_in, ws_size, (size_t)WS_END); grid = -1; return; }
        int dev = 0, cus = 0, per_cu = 0;
        if (hipGetDevice(&dev) != hipSuccess || hipDeviceGetAttribute(&cus, hipDeviceAttributeMultiprocessorCount, dev) != hipSuccess) { grid = -1; return; }
        if (hipFuncSetAttribute((const void*)mega_fwd, hipFuncAttributeMaxDynamicSharedMemorySize, LDS_BYTES) != hipSuccess) { fprintf(stderr, "kernel_launch: hipFuncSetAttribute failed\n"); grid = -1; return; }
        if (hipOccupancyMaxActiveBlocksPerMultiprocessor(&per_cu, (const void*)mega_fwd, 512, LDS_BYTES) != hipSuccess || per_cu < 1) fprintf(stderr, "kernel_launch: occupancy query says %d\n", per_cu);
        (void)hipGetLastError();
        grid = cus;
    }
    if (grid < 0) return;
    (void)hipMemsetAsync((char*)d_ws + WS_CTL, 0, CTL_BYTES, stream);
#if MK_DEBUG
    (void)hipMemsetAsync((char*)d_ws + WS_DIAG, 0x7f, 64, stream);
#endif
    Args a{};
    for (int i = 0; i < 32; ++i) a.in[i] = (const float*)d_in[i];
    a.out = (float*)d_out; a.ws = (unsigned char*)d_ws;
#if MK_PER_PHASE
    for (int p = 0; p < DEPTH * NPH; ++p) { a.ph_lo = p; a.ph_hi = p + 1; a.li = 0; a.flags = 0; hipLaunchKernelGGL(mega_fwd, dim3(grid), dim3(512), LDS_BYTES, stream, a);
#if MK_DEBUG
        { unsigned char* w = (unsigned char*)d_ws; unsigned* diag = (unsigned*)(w + WS_DIAG); const unsigned code = (unsigned)p + 1u; const int ph = p % NPH, l = p / NPH;
#define SCAN(off, n, f) hipLaunchKernelGGL(dbg_scan, dim3(1024), dim3(256), 0, stream, (const void*)(w + (off)), (size_t)(n), (f), code, diag, 1e30f)
          if (ph == 0) { SCAN(WS_WIN, (size_t)NIN * D, 0); SCAN(WS_W1, (size_t)NE * 4096 * D, 0); SCAN(WS_W2, (size_t)NE * D * FF, 0); SCAN(WS_WUP, (size_t)D * D, 0); SCAN(WS_WMIX, (size_t)D * D, 0); SCAN(WS_WGLU, 65536, 0);
                         SCAN(WS_S5MIN, (size_t)16 * 256 * 512, 0); SCAN(WS_S5BT2, (size_t)16 * 512 * 768, 0); SCAN(WS_LRUW, 131072, 0); SCAN(WS_WRT, 32768, 0); if (l == 0) { SCAN(WS_HB, (size_t)T * D, 0); SCAN(WS_SS1, T, 1); } }
          if (ph == 1) { SCAN(WS_XB, (size_t)T * 512, 0); SCAN(WS_Q, (size_t)T * 1024, 0); SCAN(WS_ALR, (size_t)T * 32, 1); SCAN(WS_GATES, (size_t)T * 3072, 0); }
          if (false) hipLaunchKernelGGL(dbg_oin, dim3(1024), dim3(256), 0, stream, (const unsigned short*)(w + WS_OIN), diag);
          if (false) {
#define SCANT(off, n, f, cd, th) hipLaunchKernelGGL(dbg_scan, dim3(1024), dim3(256), 0, stream, (const void*)(w + (off)), (size_t)(n), (f), (unsigned)(cd), diag, (float)(th))
              SCANT(WS_HB, (size_t)T * D, 0, 1, 10.f); SCANT(WS_SS1, T, 1, 2, 3000.f); SCANT(WS_XB, (size_t)T * 512, 0, 4, 30.f); SCANT(WS_Q, (size_t)T * 1024, 0, 8, 30.f); SCANT(WS_GATES, (size_t)T * 3072, 0, 16, 1.01f); SCANT(WS_WIN, (size_t)NIN * D, 0, 32, 1.f); }
          if (ph == 2) { SCAN(WS_XLOC, (size_t)16 * 1024 * 256, 1); SCAN(WS_YLOC, (size_t)T * 512 * 3, 0); SCAN(WS_LSUM, (size_t)512 * 512 * 4, 1); SCAN(WS_OIN, (size_t)T * 256 * 3, 0); SCAN(WS_KV, (size_t)2048 * 2 * 4096, 0); SCAN(WS_GDEC, (size_t)2048 * 128, 1); }
          if (ph == 3) { SCAN(WS_UX, (size_t)16 * 1024 * 768, 0); SCAN(WS_LCAR, (size_t)512 * 512 * 2, 1); SCAN(WS_KV, (size_t)2048 * 2 * 4096, 0); }
          if (ph == 4) { SCAN(WS_Z, (size_t)T * 256, 0); }
          if (ph == 5) { SCAN(WS_YCAT, (size_t)T * 1024, 0); }
          if (ph == 6) { SCAN(WS_MERGED, (size_t)T * 1024, 0); }
          if (ph == 7) { SCAN(WS_HB2, (size_t)T * 1024, 0); }
          if (ph == 8) { SCAN(WS_PROBS, (size_t)128 * 4096, 1); SCAN(WS_SS2, T, 1); }
          if (ph == 9) { SCAN(WS_GATEP, 65536, 1); }
          if (ph == 10) { SCAN(WS_XE, (size_t)65536 * 1024, 0); }
          if (ph == 11) { SCAN(WS_HID, (size_t)65536 * 2048, 0); }
          if (ph == 12) { SCAN(WS_XE, (size_t)65536 * 1024, 0); }
          if (ph == 13) { if (l == 0) { SCAN(WS_HB, (size_t)T * D, 0); SCAN(WS_SS1, T, 1); } else hipLaunchKernelGGL(dbg_scan, dim3(1024), dim3(256), 0, stream, (const void*)d_out, (size_t)T * D, 1, code, diag, 1e30f); }
#undef SCAN
        }
#endif
    }
#if MK_DEBUG
    hipLaunchKernelGGL(dbg_report, dim3(1024), dim3(256), 0, stream, (float*)d_out, (size_t)T * D, (const unsigned*)((unsigned char*)d_ws + WS_DIAG));
#endif
#elif MK_PROBE >= 0
    { const int k = MK_PROBE; const int seg[6][3] = {{0, k + 1, 0}, {k, k + 1, MK_PROBE_FLAGS_SET}, {k + 1, NPH + k + 1, 0}, {NPH + k, NPH + k + 1, MK_PROBE_FLAGS_SET}, {NPH + k + 1, 2 * NPH, 0}, {0, 0, 0}};
      for (int i = 0; i < 5; ++i) { if (seg[i][1] <= seg[i][0]) continue; a.ph_lo = seg[i][0]; a.ph_hi = seg[i][1]; a.li = i; a.flags = seg[i][2]; hipLaunchKernelGGL(mega_fwd, dim3(grid), dim3(512), LDS_BYTES, stream, a); } }
#else
    a.ph_lo = 0; a.ph_hi = DEPTH * NPH; a.li = 0; a.flags = 0;
    hipLaunchKernelGGL(mega_fwd, dim3(grid), dim3(512), LDS_BYTES, stream, a);
#endif
    (void)out_size; (void)in_sizes;
}
```
